# Optimizing an MI355X kernel written in HIP

```python
import math
import jax, jax.numpy as jnp
from jax import lax
import numpy as np

D_MODEL = 1024
BATCH = 2
SEQ = 8192
DEPTH = 2

ATT_HEADS = 8
ATT_KV_HEADS = 2
HEAD_DIM = 64
IDX_HEADS = 8
IDX_DIM = 64
TOPK_MAX = 256
Q_BLOCK = 128
ROPE_THETA = 10000.0
RWKV_HEADS = 4
RWKV_HEAD = 64
RWKV_DECAY_LORA = 32
RWKV_A_LORA = 32
RWKV_MV_LORA = 32
RWKV_GATE_LORA = 64
RWKV_GN_EPS = 64e-5
GDN_HEADS = 4
GDN_HEAD = 64
GDN_CONV = 4
GDN_CHUNK = 64
D_FF = 2816
NORM_EPS = 1e-6

ATT_W = ATT_HEADS * HEAD_DIM
KV_W = ATT_KV_HEADS * HEAD_DIM
RWKV_W = RWKV_HEADS * RWKV_HEAD
GDN_W = GDN_HEADS * GDN_HEAD
MIX_W = ATT_W + RWKV_W + GDN_W
ATT_SPLITS = (ATT_W, KV_W, KV_W, IDX_HEADS * IDX_DIM, IDX_DIM, IDX_HEADS)
RWKV_SPLITS = (RWKV_W, RWKV_W, RWKV_W, RWKV_DECAY_LORA, RWKV_A_LORA, RWKV_GATE_LORA)
GDN_SPLITS = (GDN_W, GDN_W, GDN_W, GDN_W, GDN_HEADS, GDN_HEADS)
RWKV_IN = sum(RWKV_SPLITS)
GROUP_SPLITS = (sum(ATT_SPLITS), RWKV_IN, sum(GDN_SPLITS))
IN_W = sum(GROUP_SPLITS)

kernel_name = 'hybrid_dsa_rwkv7_gdn_macaron'


def split_cols(p, sizes):
    offs = [int(o) for o in np.cumsum(sizes)[:-1]]
    return jnp.split(p, offs, axis=-1)


def rms_norm(x, g, eps=NORM_EPS):
    xf = x.astype(jnp.float32)
    y = xf * lax.rsqrt(jnp.mean(xf * xf, axis=-1, keepdims=True) + eps)
    return (y * g.astype(jnp.float32)).astype(x.dtype)


def l2_normalize(x, eps):
    xf = x.astype(jnp.float32)
    return xf * lax.rsqrt(jnp.sum(xf * xf, axis=-1, keepdims=True) + eps)


def rope(x, pos):
    half = x.shape[-1] // 2
    inv = ROPE_THETA ** (-jnp.arange(half, dtype=jnp.float32) / half)
    ang = pos.astype(jnp.float32)[:, None] * inv[None, :]
    cos, sin = jnp.cos(ang)[:, None, :], jnp.sin(ang)[:, None, :]
    xf = x.astype(jnp.float32)
    x1, x2 = xf[..., :half], xf[..., half:]
    return jnp.concatenate([x1 * cos - x2 * sin, x2 * cos + x1 * sin], axis=-1).astype(x.dtype)


def swiglu(h, w_gate, w_up, w_down):
    return (jax.nn.silu(h @ w_gate) * (h @ w_up)) @ w_down


def dsa_attention(pa, q_norm, k_norm):
    B, L, _ = pa.shape
    q, k, v, qi, ki, wi = split_cols(pa, ATT_SPLITS)
    pos = jnp.arange(L)
    q = rope(rms_norm(q.reshape(B, L, ATT_HEADS, HEAD_DIM), q_norm), pos)
    k = rope(rms_norm(k.reshape(B, L, ATT_KV_HEADS, HEAD_DIM), k_norm), pos)
    v = v.reshape(B, L, ATT_KV_HEADS, HEAD_DIM)
    qi = rope(qi.reshape(B, L, IDX_HEADS, IDX_DIM), pos).astype(jnp.float32)
    ki = rope(ki[:, :, None, :], pos)[:, :, 0].astype(jnp.float32)
    wi = wi.astype(jnp.float32) * (IDX_HEADS ** -0.5 * IDX_DIM ** -0.5)
    n_sel = min(TOPK_MAX, L // 4)
    n_blk = L // Q_BLOCK
    rep = ATT_HEADS // ATT_KV_HEADS
    scale = HEAD_DIM ** -0.5

    def to_blocks(a):
        return a.reshape(B, n_blk, Q_BLOCK, *a.shape[2:]).swapaxes(0, 1)

    def block(args):
        qb, qib, wib, tb = args
        logits = jnp.einsum('bqhd,bsd->bqhs', qib, ki)
        score = jnp.einsum('bqhs,bqh->bqs', jax.nn.relu(logits), wib)
        score = jnp.where(pos[None, None, :] <= tb[None, :, None], score, -jnp.inf)
        _, idx = lax.top_k(score, n_sel)
        valid = idx <= tb[None, :, None]
        ks = jax.vmap(lambda kb, ib: kb[ib])(k, idx).astype(jnp.float32)
        vs = jax.vmap(lambda vb, ib: vb[ib])(v, idx)
        qg = qb.reshape(B, Q_BLOCK, ATT_KV_HEADS, rep, HEAD_DIM).astype(jnp.float32)
        s = jnp.einsum('bqgrd,bqkgd->bqgrk', qg, ks) * scale
        s = jnp.where(valid[:, :, None, None, :], s, -jnp.inf)
        p = jax.nn.softmax(s, axis=-1).astype(vs.dtype)
        o = jnp.einsum('bqgrk,bqkgd->bqgrd', p, vs)
        return o.reshape(B, Q_BLOCK, ATT_W)

    out = lax.map(block, (to_blocks(q), to_blocks(qi), to_blocks(wi), pos.reshape(n_blk, Q_BLOCK)))
    return out.swapaxes(0, 1).reshape(B, L, ATT_W).astype(pa.dtype)


def rwkv7_scan(r, w, k, v, a, b):
    B, L, H, N = r.shape

    def step(S, inp):
        rt, wt, kt, vt, at, bt = inp
        sa = jnp.einsum('bhij,bhj->bhi', S, at)
        S = S * wt[:, :, None, :] + sa[..., None] * bt[:, :, None, :] + vt[..., None] * kt[:, :, None, :]
        return S, jnp.einsum('bhij,bhj->bhi', S, rt)

    xs = tuple(jnp.moveaxis(t, 1, 0) for t in (r, w, k, v, a, b))
    _, y = lax.scan(step, jnp.zeros((B, H, N, N), jnp.float32), xs)
    return jnp.moveaxis(y, 0, 1)


def rwkv7_time_mix(pb, mu, w0, w_up, a0, a_up, g_up, k_k, k_a, r_k, gn_w, gn_b, v_first, v0, v_down, v_up):
    dt = pb.dtype
    B, L, _ = pb.shape
    hb = pb.astype(jnp.float32)
    prev = jnp.pad(hb, ((0, 0), (1, 0), (0, 0)))[:, :-1]
    hb = hb + (prev - hb) * mu
    r, k, v, wd, ad, gd = split_cols(hb, RWKV_SPLITS)
    heads = lambda t: t.reshape(B, L, RWKV_HEADS, RWKV_HEAD)
    w_log = -jax.nn.softplus(-(w0 + jnp.tanh(wd) @ w_up)) - 0.5
    decay = jnp.exp(-jnp.exp(w_log))
    a = jax.nn.sigmoid(a0 + ad @ a_up)
    g = jax.nn.sigmoid(gd) @ g_up
    kk = l2_normalize(heads(k * k_k), 1e-12)
    k = k * (1.0 + (a - 1.0) * k_a)
    if v_first is None:
        v_first = v
    else:
        v = v + (v_first - v) * jax.nn.sigmoid(v0 + (v @ v_down) @ v_up)
    rh, kh, vh = heads(r), heads(k), heads(v)
    y = rwkv7_scan(rh, heads(decay), kh, vh, -kk, kk * heads(a))
    mean = jnp.mean(y, axis=-1, keepdims=True)
    var = jnp.mean(jnp.square(y - mean), axis=-1, keepdims=True)
    y = ((y - mean) * lax.rsqrt(var + RWKV_GN_EPS)).reshape(B, L, RWKV_W) * gn_w + gn_b
    bonus = jnp.sum(rh * kh * r_k, axis=-1, keepdims=True) * vh
    y = (y + bonus.reshape(B, L, RWKV_W)) * g
    return y.astype(dt), v_first


def causal_dwconv(x, w):
    C = x.shape[-1]
    return lax.conv_general_dilated(x, w[:, None, :], window_strides=(1,), padding=[(w.shape[0] - 1, 0)],
                                    dimension_numbers=('NWC', 'WIO', 'NWC'), feature_group_count=C)


def chunk_gated_delta_rule(q, k, v, g, beta):
    B, L, H, Dk = q.shape
    Dv = v.shape[-1]
    C = GDN_CHUNK
    n = L // C
    chunks = lambda t: t.reshape(B, n, C, H, t.shape[-1]).transpose(0, 3, 1, 2, 4)
    q, k, v = chunks(q), chunks(k), chunks(v)
    beta = beta.reshape(B, n, C, H).transpose(0, 3, 1, 2)
    g = jnp.cumsum(g.reshape(B, n, C, H).transpose(0, 3, 1, 2), axis=-1)
    incl = jnp.tril(jnp.ones((C, C), bool))
    strict = jnp.tril(jnp.ones((C, C), bool), -1)
    decay = jnp.exp(jnp.where(incl, g[..., :, None] - g[..., None, :], -jnp.inf))
    kb = k * beta[..., None]
    lower = jnp.where(strict, jnp.einsum('bhncd,bhnsd->bhncs', kb, k) * decay, 0.0)
    rhs = jnp.concatenate([v * beta[..., None], kb * jnp.exp(g)[..., None]], axis=-1)
    sol = lax.linalg.triangular_solve(jnp.eye(C, dtype=jnp.float32) + lower, rhs,
                                      left_side=True, lower=True, unit_diagonal=True)
    u, wk = sol[..., :Dv], sol[..., Dv:]
    intra = jnp.where(incl, jnp.einsum('bhncd,bhnsd->bhncs', q, k) * decay, 0.0)

    def step(S, inp):
        qc, kc, uc, wc, gc, ac = inp
        v_new = uc - jnp.einsum('bhck,bhkv->bhcv', wc, S)
        o = jnp.einsum('bhck,bhkv->bhcv', qc * jnp.exp(gc)[..., None], S) + jnp.einsum('bhcs,bhsv->bhcv', ac, v_new)
        g_last = gc[..., -1]
        S = S * jnp.exp(g_last)[..., None, None] + jnp.einsum(
            'bhck,bhcv->bhkv', kc * jnp.exp(g_last[..., None] - gc)[..., None], v_new)
        return S, o

    xs = tuple(jnp.moveaxis(t, 2, 0) for t in (q, k, u, wk, g, intra))
    _, o = lax.scan(step, jnp.zeros((B, H, Dk, Dv), jnp.float32), xs)
    return o.transpose(1, 0, 3, 2, 4).reshape(B, L, H, Dv)


def gated_deltanet(pc, conv_w, a_log, dt_bias, o_norm):
    dt = pc.dtype
    B, L, _ = pc.shape
    q, k, v, z, b_in, a_in = split_cols(pc.astype(jnp.float32), GDN_SPLITS)
    qkv = jax.nn.silu(causal_dwconv(jnp.concatenate([q, k, v], axis=-1), conv_w.astype(jnp.float32)))
    q, k, v = jnp.split(qkv, 3, axis=-1)
    heads = lambda t: t.reshape(B, L, GDN_HEADS, GDN_HEAD)
    q = l2_normalize(heads(q), 1e-6) * (GDN_HEAD ** -0.5)
    k = l2_normalize(heads(k), 1e-6)
    beta = jax.nn.sigmoid(b_in)
    g = -jnp.exp(a_log.astype(jnp.float32)) * jax.nn.softplus(a_in + dt_bias)
    o = chunk_gated_delta_rule(q, k, heads(v), g, beta)
    o = rms_norm(o, o_norm) * jax.nn.silu(heads(z))
    return o.reshape(B, L, GDN_W).astype(dt)


def setup_inputs(seed: int = 0) -> dict:
    key = jax.random.key(seed)
    ks = iter(jax.random.split(key, 40))
    nrm = lambda shape, s: jax.random.normal(next(ks), shape, jnp.float32) * s
    uni = lambda shape, lo, hi: jax.random.uniform(next(ks), shape, jnp.float32, lo, hi)
    D, F = D_MODEL, D_FF
    dt0 = jnp.exp(uni((DEPTH, GDN_HEADS), math.log(1e-3), math.log(1e-1)))
    return {
        'x': nrm((BATCH, SEQ, D), 1.0),
        'ffn_norm': 1.0 + nrm((DEPTH, 2, D), 0.02),
        'ffn_w_gate': nrm((DEPTH, 2, D, F), D ** -0.5),
        'ffn_w_up': nrm((DEPTH, 2, D, F), D ** -0.5),
        'ffn_w_down': nrm((DEPTH, 2, F, D), F ** -0.5),
        'mix_norm': 1.0 + nrm((DEPTH, D), 0.02),
        'w_in': nrm((DEPTH, D, IN_W), D ** -0.5),
        'w_out': nrm((DEPTH, MIX_W, D), MIX_W ** -0.5),
        'att_q_norm': 1.0 + nrm((DEPTH, HEAD_DIM), 0.02),
        'att_k_norm': 1.0 + nrm((DEPTH, HEAD_DIM), 0.02),
        'rwkv_mu': uni((DEPTH, RWKV_IN), 0.0, 1.0),
        'rwkv_w0': uni((DEPTH, RWKV_W), -6.5, -1.5),
        'rwkv_w_up': nrm((DEPTH, RWKV_DECAY_LORA, RWKV_W), RWKV_DECAY_LORA ** -0.5),
        'rwkv_a0': nrm((DEPTH, RWKV_W), 0.1),
        'rwkv_a_up': nrm((DEPTH, RWKV_A_LORA, RWKV_W), RWKV_A_LORA ** -0.5),
        'rwkv_g_up': nrm((DEPTH, RWKV_GATE_LORA, RWKV_W), RWKV_GATE_LORA ** -0.5),
        'rwkv_k_k': 0.85 + nrm((DEPTH, RWKV_W), 0.05),
        'rwkv_k_a': 1.0 + nrm((DEPTH, RWKV_W), 0.05),
        'rwkv_r_k': nrm((DEPTH, RWKV_HEADS, RWKV_HEAD), 0.1),
        'rwkv_gn_w': 1.0 + nrm((DEPTH, RWKV_W), 0.02),
        'rwkv_gn_b': nrm((DEPTH, RWKV_W), 0.02),
        'rwkv_v0': 1.0 + nrm((DEPTH - 1, RWKV_W), 0.05),
        'rwkv_v_down': nrm((DEPTH - 1, RWKV_W, RWKV_MV_LORA), RWKV_W ** -0.5),
        'rwkv_v_up': nrm((DEPTH - 1, RWKV_MV_LORA, RWKV_W), 0.1 * RWKV_MV_LORA ** -0.5),
        'gdn_conv': nrm((DEPTH, GDN_CONV, 3 * GDN_W), GDN_CONV ** -0.5),
        'gdn_a_log': jnp.log(uni((DEPTH, GDN_HEADS), 1.0, 16.0)),
        'gdn_dt_bias': dt0 + jnp.log(-jnp.expm1(-dt0)),
        'gdn_o_norm': 1.0 + nrm((DEPTH, GDN_HEAD), 0.02),
    }


def reference(x, ffn_norm, ffn_w_gate, ffn_w_up, ffn_w_down, mix_norm, w_in, w_out, att_q_norm, att_k_norm,
              rwkv_mu, rwkv_w0, rwkv_w_up, rwkv_a0, rwkv_a_up, rwkv_g_up, rwkv_k_k, rwkv_k_a, rwkv_r_k,
              rwkv_gn_w, rwkv_gn_b, rwkv_v0, rwkv_v_down, rwkv_v_up, gdn_conv, gdn_a_log, gdn_dt_bias, gdn_o_norm):
    v_first = None
    for l in range(DEPTH):
        x = x + 0.5 * swiglu(rms_norm(x, ffn_norm[l, 0]), ffn_w_gate[l, 0], ffn_w_up[l, 0], ffn_w_down[l, 0])
        p = rms_norm(x, mix_norm[l]) @ w_in[l]
        pa, pb, pc = split_cols(p, GROUP_SPLITS)
        ya = dsa_attention(pa, att_q_norm[l], att_k_norm[l])
        if l == 0:
            vres = (None, None, None)
        else:
            vres = (rwkv_v0[l - 1], rwkv_v_down[l - 1], rwkv_v_up[l - 1])
        yb, v_first = rwkv7_time_mix(pb, rwkv_mu[l], rwkv_w0[l], rwkv_w_up[l], rwkv_a0[l], rwkv_a_up[l],
                                     rwkv_g_up[l], rwkv_k_k[l], rwkv_k_a[l], rwkv_r_k[l], rwkv_gn_w[l],
                                     rwkv_gn_b[l], v_first, *vres)
        yc = gated_deltanet(pc, gdn_conv[l], gdn_a_log[l], gdn_dt_bias[l], gdn_o_norm[l])
        x = x + jnp.concatenate([ya, yb, yc], axis=-1) @ w_out[l]
        x = x + 0.5 * swiglu(rms_norm(x, ffn_norm[l, 1]), ffn_w_gate[l, 1], ffn_w_up[l, 1], ffn_w_down[l, 1])
    return x
```

```cpp
#include <hip/hip_runtime.h>
#include <cstdio>
#include <cstdint>

#ifndef MK_N_LAUNCHES
#define MK_N_LAUNCHES 0
#endif

#define LAS __attribute__((address_space(3)))
#define GAS __attribute__((address_space(1)))
typedef unsigned short bf16_t;
typedef short bf16x8 __attribute__((ext_vector_type(8)));
typedef float f32x4 __attribute__((ext_vector_type(4)));
typedef float f32x16 __attribute__((ext_vector_type(16)));
typedef float f32x2 __attribute__((ext_vector_type(2)));
typedef unsigned u32x4 __attribute__((ext_vector_type(4)));
typedef unsigned u32x2 __attribute__((ext_vector_type(2)));

constexpr int BATCH = 2, SEQ = 8192, DM = 1024, FF = 2816, MTOK = BATCH * SEQ;
constexpr int NGU = 2 * FF;
constexpr int NIN = 3328;
constexpr int PQ = 0, PK = 512, PV = 640, PQI = 768, PKI = 1280, PWI = 1344, PGB = 1352, PGA = 1356;
constexpr int PRW = 1408;
constexpr int PGD = 2304;
constexpr float NORM_EPS = 1e-6f;

constexpr size_t MiB = 1u << 20;
constexpr size_t WS_CTL = 0, CTL_ZERO_BYTES = 64 * 1024;
constexpr size_t WS_ROPE = 64 * 1024;
constexpr size_t WS_W = 3 * MiB;
constexpr size_t W_GU1 = 0, W_D1 = 11 * MiB, W_IN = W_D1 + 5632 * 1024, W_OUT = W_IN + (size_t)NIN * DM * 2, W_GU2 = W_OUT + 2 * MiB, W_D2 = W_GU2 + 11 * MiB, W_END = W_D2 + 5632 * 1024;
constexpr size_t WS_XBF = 45 * MiB;
constexpr size_t WS_BIG = 77 * MiB;
constexpr size_t WS_P = WS_BIG, WS_Y = WS_BIG + 104 * MiB, WS_ACT = WS_BIG;
constexpr size_t WS_SSQ = 213 * MiB;
constexpr size_t WS_VF = 216 * MiB;
constexpr size_t WS_END = 224 * MiB;
static_assert(W_END <= 42 * MiB && WS_W + W_END <= WS_XBF && WS_Y + 32 * MiB <= WS_SSQ, "ws map");

constexpr int CW_BAR = 1024;
constexpr int CW_WORK = 8192;

constexpr int LDS_MISC = 154 * 1024;
constexpr int LDS_BYTES = 155 * 1024;

__device__ __forceinline__ unsigned f2bf(float f) { unsigned u = __builtin_bit_cast(unsigned, f); return (u + 0x7fffu + ((u >> 16) & 1u)) >> 16; }
__device__ __forceinline__ unsigned pk2(float lo, float hi) { return f2bf(lo) | (f2bf(hi) << 16); }
__device__ __forceinline__ float bf2f(unsigned short h) { return __builtin_bit_cast(float, (unsigned)h << 16); }
__device__ __forceinline__ float bflo(unsigned w) { return __builtin_bit_cast(float, w << 16); }
__device__ __forceinline__ float bfhi(unsigned w) { return __builtin_bit_cast(float, w & 0xffff0000u); }
__device__ __forceinline__ float wave_sum(float v) {
#pragma unroll
    for (int o = 1; o < 64; o <<= 1) v += __shfl_xor(v, o);
    return v;
}
__device__ __forceinline__ float sigmoidf_(float x) { return 1.f / (1.f + __expf(-x)); }
__device__ __forceinline__ float siluf_(float x) { return x / (1.f + __expf(-x)); }
__device__ __forceinline__ float softplusf_(float x) { return x > 20.f ? x : log1pf(__expf(x)); }

namespace pg8 {
constexpr int BM = 256, BK = 64, HALF = 128, HTB = HALF * BK * 2, STAGE_BYTES = 8 * HTB, NXCD = 8, WGM = 8;
__host__ __device__ __forceinline__ int lds_byte(int r, int c) { const int st = (r >> 4) * 2 + (c >> 5), rr = r & 15, cc = c & 31, ob = rr * 64 + cc * 2; return st * 1024 + (ob ^ (((ob >> 9) & 1) << 5)); }
__host__ __device__ __forceinline__ void stage_rc(int b, int& R, int& C) { const int st = b / 1024, sb = b % 1024, swz = sb ^ (((sb >> 9) & 1) << 5); R = (st >> 1) * 16 + swz / 64; C = (st & 1) * 32 + (swz % 64) / 2; }
__host__ __device__ __forceinline__ int perm32(int rho) { const int n = rho >> 4, i = rho & 15; return 8 * (i >> 2) + 4 * n + (i & 3); }
struct Unit { int pm, pn; };
struct Gemm { const bf16_t* A; const bf16_t* Bt; int M, N, K; };
struct StaticOrder {
    int nM, nN, nwg, G, c;
    __host__ __device__ void init(int M, int N, int G_, int c_) { nM = M / BM; nN = N / BM; nwg = nM * nN; G = G_; c = c_; }
    __host__ __device__ bool next(int i, Unit& u) const {
        const long L = (long)i * G + c; if (L >= nwg) return false;
        int wgid = (int)L; { const int q = nwg / NXCD, r = nwg % NXCD, xcd = wgid % NXCD, off = wgid / NXCD; wgid = (xcd < r ? xcd * (q + 1) : r * (q + 1) + (xcd - r) * q) + off; }
        const int nig = WGM * nN, gid = wgid / nig, fm = gid * WGM, gsz = (nM - fm) < WGM ? (nM - fm) : WGM;
        u.pm = fm + ((wgid % nig) % gsz); u.pn = (wgid % nig) / gsz; return true;
    }
};
__device__ __forceinline__ unsigned cvt_pk_bf16(float lo, float hi) { unsigned r; asm volatile("v_cvt_pk_bf16_f32 %0, %1, %2" : "=v"(r) : "v"(lo), "v"(hi)); return r; }

__device__ __forceinline__ float row_rstd(const float* ssq, int row, int fq) {
    const f32x4 v = *(const f32x4*)(ssq + (size_t)row * 16 + 4 * fq);
    float s = (v[0] + v[1]) + (v[2] + v[3]);
    s += __shfl_xor(s, 16); s += __shfl_xor(s, 32);
    return rsqrtf(s * (1.0f / DM) + NORM_EPS);
}
struct EpiFfnUp {
    static constexpr bool PERM = true;
    bf16_t* O; const float* ssq;
    __device__ __forceinline__ void operator()(const f32x4 (&acc)[2][2][4][2], const Unit& u, int wr, int wc, int fr, int fq) const {
        const int row0 = u.pm * BM + wr * 64 + fr; const int col0 = u.pn * HALF + wc * 32 + 8 * fq;
#pragma unroll
        for (int ai = 0; ai < 2; ++ai)
#pragma unroll
            for (int m = 0; m < 4; ++m) { const int row = row0 + ai * HALF + m * 16; const float rs = row_rstd(ssq, row, fq);
                float o[8];
#pragma unroll
                for (int n = 0; n < 2; ++n)
#pragma unroll
                    for (int e = 0; e < 4; ++e) { const float g = acc[ai][0][m][n][e] * rs, up = acc[ai][1][m][n][e] * rs;
                        o[n * 4 + e] = g * __builtin_amdgcn_rcpf(1.f + __builtin_amdgcn_exp2f(-1.4426950408889634f * g)) * up; }
                u32x4 w; w.x = cvt_pk_bf16(o[0], o[1]); w.y = cvt_pk_bf16(o[2], o[3]); w.z = cvt_pk_bf16(o[4], o[5]); w.w = cvt_pk_bf16(o[6], o[7]);
                *(u32x4*)(O + (size_t)row * FF + col0) = w; asm volatile("" ::: "memory"); }
    }
};
struct EpiRowScaleBf16 {
    static constexpr bool PERM = true;
    bf16_t* O; int ldc; const float* ssq;
    __device__ __forceinline__ void operator()(const f32x4 (&acc)[2][2][4][2], const Unit& u, int wr, int wc, int fr, int fq) const {
        const int row0 = u.pm * BM + wr * 64 + fr; const int col0 = u.pn * BM + wc * 32 + 8 * fq;
#pragma unroll
        for (int ai = 0; ai < 2; ++ai)
#pragma unroll
            for (int m = 0; m < 4; ++m) { const int row = row0 + ai * HALF + m * 16; const float rs = row_rstd(ssq, row, fq);
#pragma unroll
                for (int bj = 0; bj < 2; ++bj) { const f32x4 v0 = acc[ai][bj][m][0] * rs, v1 = acc[ai][bj][m][1] * rs;
                    u32x4 w; w.x = cvt_pk_bf16(v0[0], v0[1]); w.y = cvt_pk_bf16(v0[2], v0[3]); w.z = cvt_pk_bf16(v1[0], v1[1]); w.w = cvt_pk_bf16(v1[2], v1[3]);
                    *(u32x4*)(O + (size_t)row * ldc + col0 + bj * HALF) = w; } asm volatile("" ::: "memory"); }
    }
};
struct EpiResid {
    static constexpr bool PERM = false;
    const float* xin; float* xout; bf16_t* xbf; float* ssq; float alpha;
    __device__ __forceinline__ void operator()(const f32x4 (&acc)[2][2][4][2], const Unit& u, int wr, int wc, int fr, int fq) const {
        const int row0 = u.pm * BM + wr * 64 + fr; const int col0 = u.pn * BM + wc * 32 + 4 * fq;
#pragma unroll
        for (int ai = 0; ai < 2; ++ai)
#pragma unroll
            for (int m = 0; m < 4; ++m) { const int row = row0 + ai * HALF + m * 16; const size_t off = (size_t)row * DM + col0; float s = 0.f;
#pragma unroll
                for (int bj = 0; bj < 2; ++bj)
#pragma unroll
                    for (int n = 0; n < 2; ++n) { const size_t o2 = off + bj * HALF + n * 16; const f32x4 xi = *(const f32x4*)(xin + o2); const f32x4 v = xi + acc[ai][bj][m][n] * alpha;
                        *(f32x4*)(xout + o2) = v; u32x2 w; w.x = cvt_pk_bf16(v[0], v[1]); w.y = cvt_pk_bf16(v[2], v[3]); *(u32x2*)(xbf + o2) = w;
                        s += (v[0] * v[0] + v[1] * v[1]) + (v[2] * v[2] + v[3] * v[3]); }
                s += __shfl_xor(s, 16); s += __shfl_xor(s, 32);
                if (fq == 0) ssq[(size_t)row * 16 + u.pn * 4 + wc] = s; }
    }
};

template <class Epi, class Sched, bool ALIGN_EPI = false, bool SP2 = false>
__device__ __forceinline__ void gemm_phase(LAS unsigned char* lds, const Gemm g, const Sched& S, const Epi& E, const int tid) {
    const int wid = __builtin_amdgcn_readfirstlane(tid >> 6), lane = tid & 63, wr = wid >> 2, wc = wid & 3, fr = lane & 15, fq = lane >> 4;
    const int K = g.K, nt = K / BK;
    unsigned voffA[2], voffB[2];
#pragma unroll
    for (int i = 0; i < 2; ++i) { int R, C; stage_rc(tid * 16 + i * 8192, R, C); const int Rb = Epi::PERM ? ((R & ~31) + perm32(R & 31)) : R;
        voffA[i] = (unsigned)(R * K + C) * 2u; voffB[i] = (unsigned)(Rb * K + C) * 2u; }
    const size_t kstep = (size_t)(BK * 2);
    const size_t hstep = (size_t)HALF * K * 2;
    const size_t tstep = 2 * hstep;
    const unsigned ldsw = (unsigned)wid * 1024u;
    const int aoff = lds_byte(wr * 64 + fr, fq * 8), boff = lds_byte(wc * 32 + fr, fq * 8);
#define PG8_SA(b, h) (((b) * 2 + (h)) * HTB)
#define PG8_SB(b, h) ((4 + (b) * 2 + (h)) * HTB)
#define PG8_STAGE(bufoff, gbase, voff) do { _Pragma("unroll") for (int _i = 0; _i < 2; ++_i) \
        __builtin_amdgcn_global_load_lds((const unsigned*)((const char*)(gbase) + (voff)[_i]), (LAS unsigned*)(lds + (bufoff) + ldsw + _i * 8192), 16, 0, 0); } while (0)
#define PG8_LDA(dst, b, h) do { _Pragma("unroll") for (int m = 0; m < 4; ++m) _Pragma("unroll") for (int k = 0; k < 2; ++k) dst[m][k] = *(const LAS bf16x8*)(lds + PG8_SA(b, h) + aoff + m * 2048 + k * 1024); } while (0)
#define PG8_LDB(dst, b, h) do { _Pragma("unroll") for (int n = 0; n < 2; ++n) _Pragma("unroll") for (int k = 0; k < 2; ++k) dst[n][k] = *(const LAS bf16x8*)(lds + PG8_SB(b, h) + boff + n * 2048 + k * 1024); } while (0)
#define PG8_MMA(ai, bj, At, Bt) do { __builtin_amdgcn_s_setprio(1); _Pragma("unroll") for (int m = 0; m < 4; ++m) _Pragma("unroll") for (int n = 0; n < 2; ++n) _Pragma("unroll") for (int k = 0; k < 2; ++k) \
        acc[ai][bj][m][n] = __builtin_amdgcn_mfma_f32_16x16x32_bf16(Bt[n][k], At[m][k], acc[ai][bj][m][n], 0, 0, 0); __builtin_amdgcn_s_setprio(0); } while (0)
#define PG8_WAIT_V(n) asm volatile("s_waitcnt vmcnt(" #n ")" ::: "memory")
#define PG8_WAIT_L(n) asm volatile("s_waitcnt lgkmcnt(" #n ")" ::: "memory")
#define PG8_BAR __builtin_amdgcn_s_barrier()
#define PG8_SCHED __builtin_amdgcn_sched_barrier(0)
    Unit cur, nxt; int ui = 0;
    if (!S.next(0, cur)) return;
    f32x4 acc[2][2][4][2];
#pragma unroll
    for (int a = 0; a < 2; ++a)
#pragma unroll
        for (int b = 0; b < 2; ++b)
#pragma unroll
            for (int m = 0; m < 4; ++m)
#pragma unroll
                for (int n = 0; n < 2; ++n) acc[a][b][m][n] = (f32x4){0.f, 0.f, 0.f, 0.f};
    bf16x8 At[4][2], B0[2][2], B1[2][2];
    const char* cA = (const char*)g.A + (size_t)cur.pm * tstep; const char* cB = (const char*)g.Bt + (size_t)cur.pn * tstep;
    if constexpr (SP2) {
        PG8_STAGE(PG8_SB(0, 0), cB, voffB); PG8_STAGE(PG8_SB(0, 1), cB + hstep, voffB); PG8_STAGE(PG8_SA(0, 0), cA, voffA); PG8_STAGE(PG8_SA(0, 1), cA + hstep, voffA);
        if (wr == 1) PG8_BAR;
        PG8_WAIT_V(2); PG8_BAR;
        PG8_STAGE(PG8_SB(1, 0), cB + kstep, voffB); PG8_STAGE(PG8_SA(1, 0), cA + kstep, voffA); PG8_STAGE(PG8_SB(1, 1), cB + hstep + kstep, voffB);
        PG8_WAIT_V(6); PG8_BAR;
    } else {
        PG8_STAGE(PG8_SB(0, 0), cB, voffB); PG8_STAGE(PG8_SA(0, 0), cA, voffA); PG8_STAGE(PG8_SB(0, 1), cB + hstep, voffB); PG8_STAGE(PG8_SA(0, 1), cA + hstep, voffA);
        if (wr == 1) PG8_BAR;
        PG8_WAIT_V(4); PG8_BAR;
        PG8_STAGE(PG8_SB(1, 0), cB + kstep, voffB); PG8_STAGE(PG8_SA(1, 0), cA + kstep, voffA); PG8_STAGE(PG8_SB(1, 1), cB + hstep + kstep, voffB);
        PG8_WAIT_V(6); PG8_BAR;
    }
    for (;;) {
        const bool has_next = S.next(ui + 1, nxt);
        const char* nA = has_next ? (const char*)g.A + (size_t)nxt.pm * tstep : cA; const char* nB = has_next ? (const char*)g.Bt + (size_t)nxt.pn * tstep : cB;
        for (int t = 0; t < nt; t += 2) {
            const bool last = (t == nt - 2);
            const char* a1 = cA + (size_t)(t + 1) * kstep;
            const char* a2 = last ? nA : cA + (size_t)(t + 2) * kstep; const char* b2 = last ? nB : cB + (size_t)(t + 2) * kstep;
            const char* a3 = a2 + kstep; const char* b3 = b2 + kstep;
            if constexpr (SP2) {
            PG8_LDB(B0, 0, 0); PG8_LDB(B1, 0, 1); PG8_SCHED; PG8_LDA(At, 0, 0); PG8_STAGE(PG8_SA(1, 1), a1 + hstep, voffA);
            PG8_WAIT_V(8); PG8_WAIT_L(0); PG8_BAR; PG8_MMA(0, 0, At, B0); PG8_MMA(0, 1, At, B1); PG8_BAR; PG8_SCHED;
            PG8_LDA(At, 0, 1); PG8_STAGE(PG8_SB(0, 0), b2, voffB); PG8_STAGE(PG8_SB(0, 1), b2 + hstep, voffB); PG8_STAGE(PG8_SA(0, 0), a2, voffA);
            PG8_WAIT_V(8); PG8_WAIT_L(0); PG8_BAR; PG8_MMA(1, 0, At, B0); PG8_MMA(1, 1, At, B1); PG8_BAR; PG8_SCHED;
            PG8_LDB(B0, 1, 0); PG8_LDB(B1, 1, 1); PG8_SCHED; PG8_LDA(At, 1, 0); PG8_STAGE(PG8_SA(0, 1), a2 + hstep, voffA);
            PG8_WAIT_V(8); PG8_WAIT_L(0); PG8_BAR; PG8_MMA(0, 0, At, B0); PG8_MMA(0, 1, At, B1); PG8_BAR; PG8_SCHED;
            PG8_LDA(At, 1, 1); PG8_STAGE(PG8_SB(1, 0), b3, voffB); PG8_STAGE(PG8_SB(1, 1), b3 + hstep, voffB); PG8_STAGE(PG8_SA(1, 0), a3, voffA);
            PG8_WAIT_V(8); PG8_WAIT_L(0); PG8_BAR; PG8_MMA(1, 0, At, B0); PG8_MMA(1, 1, At, B1); PG8_BAR; PG8_SCHED;
            } else {
            PG8_LDB(B0, 0, 0); PG8_SCHED; PG8_LDA(At, 0, 0); PG8_STAGE(PG8_SA(1, 1), a1 + hstep, voffA);
            PG8_WAIT_L(8); PG8_BAR; PG8_WAIT_L(0); PG8_MMA(0, 0, At, B0); PG8_BAR; PG8_SCHED;
            PG8_LDB(B1, 0, 1); PG8_STAGE(PG8_SB(0, 0), b2, voffB);
            PG8_BAR; PG8_WAIT_L(0); PG8_MMA(0, 1, At, B1); PG8_BAR;
            PG8_LDA(At, 0, 1); PG8_STAGE(PG8_SA(0, 0), a2, voffA);
            PG8_BAR; PG8_WAIT_L(0); PG8_MMA(1, 0, At, B0); PG8_BAR; PG8_SCHED;
            PG8_STAGE(PG8_SB(0, 1), b2 + hstep, voffB);
            PG8_WAIT_V(6); PG8_BAR; PG8_MMA(1, 1, At, B1); PG8_BAR;
            PG8_LDB(B0, 1, 0); PG8_SCHED; PG8_LDA(At, 1, 0); PG8_STAGE(PG8_SA(0, 1), a2 + hstep, voffA);
            PG8_WAIT_L(8); PG8_BAR; PG8_WAIT_L(0); PG8_MMA(0, 0, At, B0); PG8_BAR; PG8_SCHED;
            PG8_LDB(B1, 1, 1); PG8_STAGE(PG8_SB(1, 0), b3, voffB);
            PG8_BAR; PG8_WAIT_L(0); PG8_MMA(0, 1, At, B1); PG8_BAR;
            PG8_LDA(At, 1, 1); PG8_STAGE(PG8_SA(1, 0), a3, voffA);
            PG8_BAR; PG8_WAIT_L(0); PG8_MMA(1, 0, At, B0); PG8_BAR; PG8_SCHED;
            PG8_STAGE(PG8_SB(1, 1), b3 + hstep, voffB);
            PG8_WAIT_V(6); PG8_BAR; PG8_MMA(1, 1, At, B1); PG8_BAR;
            }
        }
        if constexpr (ALIGN_EPI) { if (wr == 0) PG8_BAR; }
        E(acc, cur, wr, wc, fr, fq);
        if (!has_next) break;
#pragma unroll
        for (int a = 0; a < 2; ++a)
#pragma unroll
            for (int b = 0; b < 2; ++b)
#pragma unroll
                for (int m = 0; m < 4; ++m)
#pragma unroll
                    for (int n = 0; n < 2; ++n) acc[a][b][m][n] = (f32x4){0.f, 0.f, 0.f, 0.f};
        cur = nxt; cA = nA; cB = nB; ++ui;
        if constexpr (ALIGN_EPI) { if (wr == 1) PG8_BAR; }
    }
    PG8_WAIT_V(0);
    if constexpr (!ALIGN_EPI) { if (wr == 0) PG8_BAR; }
    PG8_BAR;
#undef PG8_SA
#undef PG8_SB
#undef PG8_STAGE
#undef PG8_LDA
#undef PG8_LDB
#undef PG8_MMA
#undef PG8_WAIT_V
#undef PG8_WAIT_L
#undef PG8_BAR
#undef PG8_SCHED
}
}

#define XB_TMO      128
#define XB_XCNT(j)  (256  + 64 * (j))
#define XB_XSUB(j)  (1280 + 64 * (j))
#define XB_XGEN(j)  (2304 + 64 * (j))
#define XB_TOP      3328
#define XB_TOPGEN   3392
#define XCD_BAR_WORDS 3456
#define XB_SPIN_CAP (1u << 20)
__device__ __forceinline__ unsigned xb_ld(unsigned* p)              { return __hip_atomic_load(p, __ATOMIC_RELAXED, __HIP_MEMORY_SCOPE_AGENT); }
__device__ __forceinline__ unsigned xb_add(unsigned* p, unsigned v) { return __hip_atomic_fetch_add(p, v, __ATOMIC_RELAXED, __HIP_MEMORY_SCOPE_AGENT); }
__device__ __forceinline__ unsigned xb_xcc_id() { return (unsigned)__builtin_amdgcn_s_getreg((3 << 11) | 20) & 0xFu; }
#define XB_SPIN(cond, bar) do { unsigned _sp = 0; while (cond) { __builtin_amdgcn_s_sleep(1); \
    if ((++_sp & 255u) == 0u) { if (xb_ld(&(bar)[XB_TMO])) break; if (_sp > XB_SPIN_CAP) { atomicAdd(&(bar)[XB_TMO], 1u); break; } } } } while (0)
struct XcdBarrier { unsigned* bar; unsigned x; volatile LAS unsigned* st; };
__device__ __forceinline__ XcdBarrier xcd_barrier_post(unsigned* bar, volatile LAS unsigned* st) {
    XcdBarrier b; b.bar = bar; b.x = xb_xcc_id(); b.st = st;
    if (threadIdx.x == 0) (void)xb_add(&bar[XB_XCNT(b.x)], 1u);
    return b;
}
__device__ __forceinline__ void xcd_barrier_complete(unsigned* bar, unsigned x, unsigned& nloc, unsigned& nx) {
    const unsigned G = gridDim.x * gridDim.y * gridDim.z;
    unsigned sum, cnt, mine, sp = 0u;
    for (;;) {
        sum = 0u; cnt = 0u; mine = 0u;
#pragma unroll
        for (unsigned j = 0; j < 16; ++j) { const unsigned c = xb_ld(&bar[XB_XCNT(j)]); sum += c; cnt += (c > 0u) ? 1u : 0u; mine = (j == x) ? c : mine; }
        if (sum == G) break;
        __builtin_amdgcn_s_sleep(1);
        if ((++sp & 255u) == 0u) { if (xb_ld(&bar[XB_TMO])) break; if (sp > XB_SPIN_CAP) { atomicAdd(&bar[XB_TMO], 1u); break; } }
    }
    nloc = mine > 0u ? mine : 1u; nx = cnt > 0u ? cnt : 1u;
}
__device__ __forceinline__ void xcd_barrier(const XcdBarrier& b) {
    asm volatile("s_waitcnt vmcnt(0)" ::: "memory");
    __syncthreads();
    if (threadIdx.x == 0) {
        unsigned* bar = b.bar;
        __builtin_amdgcn_s_waitcnt(0);
        unsigned nloc = b.st[0], nx = b.st[1];
        if (nloc == 0u) { xcd_barrier_complete(bar, b.x, nloc, nx); b.st[0] = nloc; b.st[1] = nx; }
        const unsigned old = xb_add(&bar[XB_XSUB(b.x)], 1u);
        const unsigned gen = old / nloc;
        if (old + 1u == (gen + 1u) * nloc) {
            __builtin_amdgcn_fence(__ATOMIC_RELEASE, "agent");
            asm volatile("s_waitcnt vmcnt(0)" ::: "memory");
            const unsigned og = xb_add(&bar[XB_TOP], 1u);
            const unsigned tg = og / nx;
            if (og + 1u == (tg + 1u) * nx) xb_add(&bar[XB_TOPGEN], 1u);
            else XB_SPIN(xb_ld(&bar[XB_TOPGEN]) == tg, bar);
            __builtin_amdgcn_fence(__ATOMIC_ACQUIRE, "agent");
            xb_add(&bar[XB_XGEN(b.x)], 1u);
            asm volatile("s_waitcnt vmcnt(0)" ::: "memory");
        } else {
            XB_SPIN(xb_ld(&bar[XB_XGEN(b.x)]) == gen, bar);
            __builtin_amdgcn_fence(__ATOMIC_ACQUIRE, "agent");
            asm volatile("s_waitcnt vmcnt(0)" ::: "memory");
        }
    }
    __syncthreads();
}

struct Args { const float* in[28]; float* out; unsigned char* ws; int ph_lo, ph_hi; };
enum { I_X = 0, I_FFN_NORM, I_WG, I_WU, I_WD, I_MIX_NORM, I_WIN, I_WOUT, I_QN, I_KN, I_MU, I_W0, I_WUP, I_A0, I_AUP, I_GUP, I_KK, I_KA, I_RK, I_GNW, I_GNB, I_V0, I_VDOWN, I_VUP, I_CONV, I_ALOG, I_DTB, I_ONORM };

typedef const __attribute__((address_space(4))) Args* ArgsP;
struct Ctx {
    LAS unsigned char* lds;
    int tid, lane, wave, G, bid;
    ArgsP a;
};

template <class Get>
__device__ __forceinline__ void cvt_item(Get get, int K, bf16_t* WT, LAS float* scr, int kb, int nb, int lane) {
    const int k0 = 64 * kb, n0 = 32 * nb;
#pragma unroll 8
    for (int i = 0; i < 32; ++i) { const int kk = 2 * i + (lane >> 5); scr[kk * 33 + (lane & 31)] = get(k0 + kk, n0 + (lane & 31)); }
    asm volatile("s_waitcnt lgkmcnt(0)" ::: "memory");
    const int c = lane & 7;
#pragma unroll
    for (int j = 0; j < 4; ++j) { const int n = (lane >> 3) + 8 * j; const LAS float* s = scr + (8 * c) * 33 + n;
        u32x4 o; o.x = pk2(s[0 * 33], s[1 * 33]); o.y = pk2(s[2 * 33], s[3 * 33]); o.z = pk2(s[4 * 33], s[5 * 33]); o.w = pk2(s[6 * 33], s[7 * 33]);
        *(u32x4*)(WT + (size_t)(n0 + n) * K + k0 + 8 * c) = o; }
    asm volatile("s_waitcnt lgkmcnt(0)" ::: "memory");
}
__device__ __forceinline__ int win_cmap(int nn) {
    if (nn < 1352) return nn;
    if (nn < 1356) return 3272 + (nn - 1352);
    if (nn < 1360) return 3276 + (nn - 1356);
    if (nn < 1408) return -1;
    if (nn < 2304) return 1352 + (nn - 1408);
    return 2248 + (nn - 2304);
}
__device__ __forceinline__ void convert_layer_weights(const Ctx& C, int l) {
    const ArgsP Ap = C.a;
    LAS float* scr = (LAS float*)(C.lds + C.wave * 16384);
    unsigned char* wb = Ap->ws + WS_W;
    const int gw = C.bid * 8 + C.wave, NGW = C.G * 8;
    constexpr int I_GU = (DM / 64) * (NGU / 32), I_D = (FF / 64) * (DM / 32), I_IN = (DM / 64) * (NIN / 32), I_OUT = (DM / 64) * (DM / 32);
    constexpr int NIT = 2 * I_GU + 2 * I_D + I_IN + I_OUT;
    for (int it = gw; it < NIT; it += NGW) {
        int r = it;
        if (r < 2 * I_GU) { const int f = r / I_GU; r -= f * I_GU; const int nblk = NGU / 32, kb = r / nblk, nb = r % nblk;
            const float* wg = Ap->in[I_WG] + (size_t)(l * 2 + f) * DM * FF; const float* wu = Ap->in[I_WU] + (size_t)(l * 2 + f) * DM * FF; const float* gv = Ap->in[I_FFN_NORM] + (size_t)(l * 2 + f) * DM;
            auto get = [=](int k, int nn) -> float { const int pn = nn >> 8, bj = (nn >> 7) & 1, j = nn & 127; const float* w = bj ? wu : wg; return w[(size_t)k * FF + pn * 128 + j] * gv[k]; };
            cvt_item(get, DM, (bf16_t*)(wb + (f ? W_GU2 : W_GU1)), scr, kb, nb, C.lane); continue; }
        r -= 2 * I_GU;
        if (r < 2 * I_D) { const int f = r / I_D; r -= f * I_D; const int nblk = DM / 32, kb = r / nblk, nb = r % nblk;
            const float* wd = Ap->in[I_WD] + (size_t)(l * 2 + f) * FF * DM;
            auto get = [=](int k, int nn) -> float { return wd[(size_t)k * DM + nn]; };
            cvt_item(get, FF, (bf16_t*)(wb + (f ? W_D2 : W_D1)), scr, kb, nb, C.lane); continue; }
        r -= 2 * I_D;
        if (r < I_IN) { const int nblk = NIN / 32, kb = r / nblk, nb = r % nblk;
            const float* wi = Ap->in[I_WIN] + (size_t)l * DM * 3280; const float* gv = Ap->in[I_MIX_NORM] + (size_t)l * DM;
            auto get = [=](int k, int nn) -> float { const int c = win_cmap(nn); return c < 0 ? 0.f : wi[(size_t)k * 3280 + c] * gv[k]; };
            cvt_item(get, DM, (bf16_t*)(wb + W_IN), scr, kb, nb, C.lane); continue; }
        r -= I_IN;
        { const int nblk = DM / 32, kb = r / nblk, nb = r % nblk;
            const float* wo = Ap->in[I_WOUT] + (size_t)l * DM * DM;
            auto get = [=](int k, int nn) -> float { return wo[(size_t)k * DM + nn]; };
            cvt_item(get, DM, (bf16_t*)(wb + W_OUT), scr, kb, nb, C.lane); }
    }
}

__device__ const float ROPE_INV_HI[32] = {1.000000000e+00f, 7.498942018e-01f, 5.623413324e-01f, 4.216965139e-01f, 3.162277639e-01f, 2.371373773e-01f, 1.778279394e-01f, 1.333521456e-01f, 1.000000015e-01f, 7.498942316e-02f, 5.623413250e-02f, 4.216964915e-02f, 3.162277490e-02f, 2.371373773e-02f, 1.778279431e-02f, 1.333521400e-02f, 9.999999776e-03f, 7.498942316e-03f, 5.623413250e-03f, 4.216964822e-03f, 3.162277630e-03f, 2.371373819e-03f, 1.778279431e-03f, 1.333521446e-03f, 1.000000047e-03f, 7.498941850e-04f, 5.623413017e-04f, 4.216965172e-04f, 3.162277571e-04f, 2.371373703e-04f, 1.778279402e-04f, 1.333521504e-04f};
__device__ const float ROPE_INV_LO[32] = {0.000000000e+00f, 7.576931971e-09f, -7.245258615e-09f, -1.046263787e-08f, 2.125617904e-09f, -6.695950017e-09f, 1.612756151e-09f, -2.336302707e-09f, -1.490116142e-09f, -2.222539042e-09f, 2.053218012e-11f, 1.188910415e-09f, 1.702677888e-09f, -6.695949906e-10f, -2.112534175e-10f, 3.251632574e-10f, 2.235174129e-10f, -2.222539097e-10f, 2.053217839e-12f, 2.120233017e-10f, 3.056940465e-11f, -1.135256264e-10f, -2.112534106e-11f, -1.404980212e-11f, -4.749745042e-11f, 2.434073776e-11f, 2.348838658e-11f, -1.372226725e-11f, 8.877706729e-12f, 2.889693693e-13f, 7.978488746e-13f, -7.225746477e-12f};
__device__ __forceinline__ void prologue_x(const Ctx& C) {
    const ArgsP Ap = C.a;
    const float* x = Ap->in[I_X]; bf16_t* xbf = (bf16_t*)(Ap->ws + WS_XBF); float* ssq = (float*)(Ap->ws + WS_SSQ);
    const int gw = C.bid * 8 + C.wave, NGW = C.G * 8;
    for (int m = gw; m < MTOK; m += NGW) {
        const f32x4* xr = (const f32x4*)(x + (size_t)m * DM) + C.lane;
        f32x4 v[4]; float s = 0.f;
#pragma unroll
        for (int j = 0; j < 4; ++j) { v[j] = xr[64 * j]; s += (v[j][0] * v[j][0] + v[j][1] * v[j][1]) + (v[j][2] * v[j][2] + v[j][3] * v[j][3]); }
        s = wave_sum(s);
        u32x2* o8 = (u32x2*)(xbf + (size_t)m * DM) + C.lane;
#pragma unroll
        for (int j = 0; j < 4; ++j) { u32x2 w; w.x = pk2(v[j][0], v[j][1]); w.y = pk2(v[j][2], v[j][3]); o8[64 * j] = w; }
        if (C.lane < 16) ssq[(size_t)m * 16 + C.lane] = (C.lane == 0) ? s : 0.f;
    }
    f32x2* cs = (f32x2*)(Ap->ws + WS_ROPE);
    const int gt = C.bid * 512 + C.tid, NT = C.G * 512;
    for (int e = gt; e < SEQ * 32; e += NT) {
        const int pos = e >> 5, i = e & 31;
        const float fpos = (float)pos, ih = ROPE_INV_HI[i], il = ROPE_INV_LO[i];
        const float ph = fpos * ih; const float pe = fmaf(fpos, ih, -ph) + fpos * il;
        const float k = rintf(ph * 0.15915494309189535f);
        float r = fmaf(-k, 6.2831854820251465f, ph); r = fmaf(-k, -1.7484555e-07f, r); r += pe;
        const float r2 = r * r;
        float ts = 1.f, tc = 1.f;
        ts = 1.f - ts * r2 * (1.f / (18.f * 19.f)); ts = 1.f - ts * r2 * (1.f / (16.f * 17.f)); ts = 1.f - ts * r2 * (1.f / (14.f * 15.f)); ts = 1.f - ts * r2 * (1.f / (12.f * 13.f));
        ts = 1.f - ts * r2 * (1.f / (10.f * 11.f)); ts = 1.f - ts * r2 * (1.f / (8.f * 9.f)); ts = 1.f - ts * r2 * (1.f / (6.f * 7.f)); ts = 1.f - ts * r2 * (1.f / (4.f * 5.f)); ts = 1.f - ts * r2 * (1.f / (2.f * 3.f));
        tc = 1.f - tc * r2 * (1.f / (19.f * 20.f)); tc = 1.f - tc * r2 * (1.f / (17.f * 18.f)); tc = 1.f - tc * r2 * (1.f / (15.f * 16.f)); tc = 1.f - tc * r2 * (1.f / (13.f * 14.f)); tc = 1.f - tc * r2 * (1.f / (11.f * 12.f));
        tc = 1.f - tc * r2 * (1.f / (9.f * 10.f)); tc = 1.f - tc * r2 * (1.f / (7.f * 8.f)); tc = 1.f - tc * r2 * (1.f / (5.f * 6.f)); tc = 1.f - tc * r2 * (1.f / (3.f * 4.f)); tc = 1.f - tc * r2 * (1.f / (1.f * 2.f));
        cs[e] = (f32x2){tc, ts * r};
    }
}

__device__ __forceinline__ void prep_phase(const Ctx& C, int l) {
    const ArgsP Ap = C.a;
    bf16_t* P = (bf16_t*)(Ap->ws + WS_P);
    const f32x2* cs = (const f32x2*)(Ap->ws + WS_ROPE);
    const float* qn = Ap->in[I_QN] + l * 64; const float* kn = Ap->in[I_KN] + l * 64;
    {
        const int gw = C.bid * 8 + C.wave, NGW = C.G * 8; const int hl = C.lane >> 5, i = C.lane & 31;
        for (int m = gw; m < MTOK; m += NGW) {
            const int pos = m & (SEQ - 1); const f32x2 c = cs[pos * 32 + i];
            bf16_t* row = P + (size_t)m * NIN;
#pragma unroll 1
            for (int hp = 0; hp < 10; ++hp) {
                const int hd = hp * 2 + hl; if (hd >= 19) continue;
                int col; const float* nw = nullptr; float sc = 1.f;
                if (hd < 8) { col = PQ + hd * 64; nw = qn; sc = 0.125f; } else if (hd < 10) { col = PK + (hd - 8) * 64; nw = kn; } else if (hd < 18) { col = PQI + (hd - 10) * 64; } else { col = PKI; }
                float x1 = bf2f(row[col + i]), x2 = bf2f(row[col + 32 + i]);
                if (nw) { float ss = x1 * x1 + x2 * x2;
#pragma unroll
                    for (int o = 1; o < 32; o <<= 1) ss += __shfl_xor(ss, o);
                    const float rs = rsqrtf(ss * (1.f / 64.f) + NORM_EPS) * sc; x1 = x1 * rs * nw[i]; x2 = x2 * rs * nw[i + 32]; }
                const float o1 = x1 * c[0] - x2 * c[1], o2 = x2 * c[0] + x1 * c[1];
                row[col + i] = (bf16_t)f2bf(o1); row[col + 32 + i] = (bf16_t)f2bf(o2);
            }
        }
    }
    {
        bf16_t* LO = (bf16_t*)(Ap->ws + WS_XBF);
        LAS float* in128 = (LAS float*)C.lds;
        LAS float* vt = (LAS float*)(C.lds + 32768);
        LAS float* vd = (LAS float*)(C.lds + 32768 + 65536);
        const float* mu = Ap->in[I_MU] + l * 896;
        const int c0 = C.tid & 255, half = C.tid >> 8;
        for (int tile = C.bid; tile < MTOK / 64; tile += C.G) {
            const int m0 = tile * 64;
            int c = c0; asm volatile("" : "+v"(c));
            __syncthreads();
            for (int e = C.tid; e < 64 * 128; e += 512) { const int t = e >> 7, j = e & 127; const int m = m0 + t; const bf16_t* row = P + (size_t)m * NIN + PRW + 768;
                const float cur = bf2f(row[j]); const float prev = (m & (SEQ - 1)) ? bf2f(row[j - NIN]) : 0.f; float h = cur + (prev - cur) * mu[768 + j];
                if (j < 32) h = tanhf(h); else if (j >= 64) h = sigmoidf_(h);
                in128[e] = h; }
            if (l > 0) {
                for (int e = C.tid; e < 64 * 256; e += 512) { const int t = e >> 8, j = e & 255; const int m = m0 + t; const bf16_t* row = P + (size_t)m * NIN + PRW + 512;
                    const float cur = bf2f(row[j]); const float prev = (m & (SEQ - 1)) ? bf2f(row[j - NIN]) : 0.f; vt[e] = cur + (prev - cur) * mu[512 + j]; }
                __syncthreads();
                const float* vdn = Ap->in[I_VDOWN] + (size_t)(l - 1) * 256 * 32;
                for (int e = C.tid; e < 64 * 32; e += 512) { const int t = e >> 5, j = e & 31; float s = 0.f;
                    for (int k = 0; k < 256; ++k) s += vt[t * 256 + k] * vdn[k * 32 + j];
                    vd[e] = s; }
            }
            __syncthreads();
            const int tb = half * 32;
            { const float* wup = Ap->in[I_WUP] + (size_t)l * 32 * 256; float w[32];
#pragma unroll
              for (int j = 0; j < 32; ++j) w[j] = wup[j * 256 + c];
              const float w0 = Ap->in[I_W0][l * 256 + c];
              asm volatile("" ::: "memory");
#pragma unroll 1
              for (int t = tb; t < tb + 32; ++t) { float s = w0;
#pragma unroll
                  for (int j = 0; j < 32; ++j) s += in128[t * 128 + j] * w[j];
                  const float wlog = -softplusf_(-s) - 0.5f; LO[(size_t)(m0 + t) * 1024 + c] = (bf16_t)f2bf(-__expf(wlog)); } }
            { const float* aup = Ap->in[I_AUP] + (size_t)l * 32 * 256; float w[32];
#pragma unroll
              for (int j = 0; j < 32; ++j) w[j] = aup[j * 256 + c];
              const float a0 = Ap->in[I_A0][l * 256 + c];
              asm volatile("" ::: "memory");
#pragma unroll 1
              for (int t = tb; t < tb + 32; ++t) { float s = a0;
#pragma unroll
                  for (int j = 0; j < 32; ++j) s += in128[t * 128 + 32 + j] * w[j];
                  LO[(size_t)(m0 + t) * 1024 + 256 + c] = (bf16_t)f2bf(sigmoidf_(s)); } }
            { const float* gup = Ap->in[I_GUP] + (size_t)l * 64 * 256; float w[64];
#pragma unroll
              for (int j = 0; j < 64; ++j) w[j] = gup[j * 256 + c];
              asm volatile("" ::: "memory");
#pragma unroll 1
              for (int t = tb; t < tb + 32; ++t) { float s = 0.f;
#pragma unroll
                  for (int j = 0; j < 64; ++j) s += in128[t * 128 + 64 + j] * w[j];
                  LO[(size_t)(m0 + t) * 1024 + 512 + c] = (bf16_t)f2bf(s); } }
            if (l > 0) { const float* vup = Ap->in[I_VUP] + (size_t)(l - 1) * 32 * 256; float w[32];
#pragma unroll
              for (int j = 0; j < 32; ++j) w[j] = vup[j * 256 + c];
              const float v0 = Ap->in[I_V0][(l - 1) * 256 + c];
              asm volatile("" ::: "memory");
#pragma unroll 1
              for (int t = tb; t < tb + 32; ++t) { float s = v0;
#pragma unroll
                  for (int j = 0; j < 32; ++j) s += vd[t * 32 + j] * w[j];
                  LO[(size_t)(m0 + t) * 1024 + 768 + c] = (bf16_t)f2bf(sigmoidf_(s)); } }
        }
        __syncthreads();
    }
}

constexpr int SC_CH = 32;
struct ScanLds { LAS float *W, *A, *B, *K, *R, *V, *Y, *G, *X; };
__device__ __forceinline__ ScanLds scan_lds(LAS unsigned char* lds) {
    ScanLds s; LAS float* f = (LAS float*)lds; s.W = f; s.A = f + 2048; s.B = f + 4096; s.K = f + 6144; s.R = f + 8192; s.V = f + 10240; s.Y = f + 12288; s.G = f + 14336; s.X = f + 16384; return s;
}
__device__ __forceinline__ void scan_chunk(const ScanLds& L, float (&s)[8], int tid) {
    const int row = tid >> 3, j8 = (tid & 7) * 8;
#pragma unroll 2
    for (int t = 0; t < SC_CH; ++t) {
        const f32x4 w0 = *(const LAS f32x4*)(L.W + t * 64 + j8), w1 = *(const LAS f32x4*)(L.W + t * 64 + j8 + 4);
        const f32x4 a0 = *(const LAS f32x4*)(L.A + t * 64 + j8), a1 = *(const LAS f32x4*)(L.A + t * 64 + j8 + 4);
        const f32x4 b0 = *(const LAS f32x4*)(L.B + t * 64 + j8), b1 = *(const LAS f32x4*)(L.B + t * 64 + j8 + 4);
        const f32x4 k0 = *(const LAS f32x4*)(L.K + t * 64 + j8), k1 = *(const LAS f32x4*)(L.K + t * 64 + j8 + 4);
        const f32x4 r0 = *(const LAS f32x4*)(L.R + t * 64 + j8), r1 = *(const LAS f32x4*)(L.R + t * 64 + j8 + 4);
        const float v = L.V[t * 64 + row];
        float sa = 0.f;
#pragma unroll
        for (int c = 0; c < 4; ++c) { sa += s[c] * a0[c]; sa += s[4 + c] * a1[c]; }
        sa += __shfl_xor(sa, 1); sa += __shfl_xor(sa, 2); sa += __shfl_xor(sa, 4);
        float y = 0.f;
#pragma unroll
        for (int c = 0; c < 4; ++c) { s[c] = s[c] * w0[c] + sa * b0[c] + v * k0[c]; s[4 + c] = s[4 + c] * w1[c] + sa * b1[c] + v * k1[c]; y += s[c] * r0[c]; y += s[4 + c] * r1[c]; }
        y += __shfl_xor(y, 1); y += __shfl_xor(y, 2); y += __shfl_xor(y, 4);
        if ((tid & 7) == 0) L.Y[t * 64 + row] = y;
    }
}

__device__ __forceinline__ void rwkv_block(const Ctx& C, int l, int bh) {
    const ArgsP Ap = C.a;
    const int b = bh >> 2, h = bh & 3, lane = C.lane, ch = h * 64 + lane;
    const bf16_t* P = (const bf16_t*)(Ap->ws + WS_P); const bf16_t* LO = (const bf16_t*)(Ap->ws + WS_XBF);
    bf16_t* VF = (bf16_t*)(Ap->ws + WS_VF); bf16_t* Y = (bf16_t*)(Ap->ws + WS_Y);
    const ScanLds L = scan_lds(C.lds);
    const float* mu = Ap->in[I_MU] + l * 896;
    const float mu_r = mu[ch], mu_k = mu[256 + ch], mu_v = mu[512 + ch];
    const float k_k = Ap->in[I_KK][l * 256 + ch], k_a = Ap->in[I_KA][l * 256 + ch], r_k = Ap->in[I_RK][l * 256 + ch];
    const float gn_w = Ap->in[I_GNW][l * 256 + ch], gn_b = Ap->in[I_GNB][l * 256 + ch];
    float s[8];
#pragma unroll
    for (int c = 0; c < 8; ++c) s[c] = 0.f;
    for (int t0 = 0; t0 < SEQ; t0 += SC_CH) {
        __syncthreads();
        for (int tk = C.wave; tk < SC_CH; tk += 8) {
            const int t = t0 + tk; const size_t m = (size_t)b * SEQ + t;
            const bf16_t* row = P + m * NIN + PRW; const bool hp = t > 0;
            const float rc = bf2f(row[ch]), kc = bf2f(row[256 + ch]), vc = bf2f(row[512 + ch]);
            const float rp = hp ? bf2f(row[ch - NIN]) : 0.f, kp = hp ? bf2f(row[256 + ch - NIN]) : 0.f, vp = hp ? bf2f(row[512 + ch - NIN]) : 0.f;
            const float r = rc + (rp - rc) * mu_r, k = kc + (kp - kc) * mu_k; float v = vc + (vp - vc) * mu_v;
            const bf16_t* lo = LO + m * 1024;
            const float wl = bf2f(lo[ch]), a = bf2f(lo[256 + ch]), g = bf2f(lo[512 + ch]);
            if (l == 0) VF[m * 256 + ch] = (bf16_t)f2bf(v);
            else { const float vg = bf2f(lo[768 + ch]); const float vf = bf2f(VF[m * 256 + ch]); v = v + (vf - v) * vg; }
            const float kkp = k * k_k; const float n2 = wave_sum(kkp * kkp); const float kk = kkp * rsqrtf(n2 + 1e-12f);
            const float k2 = k * (1.f + (a - 1.f) * k_a);
            const float bon = wave_sum(r * k2 * r_k);
            L.W[tk * 64 + lane] = __expf(wl); L.A[tk * 64 + lane] = -kk; L.B[tk * 64 + lane] = kk * a; L.K[tk * 64 + lane] = k2; L.R[tk * 64 + lane] = r; L.V[tk * 64 + lane] = v; L.G[tk * 64 + lane] = g;
            if (lane == 0) L.X[tk] = bon;
        }
        __syncthreads();
        scan_chunk(L, s, C.tid);
        __syncthreads();
        for (int tk = C.wave; tk < SC_CH; tk += 8) {
            const size_t m = (size_t)b * SEQ + t0 + tk;
            const float y = L.Y[tk * 64 + lane]; const float mean = wave_sum(y) * (1.f / 64.f); const float d = y - mean; const float var = wave_sum(d * d) * (1.f / 64.f);
            const float yn = d * rsqrtf(var + 64e-5f) * gn_w + gn_b;
            const float o = (yn + L.X[tk] * L.V[tk * 64 + lane]) * L.G[tk * 64 + lane];
            Y[m * DM + 512 + ch] = (bf16_t)f2bf(o);
        }
    }
    __syncthreads();
}

__device__ __forceinline__ void gdn_block(const Ctx& C, int l, int bh) {
    const ArgsP Ap = C.a;
    const int b = bh >> 2, h = bh & 3, lane = C.lane, ch = h * 64 + lane;
    const bf16_t* P = (const bf16_t*)(Ap->ws + WS_P); bf16_t* Y = (bf16_t*)(Ap->ws + WS_Y);
    const ScanLds L = scan_lds(C.lds);
    const float* cw = Ap->in[I_CONV] + (size_t)l * 4 * 768;
    float wq[4], wk[4], wv[4];
#pragma unroll
    for (int j = 0; j < 4; ++j) { wq[j] = cw[j * 768 + ch]; wk[j] = cw[j * 768 + 256 + ch]; wv[j] = cw[j * 768 + 512 + ch]; }
    const float nexpa = -__expf(Ap->in[I_ALOG][l * 4 + h]), dtb = Ap->in[I_DTB][l * 4 + h], onw = Ap->in[I_ONORM][l * 64 + lane];
    float s[8];
#pragma unroll
    for (int c = 0; c < 8; ++c) s[c] = 0.f;
    for (int t0 = 0; t0 < SEQ; t0 += SC_CH) {
        __syncthreads();
        for (int tk = C.wave; tk < SC_CH; tk += 8) {
            const int t = t0 + tk; const size_t m = (size_t)b * SEQ + t;
            const bf16_t* row = P + m * NIN;
            float xq = 0.f, xk = 0.f, xv = 0.f;
#pragma unroll
            for (int j = 0; j < 4; ++j) { const int dt = 3 - j; if (t - dt >= 0) { const bf16_t* rr = row - (size_t)dt * NIN + PGD;
                xq += wq[j] * bf2f(rr[ch]); xk += wk[j] * bf2f(rr[256 + ch]); xv += wv[j] * bf2f(rr[512 + ch]); } }
            xq = siluf_(xq); xk = siluf_(xk); xv = siluf_(xv);
            const float q = xq * rsqrtf(wave_sum(xq * xq) + 1e-6f) * 0.125f; const float k = xk * rsqrtf(wave_sum(xk * xk) + 1e-6f);
            const float beta = sigmoidf_(bf2f(row[PGB + h])); const float gg = nexpa * softplusf_(bf2f(row[PGA + h]) + dtb); const float eg = __expf(gg);
            L.W[tk * 64 + lane] = eg; L.A[tk * 64 + lane] = eg * k; L.B[tk * 64 + lane] = -beta * k; L.K[tk * 64 + lane] = beta * k; L.R[tk * 64 + lane] = q; L.V[tk * 64 + lane] = xv;
            L.G[tk * 64 + lane] = siluf_(bf2f(row[PGD + 768 + ch]));
        }
        __syncthreads();
        scan_chunk(L, s, C.tid);
        __syncthreads();
        for (int tk = C.wave; tk < SC_CH; tk += 8) {
            const size_t m = (size_t)b * SEQ + t0 + tk;
            const float o = L.Y[tk * 64 + lane]; const float rs = rsqrtf(wave_sum(o * o) * (1.f / 64.f) + NORM_EPS);
            Y[m * DM + 768 + ch] = (bf16_t)f2bf(o * rs * onw * L.G[tk * 64 + lane]);
        }
    }
    __syncthreads();
}

constexpr int DS_CAP = 1024;
constexpr int DS_KI = 128 * 1024, DS_KIROW = 144, DS_KIBUF = 64 * DS_KIROW, DS_HIST = DS_KI + 2 * DS_KIBUF;
static_assert(DS_HIST + 8 * 1024 <= LDS_MISC, "dsa lds");

__device__ __forceinline__ unsigned wave_select256(LAS unsigned* list, int n, LAS unsigned* hist, int lane) {
    unsigned k[16];
#pragma unroll
    for (int j = 0; j < 16; ++j) { const int i = j * 64 + lane; k[j] = (i < n) ? list[i] : 0u; }
    unsigned prefix = 0u, mask = 0u; int rem = 256;
#pragma unroll 1
    for (int pass = 0; pass < 4; ++pass) {
        const int sh = 24 - 8 * pass;
        *(LAS u32x4*)(hist + 4 * lane) = (u32x4){0u, 0u, 0u, 0u};
        asm volatile("s_waitcnt lgkmcnt(0)" ::: "memory");
#pragma unroll
        for (int j = 0; j < 16; ++j) { const int i = j * 64 + lane; if (i < n && ((k[j] ^ prefix) & mask) == 0u) __hip_atomic_fetch_add((LAS unsigned*)&hist[(k[j] >> sh) & 255u], 1u, __ATOMIC_RELAXED, __HIP_MEMORY_SCOPE_WORKGROUP); }
        asm volatile("s_waitcnt lgkmcnt(0)" ::: "memory");
        const u32x4 hv = *(const LAS u32x4*)(hist + 4 * lane);
        const int tl = (int)(hv[0] + hv[1] + hv[2] + hv[3]);
        int inc = tl;
#pragma unroll
        for (int o = 1; o < 64; o <<= 1) { const int v = __shfl_down(inc, o); if (lane + o < 64) inc += v; }
        const int suf = inc - tl;
        const int s3 = suf + (int)hv[3], s2 = s3 + (int)hv[2], s1 = s2 + (int)hv[1], s0 = s1 + (int)hv[0];
        int digit = -1, above = 0;
        if (s3 >= rem && suf < rem) { digit = 4 * lane + 3; above = suf; }
        else if (s2 >= rem && s3 < rem) { digit = 4 * lane + 2; above = s3; }
        else if (s1 >= rem && s2 < rem) { digit = 4 * lane + 1; above = s2; }
        else if (s0 >= rem && s1 < rem) { digit = 4 * lane + 0; above = s1; }
        const unsigned long long bal = __ballot(digit >= 0);
        const int src = (int)__builtin_ctzll(bal | (1ull << 63));
        digit = __shfl(digit, src); above = __shfl(above, src);
        prefix |= (unsigned)digit << sh; mask |= 0xffu << sh; rem -= above;
    }
    int run = 0;
#pragma unroll
    for (int j = 0; j < 16; ++j) { const int i = j * 64 + lane; const bool keep = (i < n) && (k[j] >= prefix);
        const unsigned long long bal = __ballot(keep);
        const int pos = run + (int)__builtin_amdgcn_mbcnt_hi((unsigned)(bal >> 32), __builtin_amdgcn_mbcnt_lo((unsigned)bal, 0u));
        if (keep) list[pos] = k[j];
        run += (int)__builtin_popcountll(bal); }
    asm volatile("s_waitcnt lgkmcnt(0)" ::: "memory");
    return prefix;
}

__device__ __forceinline__ void dsa_item(const Ctx& C, int b, int qt) {
    const ArgsP Ap = C.a;
    const bf16_t* P = (const bf16_t*)(Ap->ws + WS_P); bf16_t* Y = (bf16_t*)(Ap->ws + WS_Y);
    const int lane = C.lane, w = C.wave, tid = C.tid, hl = lane >> 5, l32 = lane & 31;
    const int t0 = qt * 32;
    const size_t mb = (size_t)b * SEQ;
    LAS unsigned* cand = (LAS unsigned*)(C.lds) + w * 4 * DS_CAP;
    LAS unsigned* hist = (LAS unsigned*)(C.lds + DS_HIST) + w * 256;
    bf16x8 af[4];
    { const int rho = l32; const int qq = 2 * ((rho >> 2) & 1) + (rho >> 4), hd = (rho & 3) + 4 * ((rho >> 3) & 1);
      const bf16_t* src = P + (mb + t0 + 4 * w + qq) * NIN + PQI + hd * 64 + 8 * hl;
#pragma unroll
      for (int s = 0; s < 4; ++s) af[s] = *(const bf16x8*)(src + 16 * s); }
    float wA[8], wB[8];
    { const bf16_t* ra = P + (mb + t0 + 4 * w + 2 * hl) * NIN + PWI; const u32x4 va = *(const u32x4*)ra, vb = *(const u32x4*)(ra + NIN);
#pragma unroll
      for (int i = 0; i < 4; ++i) { wA[2 * i] = bflo(va[i]); wA[2 * i + 1] = bfhi(va[i]); wB[2 * i] = bflo(vb[i]); wB[2 * i + 1] = bfhi(vb[i]); } }
    const int tA = t0 + 4 * w + 2 * hl, tB = tA + 1;
    int cnt0 = 0, cnt1 = 0, cnt2 = 0, cnt3 = 0; unsigned th0 = 0u, th1 = 0u, th2 = 0u, th3 = 0u;
    const int NT = (t0 + 32 + 63) >> 6;
    const bf16_t* kisrc = P + (mb + (tid >> 3)) * NIN + PKI + 8 * (tid & 7);
    LAS unsigned char* kib = C.lds + DS_KI; const int kiw = (tid >> 3) * DS_KIROW + (tid & 7) * 16;
    __syncthreads();
    { const u32x4 v = *(const u32x4*)kisrc; *(LAS u32x4*)(kib + kiw) = v; }
    __syncthreads();
#pragma unroll 1
    for (int kt = 0; kt < NT; ++kt) {
        u32x4 nxt = (u32x4){0u, 0u, 0u, 0u};
        if (kt + 1 < NT) nxt = *(const u32x4*)(kisrc + (size_t)(kt + 1) * 64 * NIN);
        if (cnt0 > DS_CAP - 64) { th0 = wave_select256(cand + 0 * DS_CAP, cnt0, hist, lane); cnt0 = 256; }
        if (cnt1 > DS_CAP - 64) { th1 = wave_select256(cand + 1 * DS_CAP, cnt1, hist, lane); cnt1 = 256; }
        if (cnt2 > DS_CAP - 64) { th2 = wave_select256(cand + 2 * DS_CAP, cnt2, hist, lane); cnt2 = 256; }
        if (cnt3 > DS_CAP - 64) { th3 = wave_select256(cand + 3 * DS_CAP, cnt3, hist, lane); cnt3 = 256; }
        const LAS unsigned char* kb = kib + (kt & 1) * DS_KIBUF;
#pragma unroll
        for (int nt = 0; nt < 2; ++nt) {
            f32x16 c = {};
#pragma unroll
            for (int s = 0; s < 4; ++s) { const bf16x8 bfr = *(const LAS bf16x8*)(kb + (nt * 32 + l32) * DS_KIROW + (16 * s + 8 * hl) * 2);
                c = __builtin_amdgcn_mfma_f32_32x32x16_bf16(af[s], bfr, c, 0, 0, 0); }
            float sA = 0.f, sB = 0.f;
#pragma unroll
            for (int i = 0; i < 8; ++i) { sA = fmaf(fmaxf(c[i], 0.f), wA[i], sA); sB = fmaf(fmaxf(c[8 + i], 0.f), wB[i], sB); }
            const int sidx = kt * 64 + nt * 32 + l32;
            unsigned uA = __builtin_bit_cast(unsigned, sA), uB = __builtin_bit_cast(unsigned, sB);
            uA = (uA & 0x80000000u) ? ~uA : (uA | 0x80000000u); uB = (uB & 0x80000000u) ? ~uB : (uB | 0x80000000u);
            const unsigned keyA = (uA & 0xffffe000u) | (unsigned)(8191 - sidx), keyB = (uB & 0xffffe000u) | (unsigned)(8191 - sidx);
            const unsigned thA = hl ? th2 : th0, thB = hl ? th3 : th1;
            const bool pA = (sidx <= tA) && (keyA > thA), pB = (sidx <= tB) && (keyB > thB);
            { const unsigned long long bal = __ballot(pA); const unsigned lo = (unsigned)bal, hi = (unsigned)(bal >> 32);
              const int pos = hl ? (cnt2 + (int)__builtin_amdgcn_mbcnt_hi(hi, 0u)) : (cnt0 + (int)__builtin_amdgcn_mbcnt_lo(lo, 0u));
              if (pA) cand[(hl ? 2 : 0) * DS_CAP + pos] = keyA;
              cnt0 += __builtin_popcount(lo); cnt2 += __builtin_popcount(hi); }
            { const unsigned long long bal = __ballot(pB); const unsigned lo = (unsigned)bal, hi = (unsigned)(bal >> 32);
              const int pos = hl ? (cnt3 + (int)__builtin_amdgcn_mbcnt_hi(hi, 0u)) : (cnt1 + (int)__builtin_amdgcn_mbcnt_lo(lo, 0u));
              if (pB) cand[(hl ? 3 : 1) * DS_CAP + pos] = keyB;
              cnt1 += __builtin_popcount(lo); cnt3 += __builtin_popcount(hi); }
        }
        if (kt + 1 < NT) *(LAS u32x4*)(kib + ((kt + 1) & 1) * DS_KIBUF + kiw) = nxt;
        __syncthreads();
    }
    if (cnt0 > 256) { wave_select256(cand + 0 * DS_CAP, cnt0, hist, lane); cnt0 = 256; }
    if (cnt1 > 256) { wave_select256(cand + 1 * DS_CAP, cnt1, hist, lane); cnt1 = 256; }
    if (cnt2 > 256) { wave_select256(cand + 2 * DS_CAP, cnt2, hist, lane); cnt2 = 256; }
    if (cnt3 > 256) { wave_select256(cand + 3 * DS_CAP, cnt3, hist, lane); cnt3 = 256; }
    asm volatile("s_waitcnt lgkmcnt(0)" ::: "memory");
#pragma unroll 1
    for (int qq = 0; qq < 4; ++qq) {
        const int nsel = qq == 0 ? cnt0 : qq == 1 ? cnt1 : qq == 2 ? cnt2 : cnt3;
        const LAS unsigned* lst = cand + qq * DS_CAP;
        LAS f32x4* pb0 = (LAS f32x4*)(cand + qq * DS_CAP + 256);
        LAS f32x4* pb1 = (LAS f32x4*)(cand + (qq ^ 1) * DS_CAP + 256);
        const size_t mq = mb + t0 + 4 * w + qq;
        const bf16_t* qrow = P + mq * NIN + PQ;
#pragma unroll 1
        for (int g = 0; g < 2; ++g) {
            bf16x8 aq[2];
#pragma unroll
            for (int s = 0; s < 2; ++s) { aq[s] = (bf16x8){0, 0, 0, 0, 0, 0, 0, 0}; if ((lane & 15) < 4) aq[s] = *(const bf16x8*)(qrow + (4 * g + (lane & 15)) * 64 + 32 * s + 8 * (lane >> 4)); }
            f32x4 sc[16];
#pragma unroll
            for (int kt = 0; kt < 16; ++kt) {
                const int n = 16 * kt + (lane & 15);
                const int idx = (n < nsel) ? (8191 - (int)(lst[n] & 8191u)) : 0;
                const bf16_t* krow = P + (mb + idx) * NIN + PK + 64 * g + 8 * (lane >> 4);
                const bf16x8 k0 = *(const bf16x8*)krow, k1 = *(const bf16x8*)(krow + 32);
                f32x4 c = {0.f, 0.f, 0.f, 0.f};
                c = __builtin_amdgcn_mfma_f32_16x16x32_bf16(aq[0], k0, c, 0, 0, 0);
                c = __builtin_amdgcn_mfma_f32_16x16x32_bf16(aq[1], k1, c, 0, 0, 0);
                if (n >= nsel) c = (f32x4){-INFINITY, -INFINITY, -INFINITY, -INFINITY};
                sc[kt] = c;
            }
            f32x4 mx = sc[0];
#pragma unroll
            for (int kt = 1; kt < 16; ++kt) { mx[0] = fmaxf(mx[0], sc[kt][0]); mx[1] = fmaxf(mx[1], sc[kt][1]); mx[2] = fmaxf(mx[2], sc[kt][2]); mx[3] = fmaxf(mx[3], sc[kt][3]); }
#pragma unroll
            for (int o = 1; o < 16; o <<= 1) { mx[0] = fmaxf(mx[0], __shfl_xor(mx[0], o)); mx[1] = fmaxf(mx[1], __shfl_xor(mx[1], o)); mx[2] = fmaxf(mx[2], __shfl_xor(mx[2], o)); mx[3] = fmaxf(mx[3], __shfl_xor(mx[3], o)); }
            f32x4 sm = {0.f, 0.f, 0.f, 0.f};
#pragma unroll
            for (int kt = 0; kt < 16; ++kt) {
#pragma unroll
                for (int e = 0; e < 4; ++e) { const float p = __expf(sc[kt][e] - mx[e]); sc[kt][e] = p; sm[e] += p; } }
#pragma unroll
            for (int o = 1; o < 16; o <<= 1) { sm[0] += __shfl_xor(sm[0], o); sm[1] += __shfl_xor(sm[1], o); sm[2] += __shfl_xor(sm[2], o); sm[3] += __shfl_xor(sm[3], o); }
            const f32x4 inv = {1.f / sm[0], 1.f / sm[1], 1.f / sm[2], 1.f / sm[3]};
            if (lane < 16) {
#pragma unroll
                for (int kt = 0; kt < 16; ++kt) { const int n = 16 * kt + lane; const f32x4 pv = sc[kt] * inv;
                    if (kt < 12) pb0[n] = pv; else pb1[n - 192] = pv; }
            }
            asm volatile("s_waitcnt lgkmcnt(0)" ::: "memory");
            float o[4][2];
#pragma unroll
            for (int hh = 0; hh < 4; ++hh) { o[hh][0] = 0.f; o[hh][1] = 0.f; }
            const bf16_t* vbase = P + mb * NIN + PV + 64 * g + 2 * l32;
#pragma unroll 4
            for (int n = hl; n < nsel; n += 2) {
                const int idx = 8191 - (int)(lst[n] & 8191u);
                const unsigned v2 = *(const unsigned*)(vbase + (size_t)idx * NIN);
                const f32x4 pv = (n < 192) ? pb0[n] : pb1[n - 192];
                const float v0 = bflo(v2), v1 = bfhi(v2);
#pragma unroll
                for (int hh = 0; hh < 4; ++hh) { o[hh][0] += pv[hh] * v0; o[hh][1] += pv[hh] * v1; }
            }
#pragma unroll
            for (int hh = 0; hh < 4; ++hh) { o[hh][0] += __shfl_xor(o[hh][0], 32); o[hh][1] += __shfl_xor(o[hh][1], 32); }
            if (hl == 0) {
#pragma unroll
                for (int hh = 0; hh < 4; ++hh) *(unsigned*)(Y + mq * DM + (4 * g + hh) * 64 + 2 * l32) = pk2(o[hh][0], o[hh][1]);
            }
            asm volatile("s_waitcnt lgkmcnt(0)" ::: "memory");
        }
    }
}

__device__ __forceinline__ void mixers_phase(const Ctx& C, int l) {
    const ArgsP Ap = C.a;
    if (C.bid < 8) rwkv_block(C, l, C.bid);
    else if (C.bid < 16) gdn_block(C, l, C.bid - 8);
    unsigned* work = (unsigned*)(Ap->ws + WS_CTL) + CW_WORK + 64 * l;
    volatile LAS unsigned* misc = (volatile LAS unsigned*)(C.lds + LDS_MISC);
    for (;;) {
        __syncthreads();
        if (C.tid == 0) misc[0] = __hip_atomic_fetch_add(work, 1u, __ATOMIC_RELAXED, __HIP_MEMORY_SCOPE_AGENT);
        __syncthreads();
        const int it = (int)misc[0];
        if (it >= 512) break;
        dsa_item(C, it & 1, 255 - (it >> 1));
    }
    __syncthreads();
}

constexpr int NPHASE = 18;
__global__ void __launch_bounds__(512, 2) fwd_kernel(Args args_unused) {
    extern __shared__ __attribute__((aligned(16))) unsigned char lds_raw[];
    ArgsP ap0 = (ArgsP)__builtin_amdgcn_kernarg_segment_ptr();
    Ctx C; C.lds = (LAS unsigned char*)lds_raw; C.tid = threadIdx.x; C.lane = C.tid & 63; C.wave = __builtin_amdgcn_readfirstlane(C.tid >> 6); C.G = gridDim.x; C.bid = blockIdx.x; C.a = ap0;
    volatile LAS unsigned* misc = (volatile LAS unsigned*)(C.lds + LDS_MISC);
    if (C.tid < 64) misc[C.tid] = 0u;
    __syncthreads();
    const int ph_lo = ap0->ph_lo, ph_hi = ap0->ph_hi;
    XcdBarrier bar; bar.bar = (unsigned*)(ap0->ws + WS_CTL) + CW_BAR; bar.x = 0; bar.st = nullptr;
    const bool fused = (ph_hi - ph_lo) > 1;
    if (fused) bar = xcd_barrier_post((unsigned*)(ap0->ws + WS_CTL) + CW_BAR, misc + 8);
#ifndef PHASE_MASK
#define PHASE_MASK 0x3ff
#endif
#define PM(k) ((PHASE_MASK >> (k)) & 1)
    for (int ph = ph_lo; ph < ph_hi; ++ph) {
        { int t_ = threadIdx.x; asm volatile("" : "+v"(t_)); C.tid = t_; C.lane = t_ & 63; C.wave = __builtin_amdgcn_readfirstlane(t_ >> 6); }
        ArgsP ap = (ArgsP)__builtin_amdgcn_kernarg_segment_ptr(); asm volatile("" : "+s"(ap)); C.a = ap;
        unsigned char* ws = ap->ws; unsigned char* wb = ws + WS_W;
        bf16_t* XBF = (bf16_t*)(ws + WS_XBF); bf16_t* ACT = (bf16_t*)(ws + WS_ACT); bf16_t* PB = (bf16_t*)(ws + WS_P); bf16_t* YB = (bf16_t*)(ws + WS_Y);
        float* SSQA = (float*)(ws + WS_SSQ); float* SSQB = SSQA + (size_t)MTOK * 16; float* SSQC = SSQB + (size_t)MTOK * 16;
        if (ph == 0) { if (PM(9)) { convert_layer_weights(C, 0); prologue_x(C); } }
        else {
            const int l = (ph - 1) / 9, sp = (ph - 1) % 9;
            pg8::StaticOrder S;
            switch (sp) {
            case 0: if (PM(0)) { pg8::Gemm g{XBF, (const bf16_t*)(wb + W_GU1), MTOK, NGU, DM}; S.init(MTOK, NGU, C.G, C.bid); pg8::EpiFfnUp E{ACT, SSQA};
                      pg8::gemm_phase<pg8::EpiFfnUp, pg8::StaticOrder, true, true>(C.lds, g, S, E, C.tid); } break;
            case 1: if (PM(1)) { pg8::Gemm g{ACT, (const bf16_t*)(wb + W_D1), MTOK, DM, FF}; S.init(MTOK, DM, C.G, C.bid); pg8::EpiResid E{l == 0 ? ap->in[I_X] : ap->out, ap->out, XBF, SSQB, 0.5f};
                      pg8::gemm_phase<pg8::EpiResid, pg8::StaticOrder, true, true>(C.lds, g, S, E, C.tid); } break;
            case 2: if (PM(2)) { pg8::Gemm g{XBF, (const bf16_t*)(wb + W_IN), MTOK, NIN, DM}; S.init(MTOK, NIN, C.G, C.bid); pg8::EpiRowScaleBf16 E{PB, NIN, SSQB};
                      pg8::gemm_phase<pg8::EpiRowScaleBf16, pg8::StaticOrder, true, true>(C.lds, g, S, E, C.tid); } break;
            case 3: if (PM(3)) prep_phase(C, l); break;
            case 4: if (PM(4)) mixers_phase(C, l); break;
            case 5: if (PM(5)) { pg8::Gemm g{YB, (const bf16_t*)(wb + W_OUT), MTOK, DM, DM}; S.init(MTOK, DM, C.G, C.bid); pg8::EpiResid E{ap->out, ap->out, XBF, SSQC, 1.0f};
                      pg8::gemm_phase<pg8::EpiResid, pg8::StaticOrder, true, true>(C.lds, g, S, E, C.tid); } break;
            case 6: if (PM(6)) { pg8::Gemm g{XBF, (const bf16_t*)(wb + W_GU2), MTOK, NGU, DM}; S.init(MTOK, NGU, C.G, C.bid); pg8::EpiFfnUp E{ACT, SSQC};
                      pg8::gemm_phase<pg8::EpiFfnUp, pg8::StaticOrder, true, true>(C.lds, g, S, E, C.tid); } break;
            case 7: if (PM(7)) { pg8::Gemm g{ACT, (const bf16_t*)(wb + W_D2), MTOK, DM, FF}; S.init(MTOK, DM, C.G, C.bid); pg8::EpiResid E{ap->out, ap->out, XBF, SSQA, 0.5f};
                      pg8::gemm_phase<pg8::EpiResid, pg8::StaticOrder, true, true>(C.lds, g, S, E, C.tid); } break;
            case 8: if (PM(8)) convert_layer_weights(C, l + 1); break;
            }
        }
        if (ph + 1 < ph_hi) xcd_barrier(bar);
    }
}

extern "C" void kernel_launch(void* const* d_in, const int* in_sizes, int n_in, void* d_out, int out_size, void* d_ws, size_t ws_size, hipStream_t stream) {
    static int grid = 0;
    if (grid == 0) {
        if (n_in != 28 || out_size != MTOK * DM || ws_size < WS_END) { fprintf(stderr, "kernel_launch: unexpected shapes (n_in %d out %d ws %zu)\n", n_in, out_size, ws_size); grid = -1; return; }
        int dev = 0, cus = 0, per_cu = 0;
        if (hipGetDevice(&dev) != hipSuccess || hipDeviceGetAttribute(&cus, hipDeviceAttributeMultiprocessorCount, dev) != hipSuccess) { grid = -1; return; }
        if (hipFuncSetAttribute((const void*)fwd_kernel, hipFuncAttributeMaxDynamicSharedMemorySize, LDS_BYTES) != hipSuccess) { fprintf(stderr, "kernel_launch: hipFuncSetAttribute failed\n"); grid = -1; return; }
        if (hipOccupancyMaxActiveBlocksPerMultiprocessor(&per_cu, (const void*)fwd_kernel, 512, LDS_BYTES) != hipSuccess || per_cu < 1) { fprintf(stderr, "kernel_launch: occupancy query says %d\n", per_cu); per_cu = 1; }
        (void)hipGetLastError();
        grid = cus;
    }
    if (grid < 0) return;
    (void)hipMemsetAsync((char*)d_ws + WS_CTL, 0, CTL_ZERO_BYTES, stream);
    Args a{};
    for (int i = 0; i < 28; ++i) a.in[i] = (const float*)d_in[i];
    a.out = (float*)d_out; a.ws = (unsigned char*)d_ws;
#if MK_N_LAUNCHES == 1
    a.ph_lo = 0; a.ph_hi = NPHASE;
    void* kargs[] = {&a};
    hipError_t e = hipLaunchCooperativeKernel((const void*)fwd_kernel, dim3(grid), dim3(512), kargs, LDS_BYTES, stream);
    if (e != hipSuccess) fprintf(stderr, "kernel_launch: cooperative launch failed: %s\n", hipGetErrorString(e));
#else
    for (int ph = 0; ph < NPHASE; ++ph) { a.ph_lo = ph; a.ph_hi = ph + 1; hipLaunchKernelGGL(fwd_kernel, dim3(grid), dim3(512), LDS_BYTES, stream, a); }
#endif
}
```

```cpp
#include <hip/hip_runtime.h>
#include <cstdio>
#include <cstdint>

#ifndef MK_N_LAUNCHES
#define MK_N_LAUNCHES 1
#endif

#define LAS __attribute__((address_space(3)))
#define GAS __attribute__((address_space(1)))
typedef unsigned short bf16_t;
typedef short bf16x8 __attribute__((ext_vector_type(8)));
typedef float f32x4 __attribute__((ext_vector_type(4)));
typedef float f32x16 __attribute__((ext_vector_type(16)));
typedef float f32x2 __attribute__((ext_vector_type(2)));
typedef unsigned u32x4 __attribute__((ext_vector_type(4)));
typedef unsigned u32x2 __attribute__((ext_vector_type(2)));

constexpr int BATCH = 2, SEQ = 8192, DM = 1024, FF = 2816, MTOK = BATCH * SEQ;
constexpr int NGU = 2 * FF;
constexpr int NIN = 3328;
constexpr int PQ = 0, PK = 512, PV = 640, PQI = 768, PKI = 1280, PWI = 1344, PGB = 1352, PGA = 1356;
constexpr int PRW = 1408;
constexpr int PGD = 2304;
constexpr float NORM_EPS = 1e-6f;

constexpr size_t MiB = 1u << 20;
constexpr size_t WS_CTL = 0, CTL_ZERO_BYTES = 64 * 1024;
constexpr size_t WS_ROPE = 64 * 1024;
constexpr size_t WS_W = 3 * MiB;
constexpr size_t W_GU1 = 0, W_D1 = 11 * MiB, W_IN = W_D1 + 5632 * 1024, W_OUT = W_IN + (size_t)NIN * DM * 2, W_GU2 = W_OUT + 2 * MiB, W_D2 = W_GU2 + 11 * MiB, W_END = W_D2 + 5632 * 1024;
constexpr size_t WS_XBF = 45 * MiB;
constexpr size_t WS_BIG = 77 * MiB;
constexpr size_t WS_P = WS_BIG, WS_Y = WS_BIG + 104 * MiB, WS_ACT = WS_BIG;
constexpr size_t WS_SSQ = 213 * MiB;
constexpr size_t WS_VF = 216 * MiB;
constexpr size_t WS_END = 224 * MiB;
static_assert(W_END <= 42 * MiB && WS_W + W_END <= WS_XBF && WS_Y + 32 * MiB <= WS_SSQ, "ws map");

constexpr int CW_BAR = 1024;
constexpr int CW_WORK = 8192;

constexpr int LDS_MISC = 154 * 1024;
constexpr int LDS_BYTES = 155 * 1024;

__device__ __forceinline__ unsigned f2bf(float f) { unsigned u = __builtin_bit_cast(unsigned, f); return (u + 0x7fffu + ((u >> 16) & 1u)) >> 16; }
__device__ __forceinline__ unsigned pk2(float lo, float hi) { return f2bf(lo) | (f2bf(hi) << 16); }
__device__ __forceinline__ float bf2f(unsigned short h) { return __builtin_bit_cast(float, (unsigned)h << 16); }
__device__ __forceinline__ float bflo(unsigned w) { return __builtin_bit_cast(float, w << 16); }
__device__ __forceinline__ float bfhi(unsigned w) { return __builtin_bit_cast(float, w & 0xffff0000u); }
__device__ __forceinline__ float wave_sum(float v) {
#pragma unroll
    for (int o = 1; o < 64; o <<= 1) v += __shfl_xor(v, o);
    return v;
}
__device__ __forceinline__ float sigmoidf_(float x) { return 1.f / (1.f + __expf(-x)); }
__device__ __forceinline__ float siluf_(float x) { return x / (1.f + __expf(-x)); }
__device__ __forceinline__ float softplusf_(float x) { return x > 20.f ? x : log1pf(__expf(x)); }

namespace pg8 {
constexpr int BM = 256, BK = 64, HALF = 128, HTB = HALF * BK * 2, STAGE_BYTES = 8 * HTB, NXCD = 8, WGM = 8;
__host__ __device__ __forceinline__ int lds_byte(int r, int c) { const int st = (r >> 4) * 2 + (c >> 5), rr = r & 15, cc = c & 31, ob = rr * 64 + cc * 2; return st * 1024 + (ob ^ (((ob >> 9) & 1) << 5)); }
__host__ __device__ __forceinline__ void stage_rc(int b, int& R, int& C) { const int st = b / 1024, sb = b % 1024, swz = sb ^ (((sb >> 9) & 1) << 5); R = (st >> 1) * 16 + swz / 64; C = (st & 1) * 32 + (swz % 64) / 2; }
__host__ __device__ __forceinline__ int perm32(int rho) { const int n = rho >> 4, i = rho & 15; return 8 * (i >> 2) + 4 * n + (i & 3); }
struct Unit { int pm, pn; };
struct Gemm { const bf16_t* A; const bf16_t* Bt; int M, N, K; };
struct StaticOrder {
    int nM, nN, nwg, G, c;
    __host__ __device__ void init(int M, int N, int G_, int c_) { nM = M / BM; nN = N / BM; nwg = nM * nN; G = G_; c = c_; }
    __host__ __device__ bool next(int i, Unit& u) const {
        const long L = (long)i * G + c; if (L >= nwg) return false;
        int wgid = (int)L; { const int q = nwg / NXCD, r = nwg % NXCD, xcd = wgid % NXCD, off = wgid / NXCD; wgid = (xcd < r ? xcd * (q + 1) : r * (q + 1) + (xcd - r) * q) + off; }
        const int nig = WGM * nN, gid = wgid / nig, fm = gid * WGM, gsz = (nM - fm) < WGM ? (nM - fm) : WGM;
        u.pm = fm + ((wgid % nig) % gsz); u.pn = (wgid % nig) / gsz; return true;
    }
};
__device__ __forceinline__ unsigned cvt_pk_bf16(float lo, float hi) { unsigned r; asm volatile("v_cvt_pk_bf16_f32 %0, %1, %2" : "=v"(r) : "v"(lo), "v"(hi)); return r; }

__device__ __forceinline__ float row_rstd(const float* ssq, int row, int fq) {
    const f32x4 v = *(const f32x4*)(ssq + (size_t)row * 16 + 4 * fq);
    float s = (v[0] + v[1]) + (v[2] + v[3]);
    s += __shfl_xor(s, 16); s += __shfl_xor(s, 32);
    return rsqrtf(s * (1.0f / DM) + NORM_EPS);
}
struct EpiFfnUp {
    static constexpr bool PERM = true;
    bf16_t* O; const float* ssq;
    __device__ __forceinline__ void operator()(const f32x4 (&acc)[2][2][4][2], const Unit& u, int wr, int wc, int fr, int fq) const {
        const int row0 = u.pm * BM + wr * 64 + fr; const int col0 = u.pn * HALF + wc * 32 + 8 * fq;
#pragma unroll
        for (int ai = 0; ai < 2; ++ai)
#pragma unroll
            for (int m = 0; m < 4; ++m) { const int row = row0 + ai * HALF + m * 16; const float rs = row_rstd(ssq, row, fq);
                float o[8];
#pragma unroll
                for (int n = 0; n < 2; ++n)
#pragma unroll
                    for (int e = 0; e < 4; ++e) { const float g = acc[ai][0][m][n][e] * rs, up = acc[ai][1][m][n][e] * rs;
                        o[n * 4 + e] = g * __builtin_amdgcn_rcpf(1.f + __builtin_amdgcn_exp2f(-1.4426950408889634f * g)) * up; }
                u32x4 w; w.x = cvt_pk_bf16(o[0], o[1]); w.y = cvt_pk_bf16(o[2], o[3]); w.z = cvt_pk_bf16(o[4], o[5]); w.w = cvt_pk_bf16(o[6], o[7]);
                *(u32x4*)(O + (size_t)row * FF + col0) = w; asm volatile("" ::: "memory"); }
    }
};
struct EpiRowScaleBf16 {
    static constexpr bool PERM = true;
    bf16_t* O; int ldc; const float* ssq;
    __device__ __forceinline__ void operator()(const f32x4 (&acc)[2][2][4][2], const Unit& u, int wr, int wc, int fr, int fq) const {
        const int row0 = u.pm * BM + wr * 64 + fr; const int col0 = u.pn * BM + wc * 32 + 8 * fq;
#pragma unroll
        for (int ai = 0; ai < 2; ++ai)
#pragma unroll
            for (int m = 0; m < 4; ++m) { const int row = row0 + ai * HALF + m * 16; const float rs = row_rstd(ssq, row, fq);
#pragma unroll
                for (int bj = 0; bj < 2; ++bj) { const f32x4 v0 = acc[ai][bj][m][0] * rs, v1 = acc[ai][bj][m][1] * rs;
                    u32x4 w; w.x = cvt_pk_bf16(v0[0], v0[1]); w.y = cvt_pk_bf16(v0[2], v0[3]); w.z = cvt_pk_bf16(v1[0], v1[1]); w.w = cvt_pk_bf16(v1[2], v1[3]);
                    *(u32x4*)(O + (size_t)row * ldc + col0 + bj * HALF) = w; } asm volatile("" ::: "memory"); }
    }
};
struct EpiResid {
    static constexpr bool PERM = false;
    const float* xin; float* xout; bf16_t* xbf; float* ssq; float alpha;
    __device__ __forceinline__ void operator()(const f32x4 (&acc)[2][2][4][2], const Unit& u, int wr, int wc, int fr, int fq) const {
        const int row0 = u.pm * BM + wr * 64 + fr; const int col0 = u.pn * BM + wc * 32 + 4 * fq;
#pragma unroll
        for (int ai = 0; ai < 2; ++ai)
#pragma unroll
            for (int m = 0; m < 4; ++m) { const int row = row0 + ai * HALF + m * 16; const size_t off = (size_t)row * DM + col0; float s = 0.f;
#pragma unroll
                for (int bj = 0; bj < 2; ++bj)
#pragma unroll
                    for (int n = 0; n < 2; ++n) { const size_t o2 = off + bj * HALF + n * 16; const f32x4 xi = *(const f32x4*)(xin + o2); const f32x4 v = xi + acc[ai][bj][m][n] * alpha;
                        *(f32x4*)(xout + o2) = v; u32x2 w; w.x = cvt_pk_bf16(v[0], v[1]); w.y = cvt_pk_bf16(v[2], v[3]); *(u32x2*)(xbf + o2) = w;
                        s += (v[0] * v[0] + v[1] * v[1]) + (v[2] * v[2] + v[3] * v[3]); }
                s += __shfl_xor(s, 16); s += __shfl_xor(s, 32);
                if (fq == 0) ssq[(size_t)row * 16 + u.pn * 4 + wc] = s; }
    }
};

template <class Epi, class Sched, bool ALIGN_EPI = false, bool SP2 = false>
__device__ __forceinline__ void gemm_phase(LAS unsigned char* lds, const Gemm g, const Sched& S, const Epi& E, const int tid) {
    const int wid = __builtin_amdgcn_readfirstlane(tid >> 6), lane = tid & 63, wr = wid >> 2, wc = wid & 3, fr = lane & 15, fq = lane >> 4;
    const int K = g.K, nt = K / BK;
    unsigned voffA[2], voffB[2];
#pragma unroll
    for (int i = 0; i < 2; ++i) { int R, C; stage_rc(tid * 16 + i * 8192, R, C); const int Rb = Epi::PERM ? ((R & ~31) + perm32(R & 31)) : R;
        voffA[i] = (unsigned)(R * K + C) * 2u; voffB[i] = (unsigned)(Rb * K + C) * 2u; }
    const size_t kstep = (size_t)(BK * 2);
    const size_t hstep = (size_t)HALF * K * 2;
    const size_t tstep = 2 * hstep;
    const unsigned ldsw = (unsigned)wid * 1024u;
    const int aoff = lds_byte(wr * 64 + fr, fq * 8), boff = lds_byte(wc * 32 + fr, fq * 8);
#define PG8_SA(b, h) (((b) * 2 + (h)) * HTB)
#define PG8_SB(b, h) ((4 + (b) * 2 + (h)) * HTB)
#define PG8_STAGE(bufoff, gbase, voff) do { _Pragma("unroll") for (int _i = 0; _i < 2; ++_i) \
        __builtin_amdgcn_global_load_lds((const unsigned*)((const char*)(gbase) + (voff)[_i]), (LAS unsigned*)(lds + (bufoff) + ldsw + _i * 8192), 16, 0, 0); } while (0)
#define PG8_LDA(dst, b, h) do { _Pragma("unroll") for (int m = 0; m < 4; ++m) _Pragma("unroll") for (int k = 0; k < 2; ++k) dst[m][k] = *(const LAS bf16x8*)(lds + PG8_SA(b, h) + aoff + m * 2048 + k * 1024); } while (0)
#define PG8_LDB(dst, b, h) do { _Pragma("unroll") for (int n = 0; n < 2; ++n) _Pragma("unroll") for (int k = 0; k < 2; ++k) dst[n][k] = *(const LAS bf16x8*)(lds + PG8_SB(b, h) + boff + n * 2048 + k * 1024); } while (0)
#define PG8_MMA(ai, bj, At, Bt) do { __builtin_amdgcn_s_setprio(1); _Pragma("unroll") for (int m = 0; m < 4; ++m) _Pragma("unroll") for (int n = 0; n < 2; ++n) _Pragma("unroll") for (int k = 0; k < 2; ++k) \
        acc[ai][bj][m][n] = __builtin_amdgcn_mfma_f32_16x16x32_bf16(Bt[n][k], At[m][k], acc[ai][bj][m][n], 0, 0, 0); __builtin_amdgcn_s_setprio(0); } while (0)
#define PG8_WAIT_V(n) asm volatile("s_waitcnt vmcnt(" #n ")" ::: "memory")
#define PG8_WAIT_L(n) asm volatile("s_waitcnt lgkmcnt(" #n ")" ::: "memory")
#define PG8_BAR __builtin_amdgcn_s_barrier()
#define PG8_SCHED __builtin_amdgcn_sched_barrier(0)
    Unit cur, nxt; int ui = 0;
    if (!S.next(0, cur)) return;
    f32x4 acc[2][2][4][2];
#pragma unroll
    for (int a = 0; a < 2; ++a)
#pragma unroll
        for (int b = 0; b < 2; ++b)
#pragma unroll
            for (int m = 0; m < 4; ++m)
#pragma unroll
                for (int n = 0; n < 2; ++n) acc[a][b][m][n] = (f32x4){0.f, 0.f, 0.f, 0.f};
    bf16x8 At[4][2], B0[2][2], B1[2][2];
    const char* cA = (const char*)g.A + (size_t)cur.pm * tstep; const char* cB = (const char*)g.Bt + (size_t)cur.pn * tstep;
    if constexpr (SP2) {
        PG8_STAGE(PG8_SB(0, 0), cB, voffB); PG8_STAGE(PG8_SB(0, 1), cB + hstep, voffB); PG8_STAGE(PG8_SA(0, 0), cA, voffA); PG8_STAGE(PG8_SA(0, 1), cA + hstep, voffA);
        if (wr == 1) PG8_BAR;
        PG8_WAIT_V(2); PG8_BAR;
        PG8_STAGE(PG8_SB(1, 0), cB + kstep, voffB); PG8_STAGE(PG8_SA(1, 0), cA + kstep, voffA); PG8_STAGE(PG8_SB(1, 1), cB + hstep + kstep, voffB);
        PG8_WAIT_V(6); PG8_BAR;
    } else {
        PG8_STAGE(PG8_SB(0, 0), cB, voffB); PG8_STAGE(PG8_SA(0, 0), cA, voffA); PG8_STAGE(PG8_SB(0, 1), cB + hstep, voffB); PG8_STAGE(PG8_SA(0, 1), cA + hstep, voffA);
        if (wr == 1) PG8_BAR;
        PG8_WAIT_V(4); PG8_BAR;
        PG8_STAGE(PG8_SB(1, 0), cB + kstep, voffB); PG8_STAGE(PG8_SA(1, 0), cA + kstep, voffA); PG8_STAGE(PG8_SB(1, 1), cB + hstep + kstep, voffB);
        PG8_WAIT_V(6); PG8_BAR;
    }
    for (;;) {
        const bool has_next = S.next(ui + 1, nxt);
        const char* nA = has_next ? (const char*)g.A + (size_t)nxt.pm * tstep : cA; const char* nB = has_next ? (const char*)g.Bt + (size_t)nxt.pn * tstep : cB;
        for (int t = 0; t < nt; t += 2) {
            const bool last = (t == nt - 2);
            const char* a1 = cA + (size_t)(t + 1) * kstep;
            const char* a2 = last ? nA : cA + (size_t)(t + 2) * kstep; const char* b2 = last ? nB : cB + (size_t)(t + 2) * kstep;
            const char* a3 = a2 + kstep; const char* b3 = b2 + kstep;
            if constexpr (SP2) {
            PG8_LDB(B0, 0, 0); PG8_LDB(B1, 0, 1); PG8_SCHED; PG8_LDA(At, 0, 0); PG8_STAGE(PG8_SA(1, 1), a1 + hstep, voffA);
            PG8_WAIT_V(8); PG8_WAIT_L(0); PG8_BAR; PG8_MMA(0, 0, At, B0); PG8_MMA(0, 1, At, B1); PG8_BAR; PG8_SCHED;
            PG8_LDA(At, 0, 1); PG8_STAGE(PG8_SB(0, 0), b2, voffB); PG8_STAGE(PG8_SB(0, 1), b2 + hstep, voffB); PG8_STAGE(PG8_SA(0, 0), a2, voffA);
            PG8_WAIT_V(8); PG8_WAIT_L(0); PG8_BAR; PG8_MMA(1, 0, At, B0); PG8_MMA(1, 1, At, B1); PG8_BAR; PG8_SCHED;
            PG8_LDB(B0, 1, 0); PG8_LDB(B1, 1, 1); PG8_SCHED; PG8_LDA(At, 1, 0); PG8_STAGE(PG8_SA(0, 1), a2 + hstep, voffA);
            PG8_WAIT_V(8); PG8_WAIT_L(0); PG8_BAR; PG8_MMA(0, 0, At, B0); PG8_MMA(0, 1, At, B1); PG8_BAR; PG8_SCHED;
            PG8_LDA(At, 1, 1); PG8_STAGE(PG8_SB(1, 0), b3, voffB); PG8_STAGE(PG8_SB(1, 1), b3 + hstep, voffB); PG8_STAGE(PG8_SA(1, 0), a3, voffA);
            PG8_WAIT_V(8); PG8_WAIT_L(0); PG8_BAR; PG8_MMA(1, 0, At, B0); PG8_MMA(1, 1, At, B1); PG8_BAR; PG8_SCHED;
            } else {
            PG8_LDB(B0, 0, 0); PG8_SCHED; PG8_LDA(At, 0, 0); PG8_STAGE(PG8_SA(1, 1), a1 + hstep, voffA);
            PG8_WAIT_L(8); PG8_BAR; PG8_WAIT_L(0); PG8_MMA(0, 0, At, B0); PG8_BAR; PG8_SCHED;
            PG8_LDB(B1, 0, 1); PG8_STAGE(PG8_SB(0, 0), b2, voffB);
            PG8_BAR; PG8_WAIT_L(0); PG8_MMA(0, 1, At, B1); PG8_BAR;
            PG8_LDA(At, 0, 1); PG8_STAGE(PG8_SA(0, 0), a2, voffA);
            PG8_BAR; PG8_WAIT_L(0); PG8_MMA(1, 0, At, B0); PG8_BAR; PG8_SCHED;
            PG8_STAGE(PG8_SB(0, 1), b2 + hstep, voffB);
            PG8_WAIT_V(6); PG8_BAR; PG8_MMA(1, 1, At, B1); PG8_BAR;
            PG8_LDB(B0, 1, 0); PG8_SCHED; PG8_LDA(At, 1, 0); PG8_STAGE(PG8_SA(0, 1), a2 + hstep, voffA);
            PG8_WAIT_L(8); PG8_BAR; PG8_WAIT_L(0); PG8_MMA(0, 0, At, B0); PG8_BAR; PG8_SCHED;
            PG8_LDB(B1, 1, 1); PG8_STAGE(PG8_SB(1, 0), b3, voffB);
            PG8_BAR; PG8_WAIT_L(0); PG8_MMA(0, 1, At, B1); PG8_BAR;
            PG8_LDA(At, 1, 1); PG8_STAGE(PG8_SA(1, 0), a3, voffA);
            PG8_BAR; PG8_WAIT_L(0); PG8_MMA(1, 0, At, B0); PG8_BAR; PG8_SCHED;
            PG8_STAGE(PG8_SB(1, 1), b3 + hstep, voffB);
            PG8_WAIT_V(6); PG8_BAR; PG8_MMA(1, 1, At, B1); PG8_BAR;
            }
        }
        if constexpr (ALIGN_EPI) { if (wr == 0) PG8_BAR; }
        E(acc, cur, wr, wc, fr, fq);
        if (!has_next) break;
#pragma unroll
        for (int a = 0; a < 2; ++a)
#pragma unroll
            for (int b = 0; b < 2; ++b)
#pragma unroll
                for (int m = 0; m < 4; ++m)
#pragma unroll
                    for (int n = 0; n < 2; ++n) acc[a][b][m][n] = (f32x4){0.f, 0.f, 0.f, 0.f};
        cur = nxt; cA = nA; cB = nB; ++ui;
        if constexpr (ALIGN_EPI) { if (wr == 1) PG8_BAR; }
    }
    PG8_WAIT_V(0);
    if constexpr (!ALIGN_EPI) { if (wr == 0) PG8_BAR; }
    PG8_BAR;
#undef PG8_SA
#undef PG8_SB
#undef PG8_STAGE
#undef PG8_LDA
#undef PG8_LDB
#undef PG8_MMA
#undef PG8_WAIT_V
#undef PG8_WAIT_L
#undef PG8_BAR
#undef PG8_SCHED
}
}

#define XB_TMO      128
#define XB_XCNT(j)  (256  + 64 * (j))
#define XB_XSUB(j)  (1280 + 64 * (j))
#define XB_XGEN(j)  (2304 + 64 * (j))
#define XB_TOP      3328
#define XB_TOPGEN   3392
#define XCD_BAR_WORDS 3456
#define XB_SPIN_CAP (1u << 20)
__device__ __forceinline__ unsigned xb_ld(unsigned* p)              { return __hip_atomic_load(p, __ATOMIC_RELAXED, __HIP_MEMORY_SCOPE_AGENT); }
__device__ __forceinline__ unsigned xb_add(unsigned* p, unsigned v) { return __hip_atomic_fetch_add(p, v, __ATOMIC_RELAXED, __HIP_MEMORY_SCOPE_AGENT); }
__device__ __forceinline__ unsigned xb_xcc_id() { return (unsigned)__builtin_amdgcn_s_getreg((3 << 11) | 20) & 0xFu; }
#define XB_SPIN(cond, bar) do { unsigned _sp = 0; while (cond) { __builtin_amdgcn_s_sleep(1); \
    if ((++_sp & 255u) == 0u) { if (xb_ld(&(bar)[XB_TMO])) break; if (_sp > XB_SPIN_CAP) { atomicAdd(&(bar)[XB_TMO], 1u); break; } } } } while (0)
struct XcdBarrier { unsigned* bar; unsigned x; volatile LAS unsigned* st; };
__device__ __forceinline__ XcdBarrier xcd_barrier_post(unsigned* bar, volatile LAS unsigned* st) {
    XcdBarrier b; b.bar = bar; b.x = xb_xcc_id(); b.st = st;
    if (threadIdx.x == 0) (void)xb_add(&bar[XB_XCNT(b.x)], 1u);
    return b;
}
__device__ __forceinline__ void xcd_barrier_complete(unsigned* bar, unsigned x, unsigned& nloc, unsigned& nx) {
    const unsigned G = gridDim.x * gridDim.y * gridDim.z;
    unsigned sum, cnt, mine, sp = 0u;
    for (;;) {
        sum = 0u; cnt = 0u; mine = 0u;
#pragma unroll
        for (unsigned j = 0; j < 16; ++j) { const unsigned c = xb_ld(&bar[XB_XCNT(j)]); sum += c; cnt += (c > 0u) ? 1u : 0u; mine = (j == x) ? c : mine; }
        if (sum == G) break;
        __builtin_amdgcn_s_sleep(1);
        if ((++sp & 255u) == 0u) { if (xb_ld(&bar[XB_TMO])) break; if (sp > XB_SPIN_CAP) { atomicAdd(&bar[XB_TMO], 1u); break; } }
    }
    nloc = mine > 0u ? mine : 1u; nx = cnt > 0u ? cnt : 1u;
}
__device__ __forceinline__ void xcd_barrier(const XcdBarrier& b) {
    asm volatile("s_waitcnt vmcnt(0)" ::: "memory");
    __syncthreads();
    if (threadIdx.x == 0) {
        unsigned* bar = b.bar;
        __builtin_amdgcn_s_waitcnt(0);
        unsigned nloc = b.st[0], nx = b.st[1];
        if (nloc == 0u) { xcd_barrier_complete(bar, b.x, nloc, nx); b.st[0] = nloc; b.st[1] = nx; }
        const unsigned old = xb_add(&bar[XB_XSUB(b.x)], 1u);
        const unsigned gen = old / nloc;
        if (old + 1u == (gen + 1u) * nloc) {
            __builtin_amdgcn_fence(__ATOMIC_RELEASE, "agent");
            asm volatile("s_waitcnt vmcnt(0)" ::: "memory");
            const unsigned og = xb_add(&bar[XB_TOP], 1u);
            const unsigned tg = og / nx;
            if (og + 1u == (tg + 1u) * nx) xb_add(&bar[XB_TOPGEN], 1u);
            else XB_SPIN(xb_ld(&bar[XB_TOPGEN]) == tg, bar);
            __builtin_amdgcn_fence(__ATOMIC_ACQUIRE, "agent");
            xb_add(&bar[XB_XGEN(b.x)], 1u);
            asm volatile("s_waitcnt vmcnt(0)" ::: "memory");
        } else {
            XB_SPIN(xb_ld(&bar[XB_XGEN(b.x)]) == gen, bar);
            __builtin_amdgcn_fence(__ATOMIC_ACQUIRE, "agent");
            asm volatile("s_waitcnt vmcnt(0)" ::: "memory");
        }
    }
    __syncthreads();
}

struct Args { const float* in[28]; float* out; unsigned char* ws; int ph_lo, ph_hi; };
enum { I_X = 0, I_FFN_NORM, I_WG, I_WU, I_WD, I_MIX_NORM, I_WIN, I_WOUT, I_QN, I_KN, I_MU, I_W0, I_WUP, I_A0, I_AUP, I_GUP, I_KK, I_KA, I_RK, I_GNW, I_GNB, I_V0, I_VDOWN, I_VUP, I_CONV, I_ALOG, I_DTB, I_ONORM };

typedef const __attribute__((address_space(4))) Args* ArgsP;
struct Ctx {
    LAS unsigned char* lds;
    int tid, lane, wave, G, bid;
    ArgsP a;
};

template <class Get>
__device__ __forceinline__ void cvt_item(Get get, int K, bf16_t* WT, LAS float* scr, int kb, int nb, int lane) {
    const int k0 = 64 * kb, n0 = 32 * nb;
#pragma unroll 8
    for (int i = 0; i < 32; ++i) { const int kk = 2 * i + (lane >> 5); scr[kk * 33 + (lane & 31)] = get(k0 + kk, n0 + (lane & 31)); }
    asm volatile("s_waitcnt lgkmcnt(0)" ::: "memory");
    const int c = lane & 7;
#pragma unroll
    for (int j = 0; j < 4; ++j) { const int n = (lane >> 3) + 8 * j; const LAS float* s = scr + (8 * c) * 33 + n;
        u32x4 o; o.x = pk2(s[0 * 33], s[1 * 33]); o.y = pk2(s[2 * 33], s[3 * 33]); o.z = pk2(s[4 * 33], s[5 * 33]); o.w = pk2(s[6 * 33], s[7 * 33]);
        *(u32x4*)(WT + (size_t)(n0 + n) * K + k0 + 8 * c) = o; }
    asm volatile("s_waitcnt lgkmcnt(0)" ::: "memory");
}
__device__ __forceinline__ int win_cmap(int nn) {
    if (nn < 1352) return nn;
    if (nn < 1356) return 3272 + (nn - 1352);
    if (nn < 1360) return 3276 + (nn - 1356);
    if (nn < 1408) return -1;
    if (nn < 2304) return 1352 + (nn - 1408);
    return 2248 + (nn - 2304);
}
__device__ __forceinline__ void convert_layer_weights(const Ctx& C, int l) {
    const ArgsP Ap = C.a;
    LAS float* scr = (LAS float*)(C.lds + C.wave * 16384);
    unsigned char* wb = Ap->ws + WS_W;
    const int gw = C.bid * 8 + C.wave, NGW = C.G * 8;
    constexpr int I_GU = (DM / 64) * (NGU / 32), I_D = (FF / 64) * (DM / 32), I_IN = (DM / 64) * (NIN / 32), I_OUT = (DM / 64) * (DM / 32);
    constexpr int NIT = 2 * I_GU + 2 * I_D + I_IN + I_OUT;
    for (int it = gw; it < NIT; it += NGW) {
        int r = it;
        if (r < 2 * I_GU) { const int f = r / I_GU; r -= f * I_GU; const int nblk = NGU / 32, kb = r / nblk, nb = r % nblk;
            const float* wg = Ap->in[I_WG] + (size_t)(l * 2 + f) * DM * FF; const float* wu = Ap->in[I_WU] + (size_t)(l * 2 + f) * DM * FF; const float* gv = Ap->in[I_FFN_NORM] + (size_t)(l * 2 + f) * DM;
            auto get = [=](int k, int nn) -> float { const int pn = nn >> 8, bj = (nn >> 7) & 1, j = nn & 127; const float* w = bj ? wu : wg; return w[(size_t)k * FF + pn * 128 + j] * gv[k]; };
            cvt_item(get, DM, (bf16_t*)(wb + (f ? W_GU2 : W_GU1)), scr, kb, nb, C.lane); continue; }
        r -= 2 * I_GU;
        if (r < 2 * I_D) { const int f = r / I_D; r -= f * I_D; const int nblk = DM / 32, kb = r / nblk, nb = r % nblk;
            const float* wd = Ap->in[I_WD] + (size_t)(l * 2 + f) * FF * DM;
            auto get = [=](int k, int nn) -> float { return wd[(size_t)k * DM + nn]; };
            cvt_item(get, FF, (bf16_t*)(wb + (f ? W_D2 : W_D1)), scr, kb, nb, C.lane); continue; }
        r -= 2 * I_D;
        if (r < I_IN) { const int nblk = NIN / 32, kb = r / nblk, nb = r % nblk;
            const float* wi = Ap->in[I_WIN] + (size_t)l * DM * 3280; const float* gv = Ap->in[I_MIX_NORM] + (size_t)l * DM;
            auto get = [=](int k, int nn) -> float { const int c = win_cmap(nn); return c < 0 ? 0.f : wi[(size_t)k * 3280 + c] * gv[k]; };
            cvt_item(get, DM, (bf16_t*)(wb + W_IN), scr, kb, nb, C.lane); continue; }
        r -= I_IN;
        { const int nblk = DM / 32, kb = r / nblk, nb = r % nblk;
            const float* wo = Ap->in[I_WOUT] + (size_t)l * DM * DM;
            auto get = [=](int k, int nn) -> float { return wo[(size_t)k * DM + nn]; };
            cvt_item(get, DM, (bf16_t*)(wb + W_OUT), scr, kb, nb, C.lane); }
    }
}

__device__ const float ROPE_INV_HI[32] = {1.000000000e+00f, 7.498942018e-01f, 5.623413324e-01f, 4.216965139e-01f, 3.162277639e-01f, 2.371373773e-01f, 1.778279394e-01f, 1.333521456e-01f, 1.000000015e-01f, 7.498942316e-02f, 5.623413250e-02f, 4.216964915e-02f, 3.162277490e-02f, 2.371373773e-02f, 1.778279431e-02f, 1.333521400e-02f, 9.999999776e-03f, 7.498942316e-03f, 5.623413250e-03f, 4.216964822e-03f, 3.162277630e-03f, 2.371373819e-03f, 1.778279431e-03f, 1.333521446e-03f, 1.000000047e-03f, 7.498941850e-04f, 5.623413017e-04f, 4.216965172e-04f, 3.162277571e-04f, 2.371373703e-04f, 1.778279402e-04f, 1.333521504e-04f};
__device__ const float ROPE_INV_LO[32] = {0.000000000e+00f, 7.576931971e-09f, -7.245258615e-09f, -1.046263787e-08f, 2.125617904e-09f, -6.695950017e-09f, 1.612756151e-09f, -2.336302707e-09f, -1.490116142e-09f, -2.222539042e-09f, 2.053218012e-11f, 1.188910415e-09f, 1.702677888e-09f, -6.695949906e-10f, -2.112534175e-10f, 3.251632574e-10f, 2.235174129e-10f, -2.222539097e-10f, 2.053217839e-12f, 2.120233017e-10f, 3.056940465e-11f, -1.135256264e-10f, -2.112534106e-11f, -1.404980212e-11f, -4.749745042e-11f, 2.434073776e-11f, 2.348838658e-11f, -1.372226725e-11f, 8.877706729e-12f, 2.889693693e-13f, 7.978488746e-13f, -7.225746477e-12f};
__device__ __forceinline__ void prologue_x(const Ctx& C) {
    const ArgsP Ap = C.a;
    const float* x = Ap->in[I_X]; bf16_t* xbf = (bf16_t*)(Ap->ws + WS_XBF); float* ssq = (float*)(Ap->ws + WS_SSQ);
    const int gw = C.bid * 8 + C.wave, NGW = C.G * 8;
    for (int m = gw; m < MTOK; m += NGW) {
        const f32x4* xr = (const f32x4*)(x + (size_t)m * DM) + C.lane;
        f32x4 v[4]; float s = 0.f;
#pragma unroll
        for (int j = 0; j < 4; ++j) { v[j] = xr[64 * j]; s += (v[j][0] * v[j][0] + v[j][1] * v[j][1]) + (v[j][2] * v[j][2] + v[j][3] * v[j][3]); }
        s = wave_sum(s);
        u32x2* o8 = (u32x2*)(xbf + (size_t)m * DM) + C.lane;
#pragma unroll
        for (int j = 0; j < 4; ++j) { u32x2 w; w.x = pk2(v[j][0], v[j][1]); w.y = pk2(v[j][2], v[j][3]); o8[64 * j] = w; }
        if (C.lane < 16) ssq[(size_t)m * 16 + C.lane] = (C.lane == 0) ? s : 0.f;
    }
    f32x2* cs = (f32x2*)(Ap->ws + WS_ROPE);
    const int gt = C.bid * 512 + C.tid, NT = C.G * 512;
    for (int e = gt; e < SEQ * 32; e += NT) {
        const int pos = e >> 5, i = e & 31;
        const float fpos = (float)pos, ih = ROPE_INV_HI[i], il = ROPE_INV_LO[i];
        const float ph = fpos * ih; const float pe = fmaf(fpos, ih, -ph) + fpos * il;
        const float k = rintf(ph * 0.15915494309189535f);
        float r = fmaf(-k, 6.2831854820251465f, ph); r = fmaf(-k, -1.7484555e-07f, r); r += pe;
        const float r2 = r * r;
        float ts = 1.f, tc = 1.f;
        ts = 1.f - ts * r2 * (1.f / (18.f * 19.f)); ts = 1.f - ts * r2 * (1.f / (16.f * 17.f)); ts = 1.f - ts * r2 * (1.f / (14.f * 15.f)); ts = 1.f - ts * r2 * (1.f / (12.f * 13.f));
        ts = 1.f - ts * r2 * (1.f / (10.f * 11.f)); ts = 1.f - ts * r2 * (1.f / (8.f * 9.f)); ts = 1.f - ts * r2 * (1.f / (6.f * 7.f)); ts = 1.f - ts * r2 * (1.f / (4.f * 5.f)); ts = 1.f - ts * r2 * (1.f / (2.f * 3.f));
        tc = 1.f - tc * r2 * (1.f / (19.f * 20.f)); tc = 1.f - tc * r2 * (1.f / (17.f * 18.f)); tc = 1.f - tc * r2 * (1.f / (15.f * 16.f)); tc = 1.f - tc * r2 * (1.f / (13.f * 14.f)); tc = 1.f - tc * r2 * (1.f / (11.f * 12.f));
        tc = 1.f - tc * r2 * (1.f / (9.f * 10.f)); tc = 1.f - tc * r2 * (1.f / (7.f * 8.f)); tc = 1.f - tc * r2 * (1.f / (5.f * 6.f)); tc = 1.f - tc * r2 * (1.f / (3.f * 4.f)); tc = 1.f - tc * r2 * (1.f / (1.f * 2.f));
        cs[e] = (f32x2){tc, ts * r};
    }
}

__device__ __forceinline__ void prep_phase(const Ctx& C, int l) {
    const ArgsP Ap = C.a;
    bf16_t* P = (bf16_t*)(Ap->ws + WS_P);
    const f32x2* cs = (const f32x2*)(Ap->ws + WS_ROPE);
    const float* qn = Ap->in[I_QN] + l * 64; const float* kn = Ap->in[I_KN] + l * 64;
    {
        const int gw = C.bid * 8 + C.wave, NGW = C.G * 8; const int hl = C.lane >> 5, i = C.lane & 31;
        for (int m = gw; m < MTOK; m += NGW) {
            const int pos = m & (SEQ - 1); const f32x2 c = cs[pos * 32 + i];
            bf16_t* row = P + (size_t)m * NIN;
#pragma unroll 1
            for (int hp = 0; hp < 10; ++hp) {
                const int hd = hp * 2 + hl; if (hd >= 19) continue;
                int col; const float* nw = nullptr; float sc = 1.f;
                if (hd < 8) { col = PQ + hd * 64; nw = qn; sc = 0.125f; } else if (hd < 10) { col = PK + (hd - 8) * 64; nw = kn; } else if (hd < 18) { col = PQI + (hd - 10) * 64; } else { col = PKI; }
                float x1 = bf2f(row[col + i]), x2 = bf2f(row[col + 32 + i]);
                if (nw) { float ss = x1 * x1 + x2 * x2;
#pragma unroll
                    for (int o = 1; o < 32; o <<= 1) ss += __shfl_xor(ss, o);
                    const float rs = rsqrtf(ss * (1.f / 64.f) + NORM_EPS) * sc; x1 = x1 * rs * nw[i]; x2 = x2 * rs * nw[i + 32]; }
                const float o1 = x1 * c[0] - x2 * c[1], o2 = x2 * c[0] + x1 * c[1];
                row[col + i] = (bf16_t)f2bf(o1); row[col + 32 + i] = (bf16_t)f2bf(o2);
            }
        }
    }
    {
        bf16_t* LO = (bf16_t*)(Ap->ws + WS_XBF);
        LAS float* in128 = (LAS float*)C.lds;
        LAS float* vt = (LAS float*)(C.lds + 32768);
        LAS float* vd = (LAS float*)(C.lds + 32768 + 65536);
        const float* mu = Ap->in[I_MU] + l * 896;
        const int c0 = C.tid & 255, half = C.tid >> 8;
        for (int tile = C.bid; tile < MTOK / 64; tile += C.G) {
            const int m0 = tile * 64;
            int c = c0; asm volatile("" : "+v"(c));
            __syncthreads();
            for (int e = C.tid; e < 64 * 128; e += 512) { const int t = e >> 7, j = e & 127; const int m = m0 + t; const bf16_t* row = P + (size_t)m * NIN + PRW + 768;
                const float cur = bf2f(row[j]); const float prev = (m & (SEQ - 1)) ? bf2f(row[j - NIN]) : 0.f; float h = cur + (prev - cur) * mu[768 + j];
                if (j < 32) h = tanhf(h); else if (j >= 64) h = sigmoidf_(h);
                in128[e] = h; }
            if (l > 0) {
                for (int e = C.tid; e < 64 * 256; e += 512) { const int t = e >> 8, j = e & 255; const int m = m0 + t; const bf16_t* row = P + (size_t)m * NIN + PRW + 512;
                    const float cur = bf2f(row[j]); const float prev = (m & (SEQ - 1)) ? bf2f(row[j - NIN]) : 0.f; vt[e] = cur + (prev - cur) * mu[512 + j]; }
                __syncthreads();
                const float* vdn = Ap->in[I_VDOWN] + (size_t)(l - 1) * 256 * 32;
                for (int e = C.tid; e < 64 * 32; e += 512) { const int t = e >> 5, j = e & 31; float s = 0.f;
                    for (int k = 0; k < 256; ++k) s += vt[t * 256 + k] * vdn[k * 32 + j];
                    vd[e] = s; }
            }
            __syncthreads();
            const int tb = half * 32;
            { const float* wup = Ap->in[I_WUP] + (size_t)l * 32 * 256; float w[32];
#pragma unroll
              for (int j = 0; j < 32; ++j) w[j] = wup[j * 256 + c];
              const float w0 = Ap->in[I_W0][l * 256 + c];
              asm volatile("" ::: "memory");
#pragma unroll 1
              for (int t = tb; t < tb + 32; ++t) { float s = w0;
#pragma unroll
                  for (int j = 0; j < 32; ++j) s += in128[t * 128 + j] * w[j];
                  const float wlog = -softplusf_(-s) - 0.5f; LO[(size_t)(m0 + t) * 1024 + c] = (bf16_t)f2bf(-__expf(wlog)); } }
            { const float* aup = Ap->in[I_AUP] + (size_t)l * 32 * 256; float w[32];
#pragma unroll
              for (int j = 0; j < 32; ++j) w[j] = aup[j * 256 + c];
              const float a0 = Ap->in[I_A0][l * 256 + c];
              asm volatile("" ::: "memory");
#pragma unroll 1
              for (int t = tb; t < tb + 32; ++t) { float s = a0;
#pragma unroll
                  for (int j = 0; j < 32; ++j) s += in128[t * 128 + 32 + j] * w[j];
                  LO[(size_t)(m0 + t) * 1024 + 256 + c] = (bf16_t)f2bf(sigmoidf_(s)); } }
            { const float* gup = Ap->in[I_GUP] + (size_t)l * 64 * 256; float w[64];
#pragma unroll
              for (int j = 0; j < 64; ++j) w[j] = gup[j * 256 + c];
              asm volatile("" ::: "memory");
#pragma unroll 1
              for (int t = tb; t < tb + 32; ++t) { float s = 0.f;
#pragma unroll
                  for (int j = 0; j < 64; ++j) s += in128[t * 128 + 64 + j] * w[j];
                  LO[(size_t)(m0 + t) * 1024 + 512 + c] = (bf16_t)f2bf(s); } }
            if (l > 0) { const float* vup = Ap->in[I_VUP] + (size_t)(l - 1) * 32 * 256; float w[32];
#pragma unroll
              for (int j = 0; j < 32; ++j) w[j] = vup[j * 256 + c];
              const float v0 = Ap->in[I_V0][(l - 1) * 256 + c];
              asm volatile("" ::: "memory");
#pragma unroll 1
              for (int t = tb; t < tb + 32; ++t) { float s = v0;
#pragma unroll
                  for (int j = 0; j < 32; ++j) s += vd[t * 32 + j] * w[j];
                  LO[(size_t)(m0 + t) * 1024 + 768 + c] = (bf16_t)f2bf(sigmoidf_(s)); } }
        }
        __syncthreads();
    }
}

constexpr int SC_CH = 32;
struct ScanLds { LAS float *W, *A, *B, *K, *R, *V, *Y, *G, *X; };
__device__ __forceinline__ ScanLds scan_lds(LAS unsigned char* lds) {
    ScanLds s; LAS float* f = (LAS float*)lds; s.W = f; s.A = f + 2048; s.B = f + 4096; s.K = f + 6144; s.R = f + 8192; s.V = f + 10240; s.Y = f + 12288; s.G = f + 14336; s.X = f + 16384; return s;
}
__device__ __forceinline__ void scan_chunk(const ScanLds& L, float (&s)[8], int tid) {
    const int row = tid >> 3, j8 = (tid & 7) * 8;
#pragma unroll 2
    for (int t = 0; t < SC_CH; ++t) {
        const f32x4 w0 = *(const LAS f32x4*)(L.W + t * 64 + j8), w1 = *(const LAS f32x4*)(L.W + t * 64 + j8 + 4);
        const f32x4 a0 = *(const LAS f32x4*)(L.A + t * 64 + j8), a1 = *(const LAS f32x4*)(L.A + t * 64 + j8 + 4);
        const f32x4 b0 = *(const LAS f32x4*)(L.B + t * 64 + j8), b1 = *(const LAS f32x4*)(L.B + t * 64 + j8 + 4);
        const f32x4 k0 = *(const LAS f32x4*)(L.K + t * 64 + j8), k1 = *(const LAS f32x4*)(L.K + t * 64 + j8 + 4);
        const f32x4 r0 = *(const LAS f32x4*)(L.R + t * 64 + j8), r1 = *(const LAS f32x4*)(L.R + t * 64 + j8 + 4);
        const float v = L.V[t * 64 + row];
        float sa = 0.f;
#pragma unroll
        for (int c = 0; c < 4; ++c) { sa += s[c] * a0[c]; sa += s[4 + c] * a1[c]; }
        sa += __shfl_xor(sa, 1); sa += __shfl_xor(sa, 2); sa += __shfl_xor(sa, 4);
        float y = 0.f;
#pragma unroll
        for (int c = 0; c < 4; ++c) { s[c] = s[c] * w0[c] + sa * b0[c] + v * k0[c]; s[4 + c] = s[4 + c] * w1[c] + sa * b1[c] + v * k1[c]; y += s[c] * r0[c]; y += s[4 + c] * r1[c]; }
        y += __shfl_xor(y, 1); y += __shfl_xor(y, 2); y += __shfl_xor(y, 4);
        if ((tid & 7) == 0) L.Y[t * 64 + row] = y;
    }
}

__device__ __forceinline__ void rwkv_block(const Ctx& C, int l, int bh) {
    const ArgsP Ap = C.a;
    const int b = bh >> 2, h = bh & 3, lane = C.lane, ch = h * 64 + lane;
    const bf16_t* P = (const bf16_t*)(Ap->ws + WS_P); const bf16_t* LO = (const bf16_t*)(Ap->ws + WS_XBF);
    bf16_t* VF = (bf16_t*)(Ap->ws + WS_VF); bf16_t* Y = (bf16_t*)(Ap->ws + WS_Y);
    const ScanLds L = scan_lds(C.lds);
    const float* mu = Ap->in[I_MU] + l * 896;
    const float mu_r = mu[ch], mu_k = mu[256 + ch], mu_v = mu[512 + ch];
    const float k_k = Ap->in[I_KK][l * 256 + ch], k_a = Ap->in[I_KA][l * 256 + ch], r_k = Ap->in[I_RK][l * 256 + ch];
    const float gn_w = Ap->in[I_GNW][l * 256 + ch], gn_b = Ap->in[I_GNB][l * 256 + ch];
    float s[8];
#pragma unroll
    for (int c = 0; c < 8; ++c) s[c] = 0.f;
    for (int t0 = 0; t0 < SEQ; t0 += SC_CH) {
        __syncthreads();
        for (int tk = C.wave; tk < SC_CH; tk += 8) {
            const int t = t0 + tk; const size_t m = (size_t)b * SEQ + t;
            const bf16_t* row = P + m * NIN + PRW; const bool hp = t > 0;
            const float rc = bf2f(row[ch]), kc = bf2f(row[256 + ch]), vc = bf2f(row[512 + ch]);
            const float rp = hp ? bf2f(row[ch - NIN]) : 0.f, kp = hp ? bf2f(row[256 + ch - NIN]) : 0.f, vp = hp ? bf2f(row[512 + ch - NIN]) : 0.f;
            const float r = rc + (rp - rc) * mu_r, k = kc + (kp - kc) * mu_k; float v = vc + (vp - vc) * mu_v;
            const bf16_t* lo = LO + m * 1024;
            const float wl = bf2f(lo[ch]), a = bf2f(lo[256 + ch]), g = bf2f(lo[512 + ch]);
            if (l == 0) VF[m * 256 + ch] = (bf16_t)f2bf(v);
            else { const float vg = bf2f(lo[768 + ch]); const float vf = bf2f(VF[m * 256 + ch]); v = v + (vf - v) * vg; }
            const float kkp = k * k_k; const float n2 = wave_sum(kkp * kkp); const float kk = kkp * rsqrtf(n2 + 1e-12f);
            const float k2 = k * (1.f + (a - 1.f) * k_a);
            const float bon = wave_sum(r * k2 * r_k);
            L.W[tk * 64 + lane] = __expf(wl); L.A[tk * 64 + lane] = -kk; L.B[tk * 64 + lane] = kk * a; L.K[tk * 64 + lane] = k2; L.R[tk * 64 + lane] = r; L.V[tk * 64 + lane] = v; L.G[tk * 64 + lane] = g;
            if (lane == 0) L.X[tk] = bon;
        }
        __syncthreads();
        scan_chunk(L, s, C.tid);
        __syncthreads();
        for (int tk = C.wave; tk < SC_CH; tk += 8) {
            const size_t m = (size_t)b * SEQ + t0 + tk;
            const float y = L.Y[tk * 64 + lane]; const float mean = wave_sum(y) * (1.f / 64.f); const float d = y - mean; const float var = wave_sum(d * d) * (1.f / 64.f);
            const float yn = d * rsqrtf(var + 64e-5f) * gn_w + gn_b;
            const float o = (yn + L.X[tk] * L.V[tk * 64 + lane]) * L.G[tk * 64 + lane];
            Y[m * DM + 512 + ch] = (bf16_t)f2bf(o);
        }
    }
    __syncthreads();
}

__device__ __forceinline__ void gdn_block(const Ctx& C, int l, int bh) {
    const ArgsP Ap = C.a;
    const int b = bh >> 2, h = bh & 3, lane = C.lane, ch = h * 64 + lane;
    const bf16_t* P = (const bf16_t*)(Ap->ws + WS_P); bf16_t* Y = (bf16_t*)(Ap->ws + WS_Y);
    const ScanLds L = scan_lds(C.lds);
    const float* cw = Ap->in[I_CONV] + (size_t)l * 4 * 768;
    float wq[4], wk[4], wv[4];
#pragma unroll
    for (int j = 0; j < 4; ++j) { wq[j] = cw[j * 768 + ch]; wk[j] = cw[j * 768 + 256 + ch]; wv[j] = cw[j * 768 + 512 + ch]; }
    const float nexpa = -__expf(Ap->in[I_ALOG][l * 4 + h]), dtb = Ap->in[I_DTB][l * 4 + h], onw = Ap->in[I_ONORM][l * 64 + lane];
    float s[8];
#pragma unroll
    for (int c = 0; c < 8; ++c) s[c] = 0.f;
    for (int t0 = 0; t0 < SEQ; t0 += SC_CH) {
        __syncthreads();
        for (int tk = C.wave; tk < SC_CH; tk += 8) {
            const int t = t0 + tk; const size_t m = (size_t)b * SEQ + t;
            const bf16_t* row = P + m * NIN;
            float xq = 0.f, xk = 0.f, xv = 0.f;
#pragma unroll
            for (int j = 0; j < 4; ++j) { const int dt = 3 - j; if (t - dt >= 0) { const bf16_t* rr = row - (size_t)dt * NIN + PGD;
                xq += wq[j] * bf2f(rr[ch]); xk += wk[j] * bf2f(rr[256 + ch]); xv += wv[j] * bf2f(rr[512 + ch]); } }
            xq = siluf_(xq); xk = siluf_(xk); xv = siluf_(xv);
            const float q = xq * rsqrtf(wave_sum(xq * xq) + 1e-6f) * 0.125f; const float k = xk * rsqrtf(wave_sum(xk * xk) + 1e-6f);
            const float beta = sigmoidf_(bf2f(row[PGB + h])); const float gg = nexpa * softplusf_(bf2f(row[PGA + h]) + dtb); const float eg = __expf(gg);
            L.W[tk * 64 + lane] = eg; L.A[tk * 64 + lane] = eg * k; L.B[tk * 64 + lane] = -beta * k; L.K[tk * 64 + lane] = beta * k; L.R[tk * 64 + lane] = q; L.V[tk * 64 + lane] = xv;
            L.G[tk * 64 + lane] = siluf_(bf2f(row[PGD + 768 + ch]));
        }
        __syncthreads();
        scan_chunk(L, s, C.tid);
        __syncthreads();
        for (int tk = C.wave; tk < SC_CH; tk += 8) {
            const size_t m = (size_t)b * SEQ + t0 + tk;
            const float o = L.Y[tk * 64 + lane]; const float rs = rsqrtf(wave_sum(o * o) * (1.f / 64.f) + NORM_EPS);
            Y[m * DM + 768 + ch] = (bf16_t)f2bf(o * rs * onw * L.G[tk * 64 + lane]);
        }
    }
    __syncthreads();
}

constexpr int DS_CAP = 1024;
constexpr int DS_KI = 128 * 1024, DS_KIROW = 144, DS_KIBUF = 64 * DS_KIROW, DS_HIST = DS_KI + 2 * DS_KIBUF;
static_assert(DS_HIST + 8 * 1024 <= LDS_MISC, "dsa lds");

__device__ __forceinline__ unsigned wave_select256(LAS unsigned* list, int n, LAS unsigned* hist, int lane) {
    unsigned k[16];
#pragma unroll
    for (int j = 0; j < 16; ++j) { const int i = j * 64 + lane; k[j] = (i < n) ? list[i] : 0u; }
    unsigned prefix = 0u, mask = 0u; int rem = 256;
#pragma unroll 1
    for (int pass = 0; pass < 4; ++pass) {
        const int sh = 24 - 8 * pass;
        *(LAS u32x4*)(hist + 4 * lane) = (u32x4){0u, 0u, 0u, 0u};
        asm volatile("s_waitcnt lgkmcnt(0)" ::: "memory");
#pragma unroll
        for (int j = 0; j < 16; ++j) { const int i = j * 64 + lane; if (i < n && ((k[j] ^ prefix) & mask) == 0u) __hip_atomic_fetch_add((LAS unsigned*)&hist[(k[j] >> sh) & 255u], 1u, __ATOMIC_RELAXED, __HIP_MEMORY_SCOPE_WORKGROUP); }
        asm volatile("s_waitcnt lgkmcnt(0)" ::: "memory");
        const u32x4 hv = *(const LAS u32x4*)(hist + 4 * lane);
        const int tl = (int)(hv[0] + hv[1] + hv[2] + hv[3]);
        int inc = tl;
#pragma unroll
        for (int o = 1; o < 64; o <<= 1) { const int v = __shfl_down(inc, o); if (lane + o < 64) inc += v; }
        const int suf = inc - tl;
        const int s3 = suf + (int)hv[3], s2 = s3 + (int)hv[2], s1 = s2 + (int)hv[1], s0 = s1 + (int)hv[0];
        int digit = -1, above = 0;
        if (s3 >= rem && suf < rem) { digit = 4 * lane + 3; above = suf; }
        else if (s2 >= rem && s3 < rem) { digit = 4 * lane + 2; above = s3; }
        else if (s1 >= rem && s2 < rem) { digit = 4 * lane + 1; above = s2; }
        else if (s0 >= rem && s1 < rem) { digit = 4 * lane + 0; above = s1; }
        const unsigned long long bal = __ballot(digit >= 0);
        const int src = (int)__builtin_ctzll(bal | (1ull << 63));
        digit = __shfl(digit, src); above = __shfl(above, src);
        prefix |= (unsigned)digit << sh; mask |= 0xffu << sh; rem -= above;
    }
    int run = 0;
#pragma unroll
    for (int j = 0; j < 16; ++j) { const int i = j * 64 + lane; const bool keep = (i < n) && (k[j] >= prefix);
        const unsigned long long bal = __ballot(keep);
        const int pos = run + (int)__builtin_amdgcn_mbcnt_hi((unsigned)(bal >> 32), __builtin_amdgcn_mbcnt_lo((unsigned)bal, 0u));
        if (keep) list[pos] = k[j];
        run += (int)__builtin_popcountll(bal); }
    asm volatile("s_waitcnt lgkmcnt(0)" ::: "memory");
    return prefix;
}

__device__ __forceinline__ void dsa_item(const Ctx& C, int b, int qt) {
    const ArgsP Ap = C.a;
    const bf16_t* P = (const bf16_t*)(Ap->ws + WS_P); bf16_t* Y = (bf16_t*)(Ap->ws + WS_Y);
    const int lane = C.lane, w = C.wave, tid = C.tid, hl = lane >> 5, l32 = lane & 31;
    const int t0 = qt * 32;
    const size_t mb = (size_t)b * SEQ;
    LAS unsigned* cand = (LAS unsigned*)(C.lds) + w * 4 * DS_CAP;
    LAS unsigned* hist = (LAS unsigned*)(C.lds + DS_HIST) + w * 256;
    bf16x8 af[4];
    { const int rho = l32; const int qq = 2 * ((rho >> 2) & 1) + (rho >> 4), hd = (rho & 3) + 4 * ((rho >> 3) & 1);
      const bf16_t* src = P + (mb + t0 + 4 * w + qq) * NIN + PQI + hd * 64 + 8 * hl;
#pragma unroll
      for (int s = 0; s < 4; ++s) af[s] = *(const bf16x8*)(src + 16 * s); }
    float wA[8], wB[8];
    { const bf16_t* ra = P + (mb + t0 + 4 * w + 2 * hl) * NIN + PWI; const u32x4 va = *(const u32x4*)ra, vb = *(const u32x4*)(ra + NIN);
#pragma unroll
      for (int i = 0; i < 4; ++i) { wA[2 * i] = bflo(va[i]); wA[2 * i + 1] = bfhi(va[i]); wB[2 * i] = bflo(vb[i]); wB[2 * i + 1] = bfhi(vb[i]); } }
    const int tA = t0 + 4 * w + 2 * hl, tB = tA + 1;
    int cnt0 = 0, cnt1 = 0, cnt2 = 0, cnt3 = 0; unsigned th0 = 0u, th1 = 0u, th2 = 0u, th3 = 0u;
    const int NT = (t0 + 32 + 63) >> 6;
    const bf16_t* kisrc = P + (mb + (tid >> 3)) * NIN + PKI + 8 * (tid & 7);
    LAS unsigned char* kib = C.lds + DS_KI; const int kiw = (tid >> 3) * DS_KIROW + (tid & 7) * 16;
    __syncthreads();
    { const u32x4 v = *(const u32x4*)kisrc; *(LAS u32x4*)(kib + kiw) = v; }
    __syncthreads();
#pragma unroll 1
    for (int kt = 0; kt < NT; ++kt) {
        u32x4 nxt = (u32x4){0u, 0u, 0u, 0u};
        if (kt + 1 < NT) nxt = *(const u32x4*)(kisrc + (size_t)(kt + 1) * 64 * NIN);
        if (cnt0 > DS_CAP - 64) { th0 = wave_select256(cand + 0 * DS_CAP, cnt0, hist, lane); cnt0 = 256; }
        if (cnt1 > DS_CAP - 64) { th1 = wave_select256(cand + 1 * DS_CAP, cnt1, hist, lane); cnt1 = 256; }
        if (cnt2 > DS_CAP - 64) { th2 = wave_select256(cand + 2 * DS_CAP, cnt2, hist, lane); cnt2 = 256; }
        if (cnt3 > DS_CAP - 64) { th3 = wave_select256(cand + 3 * DS_CAP, cnt3, hist, lane); cnt3 = 256; }
        const LAS unsigned char* kb = kib + (kt & 1) * DS_KIBUF;
#pragma unroll
        for (int nt = 0; nt < 2; ++nt) {
            f32x16 c = {};
#pragma unroll
            for (int s = 0; s < 4; ++s) { const bf16x8 bfr = *(const LAS bf16x8*)(kb + (nt * 32 + l32) * DS_KIROW + (16 * s + 8 * hl) * 2);
                c = __builtin_amdgcn_mfma_f32_32x32x16_bf16(af[s], bfr, c, 0, 0, 0); }
            float sA = 0.f, sB = 0.f;
#pragma unroll
            for (int i = 0; i < 8; ++i) { sA = fmaf(fmaxf(c[i], 0.f), wA[i], sA); sB = fmaf(fmaxf(c[8 + i], 0.f), wB[i], sB); }
            const int sidx = kt * 64 + nt * 32 + l32;
            unsigned uA = __builtin_bit_cast(unsigned, sA), uB = __builtin_bit_cast(unsigned, sB);
            uA = (uA & 0x80000000u) ? ~uA : (uA | 0x80000000u); uB = (uB & 0x80000000u) ? ~uB : (uB | 0x80000000u);
            const unsigned keyA = (uA & 0xffffe000u) | (unsigned)(8191 - sidx), keyB = (uB & 0xffffe000u) | (unsigned)(8191 - sidx);
            const unsigned thA = hl ? th2 : th0, thB = hl ? th3 : th1;
            const bool pA = (sidx <= tA) && (keyA > thA), pB = (sidx <= tB) && (keyB > thB);
            { const unsigned long long bal = __ballot(pA); const unsigned lo = (unsigned)bal, hi = (unsigned)(bal >> 32);
              const int pos = hl ? (cnt2 + (int)__builtin_amdgcn_mbcnt_hi(hi, 0u)) : (cnt0 + (int)__builtin_amdgcn_mbcnt_lo(lo, 0u));
              if (pA) cand[(hl ? 2 : 0) * DS_CAP + pos] = keyA;
              cnt0 += __builtin_popcount(lo); cnt2 += __builtin_popcount(hi); }
            { const unsigned long long bal = __ballot(pB); const unsigned lo = (unsigned)bal, hi = (unsigned)(bal >> 32);
              const int pos = hl ? (cnt3 + (int)__builtin_amdgcn_mbcnt_hi(hi, 0u)) : (cnt1 + (int)__builtin_amdgcn_mbcnt_lo(lo, 0u));
              if (pB) cand[(hl ? 3 : 1) * DS_CAP + pos] = keyB;
              cnt1 += __builtin_popcount(lo); cnt3 += __builtin_popcount(hi); }
        }
        if (kt + 1 < NT) *(LAS u32x4*)(kib + ((kt + 1) & 1) * DS_KIBUF + kiw) = nxt;
        __syncthreads();
    }
    if (cnt0 > 256) { wave_select256(cand + 0 * DS_CAP, cnt0, hist, lane); cnt0 = 256; }
    if (cnt1 > 256) { wave_select256(cand + 1 * DS_CAP, cnt1, hist, lane); cnt1 = 256; }
    if (cnt2 > 256) { wave_select256(cand + 2 * DS_CAP, cnt2, hist, lane); cnt2 = 256; }
    if (cnt3 > 256) { wave_select256(cand + 3 * DS_CAP, cnt3, hist, lane); cnt3 = 256; }
    asm volatile("s_waitcnt lgkmcnt(0)" ::: "memory");
#pragma unroll 1
    for (int qq = 0; qq < 4; ++qq) {
        const int nsel = qq == 0 ? cnt0 : qq == 1 ? cnt1 : qq == 2 ? cnt2 : cnt3;
        const LAS unsigned* lst = cand + qq * DS_CAP;
        LAS f32x4* pb0 = (LAS f32x4*)(cand + qq * DS_CAP + 256);
        LAS f32x4* pb1 = (LAS f32x4*)(cand + (qq ^ 1) * DS_CAP + 256);
        const size_t mq = mb + t0 + 4 * w + qq;
        const bf16_t* qrow = P + mq * NIN + PQ;
#pragma unroll 1
        for (int g = 0; g < 2; ++g) {
            bf16x8 aq[2];
#pragma unroll
            for (int s = 0; s < 2; ++s) { aq[s] = (bf16x8){0, 0, 0, 0, 0, 0, 0, 0}; if ((lane & 15) < 4) aq[s] = *(const bf16x8*)(qrow + (4 * g + (lane & 15)) * 64 + 32 * s + 8 * (lane >> 4)); }
            f32x4 sc[16];
#pragma unroll
            for (int kt = 0; kt < 16; ++kt) {
                const int n = 16 * kt + (lane & 15);
                const int idx = (n < nsel) ? (8191 - (int)(lst[n] & 8191u)) : 0;
                const bf16_t* krow = P + (mb + idx) * NIN + PK + 64 * g + 8 * (lane >> 4);
                const bf16x8 k0 = *(const bf16x8*)krow, k1 = *(const bf16x8*)(krow + 32);
                f32x4 c = {0.f, 0.f, 0.f, 0.f};
                c = __builtin_amdgcn_mfma_f32_16x16x32_bf16(aq[0], k0, c, 0, 0, 0);
                c = __builtin_amdgcn_mfma_f32_16x16x32_bf16(aq[1], k1, c, 0, 0, 0);
                if (n >= nsel) c = (f32x4){-INFINITY, -INFINITY, -INFINITY, -INFINITY};
                sc[kt] = c;
            }
            f32x4 mx = sc[0];
#pragma unroll
            for (int kt = 1; kt < 16; ++kt) { mx[0] = fmaxf(mx[0], sc[kt][0]); mx[1] = fmaxf(mx[1], sc[kt][1]); mx[2] = fmaxf(mx[2], sc[kt][2]); mx[3] = fmaxf(mx[3], sc[kt][3]); }
#pragma unroll
            for (int o = 1; o < 16; o <<= 1) { mx[0] = fmaxf(mx[0], __shfl_xor(mx[0], o)); mx[1] = fmaxf(mx[1], __shfl_xor(mx[1], o)); mx[2] = fmaxf(mx[2], __shfl_xor(mx[2], o)); mx[3] = fmaxf(mx[3], __shfl_xor(mx[3], o)); }
            f32x4 sm = {0.f, 0.f, 0.f, 0.f};
#pragma unroll
            for (int kt = 0; kt < 16; ++kt) {
#pragma unroll
                for (int e = 0; e < 4; ++e) { const float p = __expf(sc[kt][e] - mx[e]); sc[kt][e] = p; sm[e] += p; } }
#pragma unroll
            for (int o = 1; o < 16; o <<= 1) { sm[0] += __shfl_xor(sm[0], o); sm[1] += __shfl_xor(sm[1], o); sm[2] += __shfl_xor(sm[2], o); sm[3] += __shfl_xor(sm[3], o); }
            const f32x4 inv = {1.f / sm[0], 1.f / sm[1], 1.f / sm[2], 1.f / sm[3]};
            if (lane < 16) {
#pragma unroll
                for (int kt = 0; kt < 16; ++kt) { const int n = 16 * kt + lane; const f32x4 pv = sc[kt] * inv;
                    if (kt < 12) pb0[n] = pv; else pb1[n - 192] = pv; }
            }
            asm volatile("s_waitcnt lgkmcnt(0)" ::: "memory");
            float o[4][2];
#pragma unroll
            for (int hh = 0; hh < 4; ++hh) { o[hh][0] = 0.f; o[hh][1] = 0.f; }
            const bf16_t* vbase = P + mb * NIN + PV + 64 * g + 2 * l32;
#pragma unroll 4
            for (int n = hl; n < nsel; n += 2) {
                const int idx = 8191 - (int)(lst[n] & 8191u);
                const unsigned v2 = *(const unsigned*)(vbase + (size_t)idx * NIN);
                const f32x4 pv = (n < 192) ? pb0[n] : pb1[n - 192];
                const float v0 = bflo(v2), v1 = bfhi(v2);
#pragma unroll
                for (int hh = 0; hh < 4; ++hh) { o[hh][0] += pv[hh] * v0; o[hh][1] += pv[hh] * v1; }
            }
#pragma unroll
            for (int hh = 0; hh < 4; ++hh) { o[hh][0] += __shfl_xor(o[hh][0], 32); o[hh][1] += __shfl_xor(o[hh][1], 32); }
            if (hl == 0) {
#pragma unroll
                for (int hh = 0; hh < 4; ++hh) *(unsigned*)(Y + mq * DM + (4 * g + hh) * 64 + 2 * l32) = pk2(o[hh][0], o[hh][1]);
            }
            asm volatile("s_waitcnt lgkmcnt(0)" ::: "memory");
        }
    }
}

__device__ __forceinline__ void mixers_phase(const Ctx& C, int l) {
    const ArgsP Ap = C.a;
    if (C.bid < 8) rwkv_block(C, l, C.bid);
    else if (C.bid < 16) gdn_block(C, l, C.bid - 8);
    unsigned* work = (unsigned*)(Ap->ws + WS_CTL) + CW_WORK + 64 * l;
    volatile LAS unsigned* misc = (volatile LAS unsigned*)(C.lds + LDS_MISC);
    for (;;) {
        __syncthreads();
        if (C.tid == 0) misc[0] = __hip_atomic_fetch_add(work, 1u, __ATOMIC_RELAXED, __HIP_MEMORY_SCOPE_AGENT);
        __syncthreads();
        const int it = (int)misc[0];
        if (it >= 512) break;
        dsa_item(C, it & 1, 255 - (it >> 1));
    }
    __syncthreads();
}

constexpr int NPHASE = 18;
__global__ void __launch_bounds__(512, 2) fwd_kernel(Args args_unused) {
    extern __shared__ __attribute__((aligned(16))) unsigned char lds_raw[];
    ArgsP ap0 = (ArgsP)__builtin_amdgcn_kernarg_segment_ptr();
    Ctx C; C.lds = (LAS unsigned char*)lds_raw; C.tid = threadIdx.x; C.lane = C.tid & 63; C.wave = __builtin_amdgcn_readfirstlane(C.tid >> 6); C.G = gridDim.x; C.bid = blockIdx.x; C.a = ap0;
    volatile LAS unsigned* misc = (volatile LAS unsigned*)(C.lds + LDS_MISC);
    if (C.tid < 64) misc[C.tid] = 0u;
    __syncthreads();
    const int ph_lo = ap0->ph_lo, ph_hi = ap0->ph_hi;
    XcdBarrier bar; bar.bar = (unsigned*)(ap0->ws + WS_CTL) + CW_BAR; bar.x = 0; bar.st = nullptr;
    const bool fused = (ph_hi - ph_lo) > 1;
    if (fused) bar = xcd_barrier_post((unsigned*)(ap0->ws + WS_CTL) + CW_BAR, misc + 8);
#ifndef PHASE_MASK
#define PHASE_MASK 0x3ff
#endif
#define PM(k) ((PHASE_MASK >> (k)) & 1)
    for (int ph = ph_lo; ph < ph_hi; ++ph) {
        { int t_ = threadIdx.x; asm volatile("" : "+v"(t_)); C.tid = t_; C.lane = t_ & 63; C.wave = __builtin_amdgcn_readfirstlane(t_ >> 6); }
        ArgsP ap = (ArgsP)__builtin_amdgcn_kernarg_segment_ptr(); asm volatile("" : "+s"(ap)); C.a = ap;
        unsigned char* ws = ap->ws; unsigned char* wb = ws + WS_W;
        bf16_t* XBF = (bf16_t*)(ws + WS_XBF); bf16_t* ACT = (bf16_t*)(ws + WS_ACT); bf16_t* PB = (bf16_t*)(ws + WS_P); bf16_t* YB = (bf16_t*)(ws + WS_Y);
        float* SSQA = (float*)(ws + WS_SSQ); float* SSQB = SSQA + (size_t)MTOK * 16; float* SSQC = SSQB + (size_t)MTOK * 16;
        if (ph == 0) { if (PM(9)) { convert_layer_weights(C, 0); prologue_x(C); } }
        else {
            const int l = (ph - 1) / 9, sp = (ph - 1) % 9;
            pg8::StaticOrder S;
            switch (sp) {
            case 0: if (PM(0)) { pg8::Gemm g{XBF, (const bf16_t*)(wb + W_GU1), MTOK, NGU, DM}; S.init(MTOK, NGU, C.G, C.bid); pg8::EpiFfnUp E{ACT, SSQA};
                      pg8::gemm_phase<pg8::EpiFfnUp, pg8::StaticOrder, true, true>(C.lds, g, S, E, C.tid); } break;
            case 1: if (PM(1)) { pg8::Gemm g{ACT, (const bf16_t*)(wb + W_D1), MTOK, DM, FF}; S.init(MTOK, DM, C.G, C.bid); pg8::EpiResid E{l == 0 ? ap->in[I_X] : ap->out, ap->out, XBF, SSQB, 0.5f};
                      pg8::gemm_phase<pg8::EpiResid, pg8::StaticOrder, true, true>(C.lds, g, S, E, C.tid); } break;
            case 2: if (PM(2)) { pg8::Gemm g{XBF, (const bf16_t*)(wb + W_IN), MTOK, NIN, DM}; S.init(MTOK, NIN, C.G, C.bid); pg8::EpiRowScaleBf16 E{PB, NIN, SSQB};
                      pg8::gemm_phase<pg8::EpiRowScaleBf16, pg8::StaticOrder, true, true>(C.lds, g, S, E, C.tid); } break;
            case 3: if (PM(3)) prep_phase(C, l); break;
            case 4: if (PM(4)) mixers_phase(C, l); break;
            case 5: if (PM(5)) { pg8::Gemm g{YB, (const bf16_t*)(wb + W_OUT), MTOK, DM, DM}; S.init(MTOK, DM, C.G, C.bid); pg8::EpiResid E{ap->out, ap->out, XBF, SSQC, 1.0f};
                      pg8::gemm_phase<pg8::EpiResid, pg8::StaticOrder, true, true>(C.lds, g, S, E, C.tid); } break;
            case 6: if (PM(6)) { pg8::Gemm g{XBF, (const bf16_t*)(wb + W_GU2), MTOK, NGU, DM}; S.init(MTOK, NGU, C.G, C.bid); pg8::EpiFfnUp E{ACT, SSQC};
                      pg8::gemm_phase<pg8::EpiFfnUp, pg8::StaticOrder, true, true>(C.lds, g, S, E, C.tid); } break;
            case 7: if (PM(7)) { pg8::Gemm g{ACT, (const bf16_t*)(wb + W_D2), MTOK, DM, FF}; S.init(MTOK, DM, C.G, C.bid); pg8::EpiResid E{ap->out, ap->out, XBF, SSQA, 0.5f};
                      pg8::gemm_phase<pg8::EpiResid, pg8::StaticOrder, true, true>(C.lds, g, S, E, C.tid); } break;
            case 8: if (PM(8)) convert_layer_weights(C, l + 1); break;
            }
        }
        if (ph + 1 < ph_hi) xcd_barrier(bar);
    }
}

extern "C" void kernel_launch(void* const* d_in, const int* in_sizes, int n_in, void* d_out, int out_size, void* d_ws, size_t ws_size, hipStream_t stream) {
    static int grid = 0;
    if (grid == 0) {
        if (n_in != 28 || out_size != MTOK * DM || ws_size < WS_END) { fprintf(stderr, "kernel_launch: unexpected shapes (n_in %d out %d ws %zu)\n", n_in, out_size, ws_size); grid = -1; return; }
        int dev = 0, cus = 0, per_cu = 0;
        if (hipGetDevice(&dev) != hipSuccess || hipDeviceGetAttribute(&cus, hipDeviceAttributeMultiprocessorCount, dev) != hipSuccess) { grid = -1; return; }
        if (hipFuncSetAttribute((const void*)fwd_kernel, hipFuncAttributeMaxDynamicSharedMemorySize, LDS_BYTES) != hipSuccess) { fprintf(stderr, "kernel_launch: hipFuncSetAttribute failed\n"); grid = -1; return; }
        if (hipOccupancyMaxActiveBlocksPerMultiprocessor(&per_cu, (const void*)fwd_kernel, 512, LDS_BYTES) != hipSuccess || per_cu < 1) { fprintf(stderr, "kernel_launch: occupancy query says %d\n", per_cu); per_cu = 1; }
        (void)hipGetLastError();
        grid = cus;
    }
    if (grid < 0) return;
    (void)hipMemsetAsync((char*)d_ws + WS_CTL, 0, CTL_ZERO_BYTES, stream);
    Args a{};
    for (int i = 0; i < 28; ++i) a.in[i] = (const float*)d_in[i];
    a.out = (float*)d_out; a.ws = (unsigned char*)d_ws;
#if MK_N_LAUNCHES == 1
    a.ph_lo = 0; a.ph_hi = NPHASE;
    void* kargs[] = {&a};
    hipError_t e = hipLaunchCooperativeKernel((const void*)fwd_kernel, dim3(grid), dim3(512), kargs, LDS_BYTES, stream);
    if (e != hipSuccess) fprintf(stderr, "kernel_launch: cooperative launch failed: %s\n", hipGetErrorString(e));
#else
    for (int ph = 0; ph < NPHASE; ++ph) { a.ph_lo = ph; a.ph_hi = ph + 1; hipLaunchKernelGGL(fwd_kernel, dim3(grid), dim3(512), LDS_BYTES, stream, a); }
#endif
}
```

```cpp
#include <hip/hip_runtime.h>
#include <cstdio>
#include <cstdint>

#ifndef MK_N_LAUNCHES
#define MK_N_LAUNCHES 1
#endif

#define LAS __attribute__((address_space(3)))
#define GAS __attribute__((address_space(1)))
typedef unsigned short bf16_t;
typedef short bf16x8 __attribute__((ext_vector_type(8)));
typedef float f32x4 __attribute__((ext_vector_type(4)));
typedef float f32x16 __attribute__((ext_vector_type(16)));
typedef float f32x2 __attribute__((ext_vector_type(2)));
typedef unsigned u32x4 __attribute__((ext_vector_type(4)));
typedef unsigned u32x2 __attribute__((ext_vector_type(2)));

constexpr int BATCH = 2, SEQ = 8192, DM = 1024, FF = 2816, MTOK = BATCH * SEQ;
constexpr int NGU = 2 * FF;
constexpr int NIN = 3328;
constexpr int PQ = 0, PK = 512, PV = 640, PQI = 768, PKI = 1280, PWI = 1344, PGB = 1352, PGA = 1356;
constexpr int PRW = 1408;
constexpr int PGD = 2304;
constexpr float NORM_EPS = 1e-6f;

constexpr size_t MiB = 1u << 20;
constexpr size_t WS_CTL = 0, CTL_ZERO_BYTES = 64 * 1024;
constexpr size_t WS_ROPE = 64 * 1024;
constexpr size_t WS_W = 3 * MiB;
constexpr size_t W_GU1 = 0, W_D1 = 11 * MiB, W_IN = W_D1 + 5632 * 1024, W_OUT = W_IN + (size_t)NIN * DM * 2, W_GU2 = W_OUT + 2 * MiB, W_D2 = W_GU2 + 11 * MiB, W_END = W_D2 + 5632 * 1024;
constexpr size_t WS_XBF = 45 * MiB;
constexpr size_t WS_BIG = 77 * MiB;
constexpr size_t WS_P = WS_BIG, WS_Y = WS_BIG + 104 * MiB, WS_ACT = WS_BIG;
constexpr size_t WS_SSQ = 213 * MiB;
constexpr size_t WS_VF = 216 * MiB;
constexpr size_t WS_END = 224 * MiB;
static_assert(W_END <= 42 * MiB && WS_W + W_END <= WS_XBF && WS_Y + 32 * MiB <= WS_SSQ, "ws map");

constexpr int CW_BAR = 1024;
constexpr int CW_WORK = 8192;

constexpr int LDS_MISC = 154 * 1024;
constexpr int LDS_BYTES = 155 * 1024;

__device__ __forceinline__ unsigned f2bf(float f) { unsigned u = __builtin_bit_cast(unsigned, f); return (u + 0x7fffu + ((u >> 16) & 1u)) >> 16; }
__device__ __forceinline__ unsigned pk2(float lo, float hi) { return f2bf(lo) | (f2bf(hi) << 16); }
__device__ __forceinline__ float bf2f(unsigned short h) { return __builtin_bit_cast(float, (unsigned)h << 16); }
__device__ __forceinline__ float bflo(unsigned w) { return __builtin_bit_cast(float, w << 16); }
__device__ __forceinline__ float bfhi(unsigned w) { return __builtin_bit_cast(float, w & 0xffff0000u); }
__device__ __forceinline__ float wave_sum(float v) {
#pragma unroll
    for (int o = 1; o < 64; o <<= 1) v += __shfl_xor(v, o);
    return v;
}
__device__ __forceinline__ float sigmoidf_(float x) { return 1.f / (1.f + __expf(-x)); }
__device__ __forceinline__ float siluf_(float x) { return x / (1.f + __expf(-x)); }
__device__ __forceinline__ float softplusf_(float x) { return x > 20.f ? x : log1pf(__expf(x)); }

namespace pg8 {
constexpr int BM = 256, BK = 64, HALF = 128, HTB = HALF * BK * 2, STAGE_BYTES = 8 * HTB, NXCD = 8, WGM = 8;
__host__ __device__ __forceinline__ int lds_byte(int r, int c) { const int st = (r >> 4) * 2 + (c >> 5), rr = r & 15, cc = c & 31, ob = rr * 64 + cc * 2; return st * 1024 + (ob ^ (((ob >> 9) & 1) << 5)); }
__host__ __device__ __forceinline__ void stage_rc(int b, int& R, int& C) { const int st = b / 1024, sb = b % 1024, swz = sb ^ (((sb >> 9) & 1) << 5); R = (st >> 1) * 16 + swz / 64; C = (st & 1) * 32 + (swz % 64) / 2; }
__host__ __device__ __forceinline__ int perm32(int rho) { const int n = rho >> 4, i = rho & 15; return 8 * (i >> 2) + 4 * n + (i & 3); }
struct Unit { int pm, pn; };
struct Gemm { const bf16_t* A; const bf16_t* Bt; int M, N, K; };
struct StaticOrder {
    int nM, nN, nwg, G, c;
    __host__ __device__ void init(int M, int N, int G_, int c_) { nM = M / BM; nN = N / BM; nwg = nM * nN; G = G_; c = c_; }
    __host__ __device__ bool next(int i, Unit& u) const {
        const long L = (long)i * G + c; if (L >= nwg) return false;
        int wgid = (int)L; { const int q = nwg / NXCD, r = nwg % NXCD, xcd = wgid % NXCD, off = wgid / NXCD; wgid = (xcd < r ? xcd * (q + 1) : r * (q + 1) + (xcd - r) * q) + off; }
        const int nig = WGM * nN, gid = wgid / nig, fm = gid * WGM, gsz = (nM - fm) < WGM ? (nM - fm) : WGM;
        u.pm = fm + ((wgid % nig) % gsz); u.pn = (wgid % nig) / gsz; return true;
    }
};
__device__ __forceinline__ unsigned cvt_pk_bf16(float lo, float hi) { unsigned r; asm volatile("v_cvt_pk_bf16_f32 %0, %1, %2" : "=v"(r) : "v"(lo), "v"(hi)); return r; }

__device__ __forceinline__ float row_rstd(const float* ssq, int row, int fq) {
    const f32x4 v = *(const f32x4*)(ssq + (size_t)row * 16 + 4 * fq);
    float s = (v[0] + v[1]) + (v[2] + v[3]);
    s += __shfl_xor(s, 16); s += __shfl_xor(s, 32);
    return rsqrtf(s * (1.0f / DM) + NORM_EPS);
}
struct EpiFfnUp {
    static constexpr bool PERM = true;
    bf16_t* O; const float* ssq;
    __device__ __forceinline__ void operator()(const f32x4 (&acc)[2][2][4][2], const Unit& u, int wr, int wc, int fr, int fq) const {
        const int row0 = u.pm * BM + wr * 64 + fr; const int col0 = u.pn * HALF + wc * 32 + 8 * fq;
#pragma unroll
        for (int ai = 0; ai < 2; ++ai)
#pragma unroll
            for (int m = 0; m < 4; ++m) { const int row = row0 + ai * HALF + m * 16; const float rs = row_rstd(ssq, row, fq);
                float o[8];
#pragma unroll
                for (int n = 0; n < 2; ++n)
#pragma unroll
                    for (int e = 0; e < 4; ++e) { const float g = acc[ai][0][m][n][e] * rs, up = acc[ai][1][m][n][e] * rs;
                        o[n * 4 + e] = g * __builtin_amdgcn_rcpf(1.f + __builtin_amdgcn_exp2f(-1.4426950408889634f * g)) * up; }
                u32x4 w; w.x = cvt_pk_bf16(o[0], o[1]); w.y = cvt_pk_bf16(o[2], o[3]); w.z = cvt_pk_bf16(o[4], o[5]); w.w = cvt_pk_bf16(o[6], o[7]);
                *(u32x4*)(O + (size_t)row * FF + col0) = w; asm volatile("" ::: "memory"); }
    }
};
struct EpiRowScaleBf16 {
    static constexpr bool PERM = true;
    bf16_t* O; int ldc; const float* ssq;
    __device__ __forceinline__ void operator()(const f32x4 (&acc)[2][2][4][2], const Unit& u, int wr, int wc, int fr, int fq) const {
        const int row0 = u.pm * BM + wr * 64 + fr; const int col0 = u.pn * BM + wc * 32 + 8 * fq;
#pragma unroll
        for (int ai = 0; ai < 2; ++ai)
#pragma unroll
            for (int m = 0; m < 4; ++m) { const int row = row0 + ai * HALF + m * 16; const float rs = row_rstd(ssq, row, fq);
#pragma unroll
                for (int bj = 0; bj < 2; ++bj) { const f32x4 v0 = acc[ai][bj][m][0] * rs, v1 = acc[ai][bj][m][1] * rs;
                    u32x4 w; w.x = cvt_pk_bf16(v0[0], v0[1]); w.y = cvt_pk_bf16(v0[2], v0[3]); w.z = cvt_pk_bf16(v1[0], v1[1]); w.w = cvt_pk_bf16(v1[2], v1[3]);
                    *(u32x4*)(O + (size_t)row * ldc + col0 + bj * HALF) = w; } asm volatile("" ::: "memory"); }
    }
};
struct EpiResid {
    static constexpr bool PERM = false;
    const float* xin; float* xout; bf16_t* xbf; float* ssq; float alpha;
    __device__ __forceinline__ void operator()(const f32x4 (&acc)[2][2][4][2], const Unit& u, int wr, int wc, int fr, int fq) const {
        const int row0 = u.pm * BM + wr * 64 + fr; const int col0 = u.pn * BM + wc * 32 + 4 * fq;
#pragma unroll
        for (int ai = 0; ai < 2; ++ai)
#pragma unroll
            for (int m = 0; m < 4; ++m) { const int row = row0 + ai * HALF + m * 16; const size_t off = (size_t)row * DM + col0; float s = 0.f;
#pragma unroll
                for (int bj = 0; bj < 2; ++bj)
#pragma unroll
                    for (int n = 0; n < 2; ++n) { const size_t o2 = off + bj * HALF + n * 16; const f32x4 xi = *(const f32x4*)(xin + o2); const f32x4 v = xi + acc[ai][bj][m][n] * alpha;
                        *(f32x4*)(xout + o2) = v; u32x2 w; w.x = cvt_pk_bf16(v[0], v[1]); w.y = cvt_pk_bf16(v[2], v[3]); *(u32x2*)(xbf + o2) = w;
                        s += (v[0] * v[0] + v[1] * v[1]) + (v[2] * v[2] + v[3] * v[3]); }
                s += __shfl_xor(s, 16); s += __shfl_xor(s, 32);
                if (fq == 0) ssq[(size_t)row * 16 + u.pn * 4 + wc] = s; }
    }
};

template <class Epi, class Sched, bool ALIGN_EPI = false, bool SP2 = false>
__device__ __forceinline__ void gemm_phase(LAS unsigned char* lds, const Gemm g, const Sched& S, const Epi& E, const int tid) {
    const int wid = __builtin_amdgcn_readfirstlane(tid >> 6), lane = tid & 63, wr = wid >> 2, wc = wid & 3, fr = lane & 15, fq = lane >> 4;
    const int K = g.K, nt = K / BK;
    unsigned voffA[2], voffB[2];
#pragma unroll
    for (int i = 0; i < 2; ++i) { int R, C; stage_rc(tid * 16 + i * 8192, R, C); const int Rb = Epi::PERM ? ((R & ~31) + perm32(R & 31)) : R;
        voffA[i] = (unsigned)(R * K + C) * 2u; voffB[i] = (unsigned)(Rb * K + C) * 2u; }
    const size_t kstep = (size_t)(BK * 2);
    const size_t hstep = (size_t)HALF * K * 2;
    const size_t tstep = 2 * hstep;
    const unsigned ldsw = (unsigned)wid * 1024u;
    const int aoff = lds_byte(wr * 64 + fr, fq * 8), boff = lds_byte(wc * 32 + fr, fq * 8);
#define PG8_SA(b, h) (((b) * 2 + (h)) * HTB)
#define PG8_SB(b, h) ((4 + (b) * 2 + (h)) * HTB)
#define PG8_STAGE(bufoff, gbase, voff) do { _Pragma("unroll") for (int _i = 0; _i < 2; ++_i) \
        __builtin_amdgcn_global_load_lds((const unsigned*)((const char*)(gbase) + (voff)[_i]), (LAS unsigned*)(lds + (bufoff) + ldsw + _i * 8192), 16, 0, 0); } while (0)
#define PG8_LDA(dst, b, h) do { _Pragma("unroll") for (int m = 0; m < 4; ++m) _Pragma("unroll") for (int k = 0; k < 2; ++k) dst[m][k] = *(const LAS bf16x8*)(lds + PG8_SA(b, h) + aoff + m * 2048 + k * 1024); } while (0)
#define PG8_LDB(dst, b, h) do { _Pragma("unroll") for (int n = 0; n < 2; ++n) _Pragma("unroll") for (int k = 0; k < 2; ++k) dst[n][k] = *(const LAS bf16x8*)(lds + PG8_SB(b, h) + boff + n * 2048 + k * 1024); } while (0)
#define PG8_MMA(ai, bj, At, Bt) do { __builtin_amdgcn_s_setprio(1); _Pragma("unroll") for (int m = 0; m < 4; ++m) _Pragma("unroll") for (int n = 0; n < 2; ++n) _Pragma("unroll") for (int k = 0; k < 2; ++k) \
        acc[ai][bj][m][n] = __builtin_amdgcn_mfma_f32_16x16x32_bf16(Bt[n][k], At[m][k], acc[ai][bj][m][n], 0, 0, 0); __builtin_amdgcn_s_setprio(0); } while (0)
#define PG8_WAIT_V(n) asm volatile("s_waitcnt vmcnt(" #n ")" ::: "memory")
#define PG8_WAIT_L(n) asm volatile("s_waitcnt lgkmcnt(" #n ")" ::: "memory")
#define PG8_BAR __builtin_amdgcn_s_barrier()
#define PG8_SCHED __builtin_amdgcn_sched_barrier(0)
    Unit cur, nxt; int ui = 0;
    if (!S.next(0, cur)) return;
    f32x4 acc[2][2][4][2];
#pragma unroll
    for (int a = 0; a < 2; ++a)
#pragma unroll
        for (int b = 0; b < 2; ++b)
#pragma unroll
            for (int m = 0; m < 4; ++m)
#pragma unroll
                for (int n = 0; n < 2; ++n) acc[a][b][m][n] = (f32x4){0.f, 0.f, 0.f, 0.f};
    bf16x8 At[4][2], B0[2][2], B1[2][2];
    const char* cA = (const char*)g.A + (size_t)cur.pm * tstep; const char* cB = (const char*)g.Bt + (size_t)cur.pn * tstep;
    if constexpr (SP2) {
        PG8_STAGE(PG8_SB(0, 0), cB, voffB); PG8_STAGE(PG8_SB(0, 1), cB + hstep, voffB); PG8_STAGE(PG8_SA(0, 0), cA, voffA); PG8_STAGE(PG8_SA(0, 1), cA + hstep, voffA);
        if (wr == 1) PG8_BAR;
        PG8_WAIT_V(2); PG8_BAR;
        PG8_STAGE(PG8_SB(1, 0), cB + kstep, voffB); PG8_STAGE(PG8_SA(1, 0), cA + kstep, voffA); PG8_STAGE(PG8_SB(1, 1), cB + hstep + kstep, voffB);
        PG8_WAIT_V(6); PG8_BAR;
    } else {
        PG8_STAGE(PG8_SB(0, 0), cB, voffB); PG8_STAGE(PG8_SA(0, 0), cA, voffA); PG8_STAGE(PG8_SB(0, 1), cB + hstep, voffB); PG8_STAGE(PG8_SA(0, 1), cA + hstep, voffA);
        if (wr == 1) PG8_BAR;
        PG8_WAIT_V(4); PG8_BAR;
        PG8_STAGE(PG8_SB(1, 0), cB + kstep, voffB); PG8_STAGE(PG8_SA(1, 0), cA + kstep, voffA); PG8_STAGE(PG8_SB(1, 1), cB + hstep + kstep, voffB);
        PG8_WAIT_V(6); PG8_BAR;
    }
    for (;;) {
        const bool has_next = S.next(ui + 1, nxt);
        const char* nA = has_next ? (const char*)g.A + (size_t)nxt.pm * tstep : cA; const char* nB = has_next ? (const char*)g.Bt + (size_t)nxt.pn * tstep : cB;
        for (int t = 0; t < nt; t += 2) {
            const bool last = (t == nt - 2);
            const char* a1 = cA + (size_t)(t + 1) * kstep;
            const char* a2 = last ? nA : cA + (size_t)(t + 2) * kstep; const char* b2 = last ? nB : cB + (size_t)(t + 2) * kstep;
            const char* a3 = a2 + kstep; const char* b3 = b2 + kstep;
            if constexpr (SP2) {
            PG8_LDB(B0, 0, 0); PG8_LDB(B1, 0, 1); PG8_SCHED; PG8_LDA(At, 0, 0); PG8_STAGE(PG8_SA(1, 1), a1 + hstep, voffA);
            PG8_WAIT_V(8); PG8_WAIT_L(0); PG8_BAR; PG8_MMA(0, 0, At, B0); PG8_MMA(0, 1, At, B1); PG8_BAR; PG8_SCHED;
            PG8_LDA(At, 0, 1); PG8_STAGE(PG8_SB(0, 0), b2, voffB); PG8_STAGE(PG8_SB(0, 1), b2 + hstep, voffB); PG8_STAGE(PG8_SA(0, 0), a2, voffA);
            PG8_WAIT_V(8); PG8_WAIT_L(0); PG8_BAR; PG8_MMA(1, 0, At, B0); PG8_MMA(1, 1, At, B1); PG8_BAR; PG8_SCHED;
            PG8_LDB(B0, 1, 0); PG8_LDB(B1, 1, 1); PG8_SCHED; PG8_LDA(At, 1, 0); PG8_STAGE(PG8_SA(0, 1), a2 + hstep, voffA);
            PG8_WAIT_V(8); PG8_WAIT_L(0); PG8_BAR; PG8_MMA(0, 0, At, B0); PG8_MMA(0, 1, At, B1); PG8_BAR; PG8_SCHED;
            PG8_LDA(At, 1, 1); PG8_STAGE(PG8_SB(1, 0), b3, voffB); PG8_STAGE(PG8_SB(1, 1), b3 + hstep, voffB); PG8_STAGE(PG8_SA(1, 0), a3, voffA);
            PG8_WAIT_V(8); PG8_WAIT_L(0); PG8_BAR; PG8_MMA(1, 0, At, B0); PG8_MMA(1, 1, At, B1); PG8_BAR; PG8_SCHED;
            } else {
            PG8_LDB(B0, 0, 0); PG8_SCHED; PG8_LDA(At, 0, 0); PG8_STAGE(PG8_SA(1, 1), a1 + hstep, voffA);
            PG8_WAIT_L(8); PG8_BAR; PG8_WAIT_L(0); PG8_MMA(0, 0, At, B0); PG8_BAR; PG8_SCHED;
            PG8_LDB(B1, 0, 1); PG8_STAGE(PG8_SB(0, 0), b2, voffB);
            PG8_BAR; PG8_WAIT_L(0); PG8_MMA(0, 1, At, B1); PG8_BAR;
            PG8_LDA(At, 0, 1); PG8_STAGE(PG8_SA(0, 0), a2, voffA);
            PG8_BAR; PG8_WAIT_L(0); PG8_MMA(1, 0, At, B0); PG8_BAR; PG8_SCHED;
            PG8_STAGE(PG8_SB(0, 1), b2 + hstep, voffB);
            PG8_WAIT_V(6); PG8_BAR; PG8_MMA(1, 1, At, B1); PG8_BAR;
            PG8_LDB(B0, 1, 0); PG8_SCHED; PG8_LDA(At, 1, 0); PG8_STAGE(PG8_SA(0, 1), a2 + hstep, voffA);
            PG8_WAIT_L(8); PG8_BAR; PG8_WAIT_L(0); PG8_MMA(0, 0, At, B0); PG8_BAR; PG8_SCHED;
            PG8_LDB(B1, 1, 1); PG8_STAGE(PG8_SB(1, 0), b3, voffB);
            PG8_BAR; PG8_WAIT_L(0); PG8_MMA(0, 1, At, B1); PG8_BAR;
            PG8_LDA(At, 1, 1); PG8_STAGE(PG8_SA(1, 0), a3, voffA);
            PG8_BAR; PG8_WAIT_L(0); PG8_MMA(1, 0, At, B0); PG8_BAR; PG8_SCHED;
            PG8_STAGE(PG8_SB(1, 1), b3 + hstep, voffB);
            PG8_WAIT_V(6); PG8_BAR; PG8_MMA(1, 1, At, B1); PG8_BAR;
            }
        }
        if constexpr (ALIGN_EPI) { if (wr == 0) PG8_BAR; }
        E(acc, cur, wr, wc, fr, fq);
        if (!has_next) break;
#pragma unroll
        for (int a = 0; a < 2; ++a)
#pragma unroll
            for (int b = 0; b < 2; ++b)
#pragma unroll
                for (int m = 0; m < 4; ++m)
#pragma unroll
                    for (int n = 0; n < 2; ++n) acc[a][b][m][n] = (f32x4){0.f, 0.f, 0.f, 0.f};
        cur = nxt; cA = nA; cB = nB; ++ui;
        if constexpr (ALIGN_EPI) { if (wr == 1) PG8_BAR; }
    }
    PG8_WAIT_V(0);
    if constexpr (!ALIGN_EPI) { if (wr == 0) PG8_BAR; }
    PG8_BAR;
#undef PG8_SA
#undef PG8_SB
#undef PG8_STAGE
#undef PG8_LDA
#undef PG8_LDB
#undef PG8_MMA
#undef PG8_WAIT_V
#undef PG8_WAIT_L
#undef PG8_BAR
#undef PG8_SCHED
}
}

#define XB_TMO      128
#define XB_XCNT(j)  (256  + 64 * (j))
#define XB_XSUB(j)  (1280 + 64 * (j))
#define XB_XGEN(j)  (2304 + 64 * (j))
#define XB_TOP      3328
#define XB_TOPGEN   3392
#define XCD_BAR_WORDS 3456
#define XB_SPIN_CAP (1u << 20)
__device__ __forceinline__ unsigned xb_ld(unsigned* p)              { return __hip_atomic_load(p, __ATOMIC_RELAXED, __HIP_MEMORY_SCOPE_AGENT); }
__device__ __forceinline__ unsigned xb_add(unsigned* p, unsigned v) { return __hip_atomic_fetch_add(p, v, __ATOMIC_RELAXED, __HIP_MEMORY_SCOPE_AGENT); }
__device__ __forceinline__ unsigned xb_xcc_id() { return (unsigned)__builtin_amdgcn_s_getreg((3 << 11) | 20) & 0xFu; }
#define XB_SPIN(cond, bar) do { unsigned _sp = 0; while (cond) { __builtin_amdgcn_s_sleep(1); \
    if ((++_sp & 255u) == 0u) { if (xb_ld(&(bar)[XB_TMO])) break; if (_sp > XB_SPIN_CAP) { atomicAdd(&(bar)[XB_TMO], 1u); break; } } } } while (0)
struct XcdBarrier { unsigned* bar; unsigned x; volatile LAS unsigned* st; };
__device__ __forceinline__ XcdBarrier xcd_barrier_post(unsigned* bar, volatile LAS unsigned* st) {
    XcdBarrier b; b.bar = bar; b.x = xb_xcc_id(); b.st = st;
    if (threadIdx.x == 0) (void)xb_add(&bar[XB_XCNT(b.x)], 1u);
    return b;
}
__device__ __forceinline__ void xcd_barrier_complete(unsigned* bar, unsigned x, unsigned& nloc, unsigned& nx) {
    const unsigned G = gridDim.x * gridDim.y * gridDim.z;
    unsigned sum, cnt, mine, sp = 0u;
    for (;;) {
        sum = 0u; cnt = 0u; mine = 0u;
#pragma unroll
        for (unsigned j = 0; j < 16; ++j) { const unsigned c = xb_ld(&bar[XB_XCNT(j)]); sum += c; cnt += (c > 0u) ? 1u : 0u; mine = (j == x) ? c : mine; }
        if (sum == G) break;
        __builtin_amdgcn_s_sleep(1);
        if ((++sp & 255u) == 0u) { if (xb_ld(&bar[XB_TMO])) break; if (sp > XB_SPIN_CAP) { atomicAdd(&bar[XB_TMO], 1u); break; } }
    }
    nloc = mine > 0u ? mine : 1u; nx = cnt > 0u ? cnt : 1u;
}
__device__ __forceinline__ void xcd_barrier(const XcdBarrier& b) {
    asm volatile("s_waitcnt vmcnt(0)" ::: "memory");
    __syncthreads();
    if (threadIdx.x == 0) {
        unsigned* bar = b.bar;
        __builtin_amdgcn_s_waitcnt(0);
        unsigned nloc = b.st[0], nx = b.st[1];
        if (nloc == 0u) { xcd_barrier_complete(bar, b.x, nloc, nx); b.st[0] = nloc; b.st[1] = nx; }
        const unsigned old = xb_add(&bar[XB_XSUB(b.x)], 1u);
        const unsigned gen = old / nloc;
        if (old + 1u == (gen + 1u) * nloc) {
            __builtin_amdgcn_fence(__ATOMIC_RELEASE, "agent");
            asm volatile("s_waitcnt vmcnt(0)" ::: "memory");
            const unsigned og = xb_add(&bar[XB_TOP], 1u);
            const unsigned tg = og / nx;
            if (og + 1u == (tg + 1u) * nx) xb_add(&bar[XB_TOPGEN], 1u);
            else XB_SPIN(xb_ld(&bar[XB_TOPGEN]) == tg, bar);
            __builtin_amdgcn_fence(__ATOMIC_ACQUIRE, "agent");
            xb_add(&bar[XB_XGEN(b.x)], 1u);
            asm volatile("s_waitcnt vmcnt(0)" ::: "memory");
        } else {
            XB_SPIN(xb_ld(&bar[XB_XGEN(b.x)]) == gen, bar);
            __builtin_amdgcn_fence(__ATOMIC_ACQUIRE, "agent");
            asm volatile("s_waitcnt vmcnt(0)" ::: "memory");
        }
    }
    __syncthreads();
}

struct Args { const float* in[28]; float* out; unsigned char* ws; int ph_lo, ph_hi; };
enum { I_X = 0, I_FFN_NORM, I_WG, I_WU, I_WD, I_MIX_NORM, I_WIN, I_WOUT, I_QN, I_KN, I_MU, I_W0, I_WUP, I_A0, I_AUP, I_GUP, I_KK, I_KA, I_RK, I_GNW, I_GNB, I_V0, I_VDOWN, I_VUP, I_CONV, I_ALOG, I_DTB, I_ONORM };

typedef const __attribute__((address_space(4))) Args* ArgsP;
struct Ctx {
    LAS unsigned char* lds;
    int tid, lane, wave, G, bid;
    ArgsP a;
};

template <class Get>
__device__ __forceinline__ void cvt_item(Get get, int K, bf16_t* WT, LAS float* scr, int kb, int nb, int lane) {
    const int k0 = 64 * kb, n0 = 32 * nb;
#pragma unroll 8
    for (int i = 0; i < 32; ++i) { const int kk = 2 * i + (lane >> 5); scr[kk * 33 + (lane & 31)] = get(k0 + kk, n0 + (lane & 31)); }
    asm volatile("s_waitcnt lgkmcnt(0)" ::: "memory");
    const int c = lane & 7;
#pragma unroll
    for (int j = 0; j < 4; ++j) { const int n = (lane >> 3) + 8 * j; const LAS float* s = scr + (8 * c) * 33 + n;
        u32x4 o; o.x = pk2(s[0 * 33], s[1 * 33]); o.y = pk2(s[2 * 33], s[3 * 33]); o.z = pk2(s[4 * 33], s[5 * 33]); o.w = pk2(s[6 * 33], s[7 * 33]);
        *(u32x4*)(WT + (size_t)(n0 + n) * K + k0 + 8 * c) = o; }
    asm volatile("s_waitcnt lgkmcnt(0)" ::: "memory");
}
__device__ __forceinline__ int win_cmap(int nn) {
    if (nn < 1352) return nn;
    if (nn < 1356) return 3272 + (nn - 1352);
    if (nn < 1360) return 3276 + (nn - 1356);
    if (nn < 1408) return -1;
    if (nn < 2304) return 1352 + (nn - 1408);
    return 2248 + (nn - 2304);
}
__device__ __forceinline__ void convert_layer_weights(const Ctx& C, int l) {
    const ArgsP Ap = C.a;
    LAS float* scr = (LAS float*)(C.lds + C.wave * 16384);
    unsigned char* wb = Ap->ws + WS_W;
    const int gw = C.bid * 8 + C.wave, NGW = C.G * 8;
    constexpr int I_GU = (DM / 64) * (NGU / 32), I_D = (FF / 64) * (DM / 32), I_IN = (DM / 64) * (NIN / 32), I_OUT = (DM / 64) * (DM / 32);
    constexpr int NIT = 2 * I_GU + 2 * I_D + I_IN + I_OUT;
    for (int it = gw; it < NIT; it += NGW) {
        int r = it;
        if (r < 2 * I_GU) { const int f = r / I_GU; r -= f * I_GU; const int nblk = NGU / 32, kb = r / nblk, nb = r % nblk;
            const float* wg = Ap->in[I_WG] + (size_t)(l * 2 + f) * DM * FF; const float* wu = Ap->in[I_WU] + (size_t)(l * 2 + f) * DM * FF; const float* gv = Ap->in[I_FFN_NORM] + (size_t)(l * 2 + f) * DM;
            auto get = [=](int k, int nn) -> float { const int pn = nn >> 8, bj = (nn >> 7) & 1, j = nn & 127; const float* w = bj ? wu : wg; return w[(size_t)k * FF + pn * 128 + j] * gv[k]; };
            cvt_item(get, DM, (bf16_t*)(wb + (f ? W_GU2 : W_GU1)), scr, kb, nb, C.lane); continue; }
        r -= 2 * I_GU;
        if (r < 2 * I_D) { const int f = r / I_D; r -= f * I_D; const int nblk = DM / 32, kb = r / nblk, nb = r % nblk;
            const float* wd = Ap->in[I_WD] + (size_t)(l * 2 + f) * FF * DM;
            auto get = [=](int k, int nn) -> float { return wd[(size_t)k * DM + nn]; };
            cvt_item(get, FF, (bf16_t*)(wb + (f ? W_D2 : W_D1)), scr, kb, nb, C.lane); continue; }
        r -= 2 * I_D;
        if (r < I_IN) { const int nblk = NIN / 32, kb = r / nblk, nb = r % nblk;
            const float* wi = Ap->in[I_WIN] + (size_t)l * DM * 3280; const float* gv = Ap->in[I_MIX_NORM] + (size_t)l * DM;
            auto get = [=](int k, int nn) -> float { const int c = win_cmap(nn); return c < 0 ? 0.f : wi[(size_t)k * 3280 + c] * gv[k]; };
            cvt_item(get, DM, (bf16_t*)(wb + W_IN), scr, kb, nb, C.lane); continue; }
        r -= I_IN;
        { const int nblk = DM / 32, kb = r / nblk, nb = r % nblk;
            const float* wo = Ap->in[I_WOUT] + (size_t)l * DM * DM;
            auto get = [=](int k, int nn) -> float { return wo[(size_t)k * DM + nn]; };
            cvt_item(get, DM, (bf16_t*)(wb + W_OUT), scr, kb, nb, C.lane); }
    }
}

__device__ const float ROPE_INV_HI[32] = {1.000000000e+00f, 7.498942018e-01f, 5.623413324e-01f, 4.216965139e-01f, 3.162277639e-01f, 2.371373773e-01f, 1.778279394e-01f, 1.333521456e-01f, 1.000000015e-01f, 7.498942316e-02f, 5.623413250e-02f, 4.216964915e-02f, 3.162277490e-02f, 2.371373773e-02f, 1.778279431e-02f, 1.333521400e-02f, 9.999999776e-03f, 7.498942316e-03f, 5.623413250e-03f, 4.216964822e-03f, 3.162277630e-03f, 2.371373819e-03f, 1.778279431e-03f, 1.333521446e-03f, 1.000000047e-03f, 7.498941850e-04f, 5.623413017e-04f, 4.216965172e-04f, 3.162277571e-04f, 2.371373703e-04f, 1.778279402e-04f, 1.333521504e-04f};
__device__ const float ROPE_INV_LO[32] = {0.000000000e+00f, 7.576931971e-09f, -7.245258615e-09f, -1.046263787e-08f, 2.125617904e-09f, -6.695950017e-09f, 1.612756151e-09f, -2.336302707e-09f, -1.490116142e-09f, -2.222539042e-09f, 2.053218012e-11f, 1.188910415e-09f, 1.702677888e-09f, -6.695949906e-10f, -2.112534175e-10f, 3.251632574e-10f, 2.235174129e-10f, -2.222539097e-10f, 2.053217839e-12f, 2.120233017e-10f, 3.056940465e-11f, -1.135256264e-10f, -2.112534106e-11f, -1.404980212e-11f, -4.749745042e-11f, 2.434073776e-11f, 2.348838658e-11f, -1.372226725e-11f, 8.877706729e-12f, 2.889693693e-13f, 7.978488746e-13f, -7.225746477e-12f};
__device__ __forceinline__ void prologue_x(const Ctx& C) {
    const ArgsP Ap = C.a;
    const float* x = Ap->in[I_X]; bf16_t* xbf = (bf16_t*)(Ap->ws + WS_XBF); float* ssq = (float*)(Ap->ws + WS_SSQ);
    const int gw = C.bid * 8 + C.wave, NGW = C.G * 8;
    for (int m = gw; m < MTOK; m += NGW) {
        const f32x4* xr = (const f32x4*)(x + (size_t)m * DM) + C.lane;
        f32x4 v[4]; float s = 0.f;
#pragma unroll
        for (int j = 0; j < 4; ++j) { v[j] = xr[64 * j]; s += (v[j][0] * v[j][0] + v[j][1] * v[j][1]) + (v[j][2] * v[j][2] + v[j][3] * v[j][3]); }
        s = wave_sum(s);
        u32x2* o8 = (u32x2*)(xbf + (size_t)m * DM) + C.lane;
#pragma unroll
        for (int j = 0; j < 4; ++j) { u32x2 w; w.x = pk2(v[j][0], v[j][1]); w.y = pk2(v[j][2], v[j][3]); o8[64 * j] = w; }
        if (C.lane < 16) ssq[(size_t)m * 16 + C.lane] = (C.lane == 0) ? s : 0.f;
    }
    f32x2* cs = (f32x2*)(Ap->ws + WS_ROPE);
    const int gt = C.bid * 512 + C.tid, NT = C.G * 512;
    for (int e = gt; e < SEQ * 32; e += NT) {
        const int pos = e >> 5, i = e & 31;
        const float fpos = (float)pos, ih = ROPE_INV_HI[i], il = ROPE_INV_LO[i];
        const float ph = fpos * ih; const float pe = fmaf(fpos, ih, -ph) + fpos * il;
        const float k = rintf(ph * 0.15915494309189535f);
        float r = fmaf(-k, 6.2831854820251465f, ph); r = fmaf(-k, -1.7484555e-07f, r); r += pe;
        const float r2 = r * r;
        float ts = 1.f, tc = 1.f;
        ts = 1.f - ts * r2 * (1.f / (18.f * 19.f)); ts = 1.f - ts * r2 * (1.f / (16.f * 17.f)); ts = 1.f - ts * r2 * (1.f / (14.f * 15.f)); ts = 1.f - ts * r2 * (1.f / (12.f * 13.f));
        ts = 1.f - ts * r2 * (1.f / (10.f * 11.f)); ts = 1.f - ts * r2 * (1.f / (8.f * 9.f)); ts = 1.f - ts * r2 * (1.f / (6.f * 7.f)); ts = 1.f - ts * r2 * (1.f / (4.f * 5.f)); ts = 1.f - ts * r2 * (1.f / (2.f * 3.f));
        tc = 1.f - tc * r2 * (1.f / (19.f * 20.f)); tc = 1.f - tc * r2 * (1.f / (17.f * 18.f)); tc = 1.f - tc * r2 * (1.f / (15.f * 16.f)); tc = 1.f - tc * r2 * (1.f / (13.f * 14.f)); tc = 1.f - tc * r2 * (1.f / (11.f * 12.f));
        tc = 1.f - tc * r2 * (1.f / (9.f * 10.f)); tc = 1.f - tc * r2 * (1.f / (7.f * 8.f)); tc = 1.f - tc * r2 * (1.f / (5.f * 6.f)); tc = 1.f - tc * r2 * (1.f / (3.f * 4.f)); tc = 1.f - tc * r2 * (1.f / (1.f * 2.f));
        cs[e] = (f32x2){tc, ts * r};
    }
}

__device__ __forceinline__ void prep_phase(const Ctx& C, int l) {
    const ArgsP Ap = C.a;
    bf16_t* P = (bf16_t*)(Ap->ws + WS_P);
    const f32x2* cs = (const f32x2*)(Ap->ws + WS_ROPE);
    const float* qn = Ap->in[I_QN] + l * 64; const float* kn = Ap->in[I_KN] + l * 64;
    {
        const int gw = C.bid * 8 + C.wave, NGW = C.G * 8; const int hl = C.lane >> 5, i = C.lane & 31;
        for (int m = gw; m < MTOK; m += NGW) {
            const int pos = m & (SEQ - 1); const f32x2 c = cs[pos * 32 + i];
            bf16_t* row = P + (size_t)m * NIN;
#pragma unroll 1
            for (int hp = 0; hp < 10; ++hp) {
                const int hd = hp * 2 + hl; if (hd >= 19) continue;
                int col; const float* nw = nullptr; float sc = 1.f;
                if (hd < 8) { col = PQ + hd * 64; nw = qn; sc = 0.125f; } else if (hd < 10) { col = PK + (hd - 8) * 64; nw = kn; } else if (hd < 18) { col = PQI + (hd - 10) * 64; } else { col = PKI; }
                float x1 = bf2f(row[col + i]), x2 = bf2f(row[col + 32 + i]);
                if (nw) { float ss = x1 * x1 + x2 * x2;
#pragma unroll
                    for (int o = 1; o < 32; o <<= 1) ss += __shfl_xor(ss, o);
                    const float rs = rsqrtf(ss * (1.f / 64.f) + NORM_EPS) * sc; x1 = x1 * rs * nw[i]; x2 = x2 * rs * nw[i + 32]; }
                const float o1 = x1 * c[0] - x2 * c[1], o2 = x2 * c[0] + x1 * c[1];
                row[col + i] = (bf16_t)f2bf(o1); row[col + 32 + i] = (bf16_t)f2bf(o2);
            }
        }
    }
    {
        bf16_t* LO = (bf16_t*)(Ap->ws + WS_XBF);
        LAS float* in128 = (LAS float*)C.lds;
        LAS float* vt = (LAS float*)(C.lds + 32768);
        LAS float* vd = (LAS float*)(C.lds + 32768 + 65536);
        const float* mu = Ap->in[I_MU] + l * 896;
        const int c0 = C.tid & 255, half = C.tid >> 8;
        for (int tile = C.bid; tile < MTOK / 64; tile += C.G) {
            const int m0 = tile * 64;
            int c = c0; asm volatile("" : "+v"(c));
            __syncthreads();
            for (int e = C.tid; e < 64 * 128; e += 512) { const int t = e >> 7, j = e & 127; const int m = m0 + t; const bf16_t* row = P + (size_t)m * NIN + PRW + 768;
                const float cur = bf2f(row[j]); const float prev = (m & (SEQ - 1)) ? bf2f(row[j - NIN]) : 0.f; float h = cur + (prev - cur) * mu[768 + j];
                if (j < 32) h = tanhf(h); else if (j >= 64) h = sigmoidf_(h);
                in128[e] = h; }
            if (l > 0) {
                for (int e = C.tid; e < 64 * 256; e += 512) { const int t = e >> 8, j = e & 255; const int m = m0 + t; const bf16_t* row = P + (size_t)m * NIN + PRW + 512;
                    const float cur = bf2f(row[j]); const float prev = (m & (SEQ - 1)) ? bf2f(row[j - NIN]) : 0.f; vt[e] = cur + (prev - cur) * mu[512 + j]; }
                __syncthreads();
                const float* vdn = Ap->in[I_VDOWN] + (size_t)(l - 1) * 256 * 32;
                for (int e = C.tid; e < 64 * 32; e += 512) { const int t = e >> 5, j = e & 31; float s = 0.f;
                    for (int k = 0; k < 256; ++k) s += vt[t * 256 + k] * vdn[k * 32 + j];
                    vd[e] = s; }
            }
            __syncthreads();
            const int tb = half * 32;
            { const float* wup = Ap->in[I_WUP] + (size_t)l * 32 * 256; float w[32];
#pragma unroll
              for (int j = 0; j < 32; ++j) w[j] = wup[j * 256 + c];
              const float w0 = Ap->in[I_W0][l * 256 + c];
              asm volatile("" ::: "memory");
#pragma unroll 1
              for (int t = tb; t < tb + 32; ++t) { float s = w0;
#pragma unroll
                  for (int j = 0; j < 32; ++j) s += in128[t * 128 + j] * w[j];
                  const float wlog = -softplusf_(-s) - 0.5f; LO[(size_t)(m0 + t) * 1024 + c] = (bf16_t)f2bf(-__expf(wlog)); } }
            { const float* aup = Ap->in[I_AUP] + (size_t)l * 32 * 256; float w[32];
#pragma unroll
              for (int j = 0; j < 32; ++j) w[j] = aup[j * 256 + c];
              const float a0 = Ap->in[I_A0][l * 256 + c];
              asm volatile("" ::: "memory");
#pragma unroll 1
              for (int t = tb; t < tb + 32; ++t) { float s = a0;
#pragma unroll
                  for (int j = 0; j < 32; ++j) s += in128[t * 128 + 32 + j] * w[j];
                  LO[(size_t)(m0 + t) * 1024 + 256 + c] = (bf16_t)f2bf(sigmoidf_(s)); } }
            { const float* gup = Ap->in[I_GUP] + (size_t)l * 64 * 256; float w[64];
#pragma unroll
              for (int j = 0; j < 64; ++j) w[j] = gup[j * 256 + c];
              asm volatile("" ::: "memory");
#pragma unroll 1
              for (int t = tb; t < tb + 32; ++t) { float s = 0.f;
#pragma unroll
                  for (int j = 0; j < 64; ++j) s += in128[t * 128 + 64 + j] * w[j];
                  LO[(size_t)(m0 + t) * 1024 + 512 + c] = (bf16_t)f2bf(s); } }
            if (l > 0) { const float* vup = Ap->in[I_VUP] + (size_t)(l - 1) * 32 * 256; float w[32];
#pragma unroll
              for (int j = 0; j < 32; ++j) w[j] = vup[j * 256 + c];
              const float v0 = Ap->in[I_V0][(l - 1) * 256 + c];
              asm volatile("" ::: "memory");
#pragma unroll 1
              for (int t = tb; t < tb + 32; ++t) { float s = v0;
#pragma unroll
                  for (int j = 0; j < 32; ++j) s += vd[t * 32 + j] * w[j];
                  LO[(size_t)(m0 + t) * 1024 + 768 + c] = (bf16_t)f2bf(sigmoidf_(s)); } }
        }
        __syncthreads();
    }
}

constexpr int CK_ST = 144, CK_MAT = 64 * CK_ST, CK_FS = 68;
template <int MODE> struct CkL {
    static constexpr int YA = 0, XB = CK_MAT, XK = 2 * CK_MAT;
    static constexpr int YR = 3 * CK_MAT, ATS = 4 * CK_MAT, RTS = 5 * CK_MAT;
    static constexpr int B0 = MODE == 0 ? 3 * CK_MAT : 6 * CK_MAT;
    static constexpr int VT = B0, BBT = B0 + CK_MAT, KBT = B0 + 2 * CK_MAT, MBR = BBT, MKR = KBT, NAK = B0 + 3 * CK_MAT, WBF = B0 + 4 * CK_MAT;
    static constexpr int S0 = WBF + CK_MAT;
    static constexpr int F0 = MODE == 0 ? B0 + 6 * CK_MAT : B0 + 6 * CK_MAT;
    static constexpr int NAB = F0;
    static constexpr int Z = NAB + 64 * CK_FS * 4;
    static constexpr int TJ = Z + (MODE == 0 ? 128 : 64) * CK_FS * 4;
    static constexpr int SC = TJ + 4096;
    static constexpr int END = SC + (3 * 64 + 512) * 4;
};
static_assert(CkL<0>::END <= LDS_MISC && CkL<1>::END <= LDS_MISC, "chunk lds");

constexpr size_t WS_PST = 224 * MiB, WS_DS = 240 * MiB;
constexpr int CW_CNTA = 12288, CW_FLAGB = 14336;

__device__ __forceinline__ void mm2(f32x4 (&c)[2], const LAS unsigned char* A, const LAS unsigned char* B, int tm, int tn0, int lane) {
    const int r = lane & 15, g = lane >> 4;
#pragma unroll
    for (int s = 0; s < 2; ++s) {
        const bf16x8 a = *(const LAS bf16x8*)(A + (tm * 16 + r) * CK_ST + (32 * s + 8 * g) * 2);
#pragma unroll
        for (int q = 0; q < 2; ++q) { const bf16x8 b = *(const LAS bf16x8*)(B + ((tn0 + q) * 16 + r) * CK_ST + (32 * s + 8 * g) * 2);
            c[q] = __builtin_amdgcn_mfma_f32_16x16x32_bf16(a, b, c[q], 0, 0, 0); }
    }
}
__device__ __forceinline__ void st_bf(LAS unsigned char* base, int row, int col, float v) { *(LAS bf16_t*)(base + row * CK_ST + col * 2) = (bf16_t)f2bf(v); }
__device__ __forceinline__ void st8_bf(LAS unsigned char* base, int row, int col0, const float (&v)[8]) {
    u32x4 w; w.x = pk2(v[0], v[1]); w.y = pk2(v[2], v[3]); w.z = pk2(v[4], v[5]); w.w = pk2(v[6], v[7]); *(LAS u32x4*)(base + row * CK_ST + col0 * 2) = w; }

struct CkTok { float ya[8], xb[8], xk[8], yr[8], ats[8], rts[8], bb[8], kb[8], v[8], gs[8], bs[8], p0[8], p1[8], p2[8]; float gam; };

template <int MODE>
__device__ __forceinline__ void rwkv_prep(const Ctx& C, int l, int b, int h, int n, CkTok& K, LAS float* wsum) {
    const ArgsP Ap = C.a; const int lane = C.lane, w = C.wave, ch = h * 64 + lane;
    const bf16_t* P = (const bf16_t*)(Ap->ws + WS_P); const bf16_t* LO = (const bf16_t*)(Ap->ws + WS_XBF); bf16_t* VF = (bf16_t*)(Ap->ws + WS_VF);
    const float* mu = Ap->in[I_MU] + l * 896;
    const float mu_r = mu[ch], mu_k = mu[256 + ch], mu_v = mu[512 + ch];
    const float k_k = Ap->in[I_KK][l * 256 + ch], k_a = Ap->in[I_KA][l * 256 + ch], r_k = Ap->in[I_RK][l * 256 + ch];
    const int tq0 = n * 64 + 8 * w;
    const size_t m0 = (size_t)b * SEQ + tq0;
    float rp = 0.f, kp = 0.f, vp = 0.f;
    if (tq0 > 0) { const bf16_t* row = P + (m0 - 1) * NIN + PRW; rp = bf2f(row[ch]); kp = bf2f(row[256 + ch]); vp = bf2f(row[512 + ch]); }
    float lw[8], as[8], bs_[8], k2[8], rr[8];
#pragma unroll
    for (int tt = 0; tt < 8; ++tt) {
        const size_t m = m0 + tt; const bf16_t* row = P + m * NIN + PRW; const bf16_t* lo = LO + m * 1024;
        const float rc = bf2f(row[ch]), kc = bf2f(row[256 + ch]), vc = bf2f(row[512 + ch]);
        const float r = rc + (rp - rc) * mu_r, k = kc + (kp - kc) * mu_k; float v = vc + (vp - vc) * mu_v;
        rp = rc; kp = kc; vp = vc;
        const float wl = bf2f(lo[ch]), a = bf2f(lo[256 + ch]);
        if (l == 0) { if (MODE == 0) VF[m * 256 + ch] = (bf16_t)f2bf(v); }
        else { const float vg = bf2f(lo[768 + ch]); const float vf = bf2f(VF[m * 256 + ch]); v = v + (vf - v) * vg; }
        const float kkp = k * k_k; const float n2 = wave_sum(kkp * kkp); const float kk = kkp * rsqrtf(n2 + 1e-12f);
        k2[tt] = k * (1.f + (a - 1.f) * k_a); as[tt] = -kk; bs_[tt] = kk * a; rr[tt] = r; lw[tt] = wl; K.v[tt] = v;
        if (MODE == 1) { K.p0[tt] = wave_sum(r * k2[tt] * r_k); K.p1[tt] = bf2f(lo[512 + ch]); K.p2[tt] = 0.f; }
    }
    float g[8]; g[0] = lw[0];
#pragma unroll
    for (int tt = 1; tt < 8; ++tt) g[tt] = g[tt - 1] + lw[tt];
    wsum[w * 64 + lane] = g[7];
    __syncthreads();
    float pre = 0.f, tot = 0.f;
#pragma unroll
    for (int ww = 0; ww < 8; ++ww) { const float s = wsum[ww * 64 + lane]; tot += s; if (ww < w) pre += s; }
    K.gam = __expf(tot);
#pragma unroll
    for (int tt = 0; tt < 8; ++tt) {
        const float G = pre + g[tt], Gp = G - lw[tt];
        const float eG = __expf(G), eGi = __expf(-G), eGp = __expf(Gp), eT = __expf(tot - G);
        K.ya[tt] = as[tt] * eGp; K.xb[tt] = bs_[tt] * eGi; K.xk[tt] = k2[tt] * eGi; K.yr[tt] = rr[tt] * eG; K.ats[tt] = K.ya[tt]; K.rts[tt] = K.yr[tt];
        K.bb[tt] = bs_[tt] * eT; K.kb[tt] = k2[tt] * eT; K.gs[tt] = 0.f; K.bs[tt] = 1.f;
    }
}
template <int MODE>
__device__ __forceinline__ void gdn_prep(const Ctx& C, int l, int b, int h, int n, CkTok& K, LAS float* wsum) {
    const ArgsP Ap = C.a; const int lane = C.lane, w = C.wave, ch = h * 64 + lane;
    const bf16_t* P = (const bf16_t*)(Ap->ws + WS_P);
    const float* cw = Ap->in[I_CONV] + (size_t)l * 4 * 768;
    float wq[4], wk[4], wv[4];
#pragma unroll
    for (int j = 0; j < 4; ++j) { wq[j] = cw[j * 768 + ch]; wk[j] = cw[j * 768 + 256 + ch]; wv[j] = cw[j * 768 + 512 + ch]; }
    const float nexpa = -__expf(Ap->in[I_ALOG][l * 4 + h]), dtb = Ap->in[I_DTB][l * 4 + h];
    const int tq0 = n * 64 + 8 * w; const size_t m0 = (size_t)b * SEQ + tq0;
    float xq[3], xk[3], xv[3];
#pragma unroll
    for (int d = 0; d < 3; ++d) { const int t = tq0 - 3 + d; xq[d] = 0.f; xk[d] = 0.f; xv[d] = 0.f;
        if (t >= 0) { const bf16_t* rr = P + (m0 - 3 + d) * NIN + PGD; xq[d] = bf2f(rr[ch]); xk[d] = bf2f(rr[256 + ch]); xv[d] = bf2f(rr[512 + ch]); } }
    float lw[8], kr[8], qr[8], be[8];
#pragma unroll
    for (int tt = 0; tt < 8; ++tt) {
        const size_t m = m0 + tt; const bf16_t* row = P + m * NIN;
        const float cq = bf2f(row[PGD + ch]), ck = bf2f(row[PGD + 256 + ch]), cv = bf2f(row[PGD + 512 + ch]);
        float sq = wq[0] * xq[0] + wq[1] * xq[1] + wq[2] * xq[2] + wq[3] * cq;
        float sk = wk[0] * xk[0] + wk[1] * xk[1] + wk[2] * xk[2] + wk[3] * ck;
        float sv = wv[0] * xv[0] + wv[1] * xv[1] + wv[2] * xv[2] + wv[3] * cv;
        xq[0] = xq[1]; xq[1] = xq[2]; xq[2] = cq; xk[0] = xk[1]; xk[1] = xk[2]; xk[2] = ck; xv[0] = xv[1]; xv[1] = xv[2]; xv[2] = cv;
        sq = siluf_(sq); sk = siluf_(sk); sv = siluf_(sv);
        qr[tt] = sq * rsqrtf(wave_sum(sq * sq) + 1e-6f) * 0.125f; kr[tt] = sk * rsqrtf(wave_sum(sk * sk) + 1e-6f); K.v[tt] = sv;
        be[tt] = sigmoidf_(bf2f(row[PGB + h])); lw[tt] = nexpa * softplusf_(bf2f(row[PGA + h]) + dtb);
        if (MODE == 1) { K.p0[tt] = siluf_(bf2f(row[PGD + 768 + ch])); K.p1[tt] = 0.f; K.p2[tt] = 0.f; }
    }
    float g[8]; g[0] = lw[0];
#pragma unroll
    for (int tt = 1; tt < 8; ++tt) g[tt] = g[tt - 1] + lw[tt];
    wsum[w * 64 + lane] = g[7];
    __syncthreads();
    float pre = 0.f, tot = 0.f;
#pragma unroll
    for (int ww = 0; ww < 8; ++ww) { const float s = wsum[ww * 64 + lane]; tot += s; if (ww < w) pre += s; }
    K.gam = __expf(tot);
#pragma unroll
    for (int tt = 0; tt < 8; ++tt) {
        const float G = pre + g[tt]; const float eG = __expf(G), eT = __expf(tot - G);
        K.ya[tt] = kr[tt]; K.xb[tt] = -kr[tt]; K.xk[tt] = kr[tt]; K.yr[tt] = qr[tt]; K.ats[tt] = kr[tt] * eG; K.rts[tt] = qr[tt] * eG;
        K.bb[tt] = -be[tt] * kr[tt] * eT; K.kb[tt] = be[tt] * kr[tt] * eT; K.gs[tt] = G; K.bs[tt] = be[tt];
    }
}

template <int MODE>
__device__ __forceinline__ void chunk_item(const Ctx& C, int l, int combo, int n) {
    typedef CkL<MODE> L;
    int lane_o = C.lane; asm volatile("" : "+v"(lane_o));
    const ArgsP Ap = C.a; const int lane = lane_o, w = C.wave, tid = w * 64 + lane, r16 = lane & 15, g4 = lane >> 4;
    const int mix = combo >> 3, bh = combo & 7, b = bh >> 2, h = bh & 3;
    LAS unsigned char* lds = C.lds;
    LAS float* NAB = (LAS float*)(lds + L::NAB); LAS float* Z = (LAS float*)(lds + L::Z); LAS float* TJ = (LAS float*)(lds + L::TJ);
    LAS float* Gs = (LAS float*)(lds + L::SC); LAS float* Bs = Gs + 64; LAS float* Gam = Gs + 128; LAS float* wsum = Gs + 192;
    bf16_t* PSTg = (bf16_t*)(Ap->ws + WS_PST) + ((size_t)combo * 128 + n) * 4096;
    bf16_t* DSg = (bf16_t*)(Ap->ws + WS_DS) + ((size_t)combo * 128 + n) * 4096;
    __syncthreads();
    CkTok K;
    Ctx C2 = C; C2.lane = lane; C2.tid = tid;
    if (mix == 0) rwkv_prep<MODE>(C2, l, b, h, n, K, wsum); else gdn_prep<MODE>(C2, l, b, h, n, K, wsum);
#pragma unroll
    for (int tt = 0; tt < 8; ++tt) { const int t = 8 * w + tt;
        st_bf(lds + L::YA, t, lane, K.ya[tt]); st_bf(lds + L::XB, t, lane, K.xb[tt]); st_bf(lds + L::XK, t, lane, K.xk[tt]);
        if (MODE == 1) { st_bf(lds + L::YR, t, lane, K.yr[tt]); st_bf(lds + L::ATS, t, lane, K.ats[tt]); st_bf(lds + L::RTS, t, lane, K.rts[tt]); } }
    st8_bf(lds + L::VT, lane, 8 * w, K.v);
    if (MODE == 0) { st8_bf(lds + L::BBT, lane, 8 * w, K.bb); st8_bf(lds + L::KBT, lane, 8 * w, K.kb);
#pragma unroll
        for (int tt = 0; tt < 8; ++tt) Z[(64 + lane) * CK_FS + 8 * w + tt] = K.ats[tt];
        if (w == 0) Gam[lane] = K.gam; }
#pragma unroll
    for (int tt = 0; tt < 8; ++tt) if (lane == tt) { Gs[8 * w + tt] = K.gs[tt]; Bs[8 * w + tt] = K.bs[tt]; }
    if (MODE == 1) {
        const int vi = tid >> 3, c8 = (tid & 7) * 8;
        u32x4 v = (u32x4){0u, 0u, 0u, 0u};
        if (n > 0) v = *(const u32x4*)(DSg - 4096 + vi * 64 + c8);
        *(LAS u32x4*)(lds + L::S0 + vi * CK_ST + c8 * 2) = v;
    }
    __syncthreads();
    const int tm = w >> 1, tn0 = 2 * (w & 1);
    {
        f32x4 cab[2] = {{0.f, 0.f, 0.f, 0.f}, {0.f, 0.f, 0.f, 0.f}}, cak[2] = {{0.f, 0.f, 0.f, 0.f}, {0.f, 0.f, 0.f, 0.f}};
        mm2(cab, lds + L::YA, lds + L::XB, tm, tn0, lane); mm2(cak, lds + L::YA, lds + L::XK, tm, tn0, lane);
        f32x4 cbr[2] = {{0.f, 0.f, 0.f, 0.f}, {0.f, 0.f, 0.f, 0.f}}, ckr[2] = {{0.f, 0.f, 0.f, 0.f}, {0.f, 0.f, 0.f, 0.f}};
        if (MODE == 1) { mm2(cbr, lds + L::YR, lds + L::XB, tm, tn0, lane); mm2(ckr, lds + L::YR, lds + L::XK, tm, tn0, lane); }
#pragma unroll
        for (int q = 0; q < 2; ++q) { const int i = 16 * (tn0 + q) + r16; const float gi = Gs[i], bi = Bs[i];
#pragma unroll
            for (int rg = 0; rg < 4; ++rg) { const int t = 16 * tm + 4 * g4 + rg; const float f = (i <= t) ? bi * __expf(Gs[t] - gi) : 0.f; const float fs = (i < t) ? f : 0.f;
                NAB[t * CK_FS + i] = cab[q][rg] * fs; st_bf(lds + L::NAK, t, i, cak[q][rg] * fs);
                if (MODE == 1) { st_bf(lds + L::MBR, t, i, cbr[q][rg] * f); st_bf(lds + L::MKR, t, i, ckr[q][rg] * f); } } }
    }
    __syncthreads();
    {
        f32x4 cx[2] = {{0.f, 0.f, 0.f, 0.f}, {0.f, 0.f, 0.f, 0.f}};
        mm2(cx, lds + L::VT, lds + L::NAK, tm, tn0, lane);
        if (MODE == 1) mm2(cx, lds + L::S0, lds + L::ATS, tm, tn0, lane);
#pragma unroll
        for (int q = 0; q < 2; ++q)
#pragma unroll
            for (int rg = 0; rg < 4; ++rg) Z[(16 * tm + 4 * g4 + rg) * CK_FS + 16 * (tn0 + q) + r16] = cx[q][rg];
    }
    if (w == 0) {
        const int J = g4, r = r16; float T[16];
#pragma unroll
        for (int c = 0; c < 16; ++c) { float s = (c == r) ? 1.f : 0.f;
#pragma unroll
            for (int mm = 0; mm < 16; ++mm) if (mm < c) s += T[mm] * NAB[(16 * J + c) * CK_FS + 16 * J + mm];
            T[c] = s; }
#pragma unroll
        for (int c = 0; c < 16; ++c) TJ[J * 256 + r * 16 + c] = T[c];
    }
    __syncthreads();
    if (MODE == 0 || w < 4) {
        const int r0 = 16 * w;
#pragma unroll
        for (int J = 0; J < 4; ++J) {
            f32x4 acc;
#pragma unroll
            for (int rg = 0; rg < 4; ++rg) acc[rg] = Z[(r0 + 4 * g4 + rg) * CK_FS + 16 * J + r16];
#pragma unroll
            for (int I = 0; I < 4; ++I) if (I < J) {
#pragma unroll
                for (int q = 0; q < 4; ++q) { const float a = Z[(r0 + r16) * CK_FS + 16 * I + 4 * q + g4]; const float bq = NAB[(16 * J + r16) * CK_FS + 16 * I + 4 * q + g4];
                    acc = __builtin_amdgcn_mfma_f32_16x16x4f32(a, bq, acc, 0, 0, 0); } }
#pragma unroll
            for (int rg = 0; rg < 4; ++rg) Z[(r0 + 4 * g4 + rg) * CK_FS + 16 * J + r16] = acc[rg];
            f32x4 wv = {0.f, 0.f, 0.f, 0.f};
#pragma unroll
            for (int q = 0; q < 4; ++q) { const float a = Z[(r0 + r16) * CK_FS + 16 * J + 4 * q + g4]; const float bq = TJ[J * 256 + (4 * q + g4) * 16 + r16];
                wv = __builtin_amdgcn_mfma_f32_16x16x4f32(a, bq, wv, 0, 0, 0); }
#pragma unroll
            for (int rg = 0; rg < 4; ++rg) { Z[(r0 + 4 * g4 + rg) * CK_FS + 16 * J + r16] = wv[rg]; st_bf(lds + L::WBF, r0 + 4 * g4 + rg, 16 * J + r16, wv[rg]); }
        }
    }
    __syncthreads();
    if (MODE == 0) {
        f32x4 cp[2] = {{0.f, 0.f, 0.f, 0.f}, {0.f, 0.f, 0.f, 0.f}};
        mm2(cp, lds + L::WBF + 64 * CK_ST, lds + L::BBT, tm, tn0, lane);
        f32x4 cd[2] = {{0.f, 0.f, 0.f, 0.f}, {0.f, 0.f, 0.f, 0.f}};
        mm2(cd, lds + L::BBT, lds + L::WBF, tm, tn0, lane); mm2(cd, lds + L::KBT, lds + L::VT, tm, tn0, lane);
#pragma unroll
        for (int q = 0; q < 2; ++q) { const int jp = 16 * (tn0 + q) + r16, j0 = 16 * tm + 4 * g4; f32x4 v = cp[q];
#pragma unroll
            for (int rg = 0; rg < 4; ++rg) if (j0 + rg == jp) v[rg] += Gam[jp];
            u32x2 o; o.x = pk2(v[0], v[1]); o.y = pk2(v[2], v[3]); *(u32x2*)(PSTg + jp * 64 + j0) = o;
            const int vi = jp; u32x2 o2; o2.x = pk2(cd[q][0], cd[q][1]); o2.y = pk2(cd[q][2], cd[q][3]); *(u32x2*)(DSg + vi * 64 + j0) = o2; }
        asm volatile("s_waitcnt vmcnt(0)" ::: "memory");
        __syncthreads();
        if (tid == 0) { __builtin_amdgcn_fence(__ATOMIC_RELEASE, "agent"); asm volatile("s_waitcnt vmcnt(0)" ::: "memory");
            __hip_atomic_fetch_add((unsigned*)(Ap->ws + WS_CTL) + CW_CNTA + 64 * (16 * l + combo), 1u, __ATOMIC_RELAXED, __HIP_MEMORY_SCOPE_AGENT); }
    } else {
        f32x4 cy[2] = {{0.f, 0.f, 0.f, 0.f}, {0.f, 0.f, 0.f, 0.f}};
        mm2(cy, lds + L::RTS, lds + L::S0, tm, tn0, lane); mm2(cy, lds + L::MBR, lds + L::WBF, tm, tn0, lane); mm2(cy, lds + L::MKR, lds + L::VT, tm, tn0, lane);
#pragma unroll
        for (int q = 0; q < 2; ++q)
#pragma unroll
            for (int rg = 0; rg < 4; ++rg) Z[(16 * tm + 4 * g4 + rg) * CK_FS + 16 * (tn0 + q) + r16] = cy[q][rg];
        __syncthreads();
        bf16_t* Y = (bf16_t*)(Ap->ws + WS_Y);
        const int ch = h * 64 + lane; const size_t m0 = (size_t)b * SEQ + n * 64 + 8 * w;
        if (mix == 0) { const float gn_w = Ap->in[I_GNW][l * 256 + ch], gn_b = Ap->in[I_GNB][l * 256 + ch];
#pragma unroll
            for (int tt = 0; tt < 8; ++tt) { const float y = Z[(8 * w + tt) * CK_FS + lane]; const float mean = wave_sum(y) * (1.f / 64.f); const float d = y - mean; const float var = wave_sum(d * d) * (1.f / 64.f);
                const float yn = d * rsqrtf(var + 64e-5f) * gn_w + gn_b; Y[(m0 + tt) * DM + 512 + ch] = (bf16_t)f2bf((yn + K.p0[tt] * K.v[tt]) * K.p1[tt]); } }
        else { const float onw = Ap->in[I_ONORM][l * 64 + lane];
#pragma unroll
            for (int tt = 0; tt < 8; ++tt) { const float o = Z[(8 * w + tt) * CK_FS + lane]; const float rs = rsqrtf(wave_sum(o * o) * (1.f / 64.f) + NORM_EPS);
                Y[(m0 + tt) * DM + 768 + ch] = (bf16_t)f2bf(o * rs * onw * K.p0[tt]); } }
    }
}

__device__ __forceinline__ void chunk_phaseB(const Ctx& C, int l, int combo0) {
    const ArgsP Ap = C.a; const int lane = C.lane, w = C.wave, r16 = lane & 15, g4 = lane >> 4;
    const int combo = combo0 + (w >> 2), vt = w & 3;
    unsigned* ctl = (unsigned*)(Ap->ws + WS_CTL);
    if (C.tid == 0) { unsigned sp = 0; while (__hip_atomic_load(ctl + CW_CNTA + 64 * (16 * l + combo0), __ATOMIC_RELAXED, __HIP_MEMORY_SCOPE_AGENT) < 128u || __hip_atomic_load(ctl + CW_CNTA + 64 * (16 * l + combo0 + 1), __ATOMIC_RELAXED, __HIP_MEMORY_SCOPE_AGENT) < 128u) { __builtin_amdgcn_s_sleep(2); if (++sp > (1u << 24)) break; }
        __builtin_amdgcn_fence(__ATOMIC_ACQUIRE, "agent"); asm volatile("s_waitcnt vmcnt(0)" ::: "memory"); }
    __syncthreads();
    const bf16_t* PSTg = (const bf16_t*)(Ap->ws + WS_PST) + (size_t)combo * 128 * 4096;
    bf16_t* DSg = (bf16_t*)(Ap->ws + WS_DS) + (size_t)combo * 128 * 4096;
    f32x4 st[4];
#pragma unroll
    for (int m = 0; m < 4; ++m) st[m] = (f32x4){0.f, 0.f, 0.f, 0.f};
    u32x2 pa[4][2][2], dd[4];
#define CKB_LOAD(nn) do { const bf16_t* ps = PSTg + (size_t)(nn) * 4096; const bf16_t* ds = DSg + (size_t)(nn) * 4096; \
        _Pragma("unroll") for (int m = 0; m < 4; ++m) { dd[m] = *(const u32x2*)(ds + (16 * vt + r16) * 64 + 16 * m + 4 * g4); \
            _Pragma("unroll") for (int s = 0; s < 2; ++s) { pa[m][s][0] = *(const u32x2*)(ps + (16 * m + r16) * 64 + 32 * s + 4 * g4); pa[m][s][1] = *(const u32x2*)(ps + (16 * m + r16) * 64 + 32 * s + 16 + 4 * g4); } } } while (0)
    CKB_LOAD(0);
#pragma unroll 1
    for (int n = 0; n < 128; ++n) {
        bf16x8 bb[2];
#pragma unroll
        for (int s = 0; s < 2; ++s) { u32x4 t4; t4.x = pk2(st[2 * s][0], st[2 * s][1]); t4.y = pk2(st[2 * s][2], st[2 * s][3]); t4.z = pk2(st[2 * s + 1][0], st[2 * s + 1][1]); t4.w = pk2(st[2 * s + 1][2], st[2 * s + 1][3]); bb[s] = __builtin_bit_cast(bf16x8, t4); }
        f32x4 nw[4];
#pragma unroll
        for (int m = 0; m < 4; ++m) { f32x4 c = {bflo(dd[m].x), bfhi(dd[m].x), bflo(dd[m].y), bfhi(dd[m].y)};
#pragma unroll
            for (int s = 0; s < 2; ++s) { u32x4 a4; a4.x = pa[m][s][0].x; a4.y = pa[m][s][0].y; a4.z = pa[m][s][1].x; a4.w = pa[m][s][1].y;
                c = __builtin_amdgcn_mfma_f32_16x16x32_bf16(__builtin_bit_cast(bf16x8, a4), bb[s], c, 0, 0, 0); }
            nw[m] = c; }
        if (n + 1 < 128) CKB_LOAD(n + 1);
#pragma unroll
        for (int m = 0; m < 4; ++m) { st[m] = nw[m]; u32x2 o; o.x = pk2(nw[m][0], nw[m][1]); o.y = pk2(nw[m][2], nw[m][3]); *(u32x2*)(DSg + (size_t)n * 4096 + (16 * vt + r16) * 64 + 16 * m + 4 * g4) = o; }
    }
#undef CKB_LOAD
    asm volatile("s_waitcnt vmcnt(0)" ::: "memory");
    __syncthreads();
    if (C.tid == 0) { __builtin_amdgcn_fence(__ATOMIC_RELEASE, "agent"); asm volatile("s_waitcnt vmcnt(0)" ::: "memory");
        __hip_atomic_store(ctl + CW_FLAGB + 64 * (16 * l + combo0), 1u, __ATOMIC_RELAXED, __HIP_MEMORY_SCOPE_AGENT); __hip_atomic_store(ctl + CW_FLAGB + 64 * (16 * l + combo0 + 1), 1u, __ATOMIC_RELAXED, __HIP_MEMORY_SCOPE_AGENT); }
}

constexpr int DS_CAP = 1024;
constexpr int DS_KI = 128 * 1024, DS_KIROW = 144, DS_KIBUF = 64 * DS_KIROW, DS_HIST = DS_KI + 2 * DS_KIBUF;
static_assert(DS_HIST + 8 * 1024 <= LDS_MISC, "dsa lds");

__device__ __forceinline__ unsigned wave_select256(LAS unsigned* list, int n, LAS unsigned* hist, int lane) {
    unsigned k[16];
#pragma unroll
    for (int j = 0; j < 16; ++j) { const int i = j * 64 + lane; k[j] = (i < n) ? list[i] : 0u; }
    unsigned prefix = 0u, mask = 0u; int rem = 256;
#pragma unroll 1
    for (int pass = 0; pass < 4; ++pass) {
        const int sh = 24 - 8 * pass;
        *(LAS u32x4*)(hist + 4 * lane) = (u32x4){0u, 0u, 0u, 0u};
        asm volatile("s_waitcnt lgkmcnt(0)" ::: "memory");
#pragma unroll
        for (int j = 0; j < 16; ++j) { const int i = j * 64 + lane; if (i < n && ((k[j] ^ prefix) & mask) == 0u) __hip_atomic_fetch_add((LAS unsigned*)&hist[(k[j] >> sh) & 255u], 1u, __ATOMIC_RELAXED, __HIP_MEMORY_SCOPE_WORKGROUP); }
        asm volatile("s_waitcnt lgkmcnt(0)" ::: "memory");
        const u32x4 hv = *(const LAS u32x4*)(hist + 4 * lane);
        const int tl = (int)(hv[0] + hv[1] + hv[2] + hv[3]);
        int inc = tl;
#pragma unroll
        for (int o = 1; o < 64; o <<= 1) { const int v = __shfl_down(inc, o); if (lane + o < 64) inc += v; }
        const int suf = inc - tl;
        const int s3 = suf + (int)hv[3], s2 = s3 + (int)hv[2], s1 = s2 + (int)hv[1], s0 = s1 + (int)hv[0];
        int digit = -1, above = 0;
        if (s3 >= rem && suf < rem) { digit = 4 * lane + 3; above = suf; }
        else if (s2 >= rem && s3 < rem) { digit = 4 * lane + 2; above = s3; }
        else if (s1 >= rem && s2 < rem) { digit = 4 * lane + 1; above = s2; }
        else if (s0 >= rem && s1 < rem) { digit = 4 * lane + 0; above = s1; }
        const unsigned long long bal = __ballot(digit >= 0);
        const int src = (int)__builtin_ctzll(bal | (1ull << 63));
        digit = __shfl(digit, src); above = __shfl(above, src);
        prefix |= (unsigned)digit << sh; mask |= 0xffu << sh; rem -= above;
    }
    int run = 0;
#pragma unroll
    for (int j = 0; j < 16; ++j) { const int i = j * 64 + lane; const bool keep = (i < n) && (k[j] >= prefix);
        const unsigned long long bal = __ballot(keep);
        const int pos = run + (int)__builtin_amdgcn_mbcnt_hi((unsigned)(bal >> 32), __builtin_amdgcn_mbcnt_lo((unsigned)bal, 0u));
        if (keep) list[pos] = k[j];
        run += (int)__builtin_popcountll(bal); }
    asm volatile("s_waitcnt lgkmcnt(0)" ::: "memory");
    return prefix;
}

__device__ __forceinline__ void dsa_item(const Ctx& C, int b, int qt) {
    const ArgsP Ap = C.a;
    const bf16_t* P = (const bf16_t*)(Ap->ws + WS_P); bf16_t* Y = (bf16_t*)(Ap->ws + WS_Y);
    int lane_o = C.lane; asm volatile("" : "+v"(lane_o));
    const int lane = lane_o, w = C.wave, tid = w * 64 + lane, hl = lane >> 5, l32 = lane & 31;
    const int t0 = qt * 32;
    const size_t mb = (size_t)b * SEQ;
    LAS unsigned* cand = (LAS unsigned*)(C.lds) + w * 4 * DS_CAP;
    LAS unsigned* hist = (LAS unsigned*)(C.lds + DS_HIST) + w * 256;
    bf16x8 af[4];
    { const int rho = l32; const int qq = 2 * ((rho >> 2) & 1) + (rho >> 4), hd = (rho & 3) + 4 * ((rho >> 3) & 1);
      const bf16_t* src = P + (mb + t0 + 4 * w + qq) * NIN + PQI + hd * 64 + 8 * hl;
#pragma unroll
      for (int s = 0; s < 4; ++s) af[s] = *(const bf16x8*)(src + 16 * s); }
    float wA[8], wB[8];
    { const bf16_t* ra = P + (mb + t0 + 4 * w + 2 * hl) * NIN + PWI; const u32x4 va = *(const u32x4*)ra, vb = *(const u32x4*)(ra + NIN);
#pragma unroll
      for (int i = 0; i < 4; ++i) { wA[2 * i] = bflo(va[i]); wA[2 * i + 1] = bfhi(va[i]); wB[2 * i] = bflo(vb[i]); wB[2 * i + 1] = bfhi(vb[i]); } }
    const int tA = t0 + 4 * w + 2 * hl, tB = tA + 1;
    int cnt0 = 0, cnt1 = 0, cnt2 = 0, cnt3 = 0; unsigned th0 = 0u, th1 = 0u, th2 = 0u, th3 = 0u;
    const int NT = (t0 + 32 + 63) >> 6;
    const bf16_t* kisrc = P + (mb + (tid >> 3)) * NIN + PKI + 8 * (tid & 7);
    LAS unsigned char* kib = C.lds + DS_KI; const int kiw = (tid >> 3) * DS_KIROW + (tid & 7) * 16;
    __syncthreads();
    { const u32x4 v = *(const u32x4*)kisrc; *(LAS u32x4*)(kib + kiw) = v; }
    __syncthreads();
#pragma unroll 1
    for (int kt = 0; kt < NT; ++kt) {
        u32x4 nxt = (u32x4){0u, 0u, 0u, 0u};
        if (kt + 1 < NT) nxt = *(const u32x4*)(kisrc + (size_t)(kt + 1) * 64 * NIN);
        if (cnt0 > DS_CAP - 64) { th0 = wave_select256(cand + 0 * DS_CAP, cnt0, hist, lane); cnt0 = 256; }
        if (cnt1 > DS_CAP - 64) { th1 = wave_select256(cand + 1 * DS_CAP, cnt1, hist, lane); cnt1 = 256; }
        if (cnt2 > DS_CAP - 64) { th2 = wave_select256(cand + 2 * DS_CAP, cnt2, hist, lane); cnt2 = 256; }
        if (cnt3 > DS_CAP - 64) { th3 = wave_select256(cand + 3 * DS_CAP, cnt3, hist, lane); cnt3 = 256; }
        const LAS unsigned char* kb = kib + (kt & 1) * DS_KIBUF;
#pragma unroll
        for (int nt = 0; nt < 2; ++nt) {
            f32x16 c = {};
#pragma unroll
            for (int s = 0; s < 4; ++s) { const bf16x8 bfr = *(const LAS bf16x8*)(kb + (nt * 32 + l32) * DS_KIROW + (16 * s + 8 * hl) * 2);
                c = __builtin_amdgcn_mfma_f32_32x32x16_bf16(af[s], bfr, c, 0, 0, 0); }
            float sA = 0.f, sB = 0.f;
#pragma unroll
            for (int i = 0; i < 8; ++i) { sA = fmaf(fmaxf(c[i], 0.f), wA[i], sA); sB = fmaf(fmaxf(c[8 + i], 0.f), wB[i], sB); }
            const int sidx = kt * 64 + nt * 32 + l32;
            unsigned uA = __builtin_bit_cast(unsigned, sA), uB = __builtin_bit_cast(unsigned, sB);
            uA = (uA & 0x80000000u) ? ~uA : (uA | 0x80000000u); uB = (uB & 0x80000000u) ? ~uB : (uB | 0x80000000u);
            const unsigned keyA = (uA & 0xffffe000u) | (unsigned)(8191 - sidx), keyB = (uB & 0xffffe000u) | (unsigned)(8191 - sidx);
            const unsigned thA = hl ? th2 : th0, thB = hl ? th3 : th1;
            const bool pA = (sidx <= tA) && (keyA > thA), pB = (sidx <= tB) && (keyB > thB);
            { const unsigned long long bal = __ballot(pA); const unsigned lo = (unsigned)bal, hi = (unsigned)(bal >> 32);
              const int pos = hl ? (cnt2 + (int)__builtin_amdgcn_mbcnt_hi(hi, 0u)) : (cnt0 + (int)__builtin_amdgcn_mbcnt_lo(lo, 0u));
              if (pA) cand[(hl ? 2 : 0) * DS_CAP + pos] = keyA;
              cnt0 += __builtin_popcount(lo); cnt2 += __builtin_popcount(hi); }
            { const unsigned long long bal = __ballot(pB); const unsigned lo = (unsigned)bal, hi = (unsigned)(bal >> 32);
              const int pos = hl ? (cnt3 + (int)__builtin_amdgcn_mbcnt_hi(hi, 0u)) : (cnt1 + (int)__builtin_amdgcn_mbcnt_lo(lo, 0u));
              if (pB) cand[(hl ? 3 : 1) * DS_CAP + pos] = keyB;
              cnt1 += __builtin_popcount(lo); cnt3 += __builtin_popcount(hi); }
        }
        if (kt + 1 < NT) *(LAS u32x4*)(kib + ((kt + 1) & 1) * DS_KIBUF + kiw) = nxt;
        __syncthreads();
    }
    if (cnt0 > 256) { wave_select256(cand + 0 * DS_CAP, cnt0, hist, lane); cnt0 = 256; }
    if (cnt1 > 256) { wave_select256(cand + 1 * DS_CAP, cnt1, hist, lane); cnt1 = 256; }
    if (cnt2 > 256) { wave_select256(cand + 2 * DS_CAP, cnt2, hist, lane); cnt2 = 256; }
    if (cnt3 > 256) { wave_select256(cand + 3 * DS_CAP, cnt3, hist, lane); cnt3 = 256; }
    asm volatile("s_waitcnt lgkmcnt(0)" ::: "memory");
#pragma unroll 1
    for (int qq = 0; qq < 4; ++qq) {
        const int nsel = qq == 0 ? cnt0 : qq == 1 ? cnt1 : qq == 2 ? cnt2 : cnt3;
        const LAS unsigned* lst = cand + qq * DS_CAP;
        LAS f32x4* pb0 = (LAS f32x4*)(cand + qq * DS_CAP + 256);
        LAS f32x4* pb1 = (LAS f32x4*)(cand + (qq ^ 1) * DS_CAP + 256);
        const size_t mq = mb + t0 + 4 * w + qq;
        const bf16_t* qrow = P + mq * NIN + PQ;
#pragma unroll 1
        for (int g = 0; g < 2; ++g) {
            bf16x8 aq[2];
#pragma unroll
            for (int s = 0; s < 2; ++s) { aq[s] = (bf16x8){0, 0, 0, 0, 0, 0, 0, 0}; if ((lane & 15) < 4) aq[s] = *(const bf16x8*)(qrow + (4 * g + (lane & 15)) * 64 + 32 * s + 8 * (lane >> 4)); }
            f32x4 sc[16];
#pragma unroll
            for (int kt = 0; kt < 16; ++kt) {
                const int n = 16 * kt + (lane & 15);
                const int idx = (n < nsel) ? (8191 - (int)(lst[n] & 8191u)) : 0;
                const bf16_t* krow = P + (mb + idx) * NIN + PK + 64 * g + 8 * (lane >> 4);
                const bf16x8 k0 = *(const bf16x8*)krow, k1 = *(const bf16x8*)(krow + 32);
                f32x4 c = {0.f, 0.f, 0.f, 0.f};
                c = __builtin_amdgcn_mfma_f32_16x16x32_bf16(aq[0], k0, c, 0, 0, 0);
                c = __builtin_amdgcn_mfma_f32_16x16x32_bf16(aq[1], k1, c, 0, 0, 0);
                if (n >= nsel) c = (f32x4){-INFINITY, -INFINITY, -INFINITY, -INFINITY};
                sc[kt] = c;
            }
            f32x4 mx = sc[0];
#pragma unroll
            for (int kt = 1; kt < 16; ++kt) { mx[0] = fmaxf(mx[0], sc[kt][0]); mx[1] = fmaxf(mx[1], sc[kt][1]); mx[2] = fmaxf(mx[2], sc[kt][2]); mx[3] = fmaxf(mx[3], sc[kt][3]); }
#pragma unroll
            for (int o = 1; o < 16; o <<= 1) { mx[0] = fmaxf(mx[0], __shfl_xor(mx[0], o)); mx[1] = fmaxf(mx[1], __shfl_xor(mx[1], o)); mx[2] = fmaxf(mx[2], __shfl_xor(mx[2], o)); mx[3] = fmaxf(mx[3], __shfl_xor(mx[3], o)); }
            f32x4 sm = {0.f, 0.f, 0.f, 0.f};
#pragma unroll
            for (int kt = 0; kt < 16; ++kt) {
#pragma unroll
                for (int e = 0; e < 4; ++e) { const float p = __expf(sc[kt][e] - mx[e]); sc[kt][e] = p; sm[e] += p; } }
#pragma unroll
            for (int o = 1; o < 16; o <<= 1) { sm[0] += __shfl_xor(sm[0], o); sm[1] += __shfl_xor(sm[1], o); sm[2] += __shfl_xor(sm[2], o); sm[3] += __shfl_xor(sm[3], o); }
            const f32x4 inv = {1.f / sm[0], 1.f / sm[1], 1.f / sm[2], 1.f / sm[3]};
            if (lane < 16) {
#pragma unroll
                for (int kt = 0; kt < 16; ++kt) { const int n = 16 * kt + lane; const f32x4 pv = sc[kt] * inv;
                    if (kt < 12) pb0[n] = pv; else pb1[n - 192] = pv; }
            }
            asm volatile("s_waitcnt lgkmcnt(0)" ::: "memory");
            float o[4][2];
#pragma unroll
            for (int hh = 0; hh < 4; ++hh) { o[hh][0] = 0.f; o[hh][1] = 0.f; }
            const bf16_t* vbase = P + mb * NIN + PV + 64 * g + 2 * l32;
#pragma unroll 4
            for (int n = hl; n < nsel; n += 2) {
                const int idx = 8191 - (int)(lst[n] & 8191u);
                const unsigned v2 = *(const unsigned*)(vbase + (size_t)idx * NIN);
                const f32x4 pv = (n < 192) ? pb0[n] : pb1[n - 192];
                const float v0 = bflo(v2), v1 = bfhi(v2);
#pragma unroll
                for (int hh = 0; hh < 4; ++hh) { o[hh][0] += pv[hh] * v0; o[hh][1] += pv[hh] * v1; }
            }
#pragma unroll
            for (int hh = 0; hh < 4; ++hh) { o[hh][0] += __shfl_xor(o[hh][0], 32); o[hh][1] += __shfl_xor(o[hh][1], 32); }
            if (hl == 0) {
#pragma unroll
                for (int hh = 0; hh < 4; ++hh) *(unsigned*)(Y + mq * DM + (4 * g + hh) * 64 + 2 * l32) = pk2(o[hh][0], o[hh][1]);
            }
            asm volatile("s_waitcnt lgkmcnt(0)" ::: "memory");
        }
    }
}

__device__ __forceinline__ void mixers_phase(const Ctx& C, int l) {
    const ArgsP Ap = C.a;
    unsigned* ctl = (unsigned*)(Ap->ws + WS_CTL);
    for (int it = C.bid; it < 2048; it += C.G) chunk_item<0>(C, l, it & 15, it >> 4);
    if (C.bid < 8) chunk_phaseB(C, l, 2 * C.bid);
    unsigned* work = ctl + CW_WORK + 64 * l;
    volatile LAS unsigned* misc = (volatile LAS unsigned*)(C.lds + LDS_MISC);
    bool bready = false;
    for (;;) {
        __syncthreads();
        if (C.tid == 0) misc[0] = __hip_atomic_fetch_add(work, 1u, __ATOMIC_RELAXED, __HIP_MEMORY_SCOPE_AGENT);
        __syncthreads();
        const int it = (int)misc[0];
        if (it >= 512 + 2048) break;
        if (it < 512) { dsa_item(C, it & 1, 255 - (it >> 1)); continue; }
        if (!bready) {
            if (C.tid == 0) { unsigned sp = 0; for (;;) { unsigned ok = 1u;
                    for (int c = 0; c < 16; ++c) ok &= __hip_atomic_load(ctl + CW_FLAGB + 64 * (16 * l + c), __ATOMIC_RELAXED, __HIP_MEMORY_SCOPE_AGENT);
                    if (ok || ++sp > (1u << 24)) break; __builtin_amdgcn_s_sleep(2); }
                __builtin_amdgcn_fence(__ATOMIC_ACQUIRE, "agent"); asm volatile("s_waitcnt vmcnt(0)" ::: "memory"); }
            __syncthreads(); bready = true; }
        const int ci = it - 512;
        chunk_item<1>(C, l, ci & 15, ci >> 4);
    }
    __syncthreads();
}

constexpr int NPHASE = 18;
__global__ void __launch_bounds__(512, 2) fwd_kernel(Args args_unused) {
    extern __shared__ __attribute__((aligned(16))) unsigned char lds_raw[];
    ArgsP ap0 = (ArgsP)__builtin_amdgcn_kernarg_segment_ptr();
    Ctx C; C.lds = (LAS unsigned char*)lds_raw; C.tid = threadIdx.x; C.lane = C.tid & 63; C.wave = __builtin_amdgcn_readfirstlane(C.tid >> 6); C.G = gridDim.x; C.bid = blockIdx.x; C.a = ap0;
    volatile LAS unsigned* misc = (volatile LAS unsigned*)(C.lds + LDS_MISC);
    if (C.tid < 64) misc[C.tid] = 0u;
    __syncthreads();
    const int ph_lo = ap0->ph_lo, ph_hi = ap0->ph_hi;
    XcdBarrier bar; bar.bar = (unsigned*)(ap0->ws + WS_CTL) + CW_BAR; bar.x = 0; bar.st = nullptr;
    const bool fused = (ph_hi - ph_lo) > 1;
    if (fused) bar = xcd_barrier_post((unsigned*)(ap0->ws + WS_CTL) + CW_BAR, misc + 8);
#ifndef PHASE_MASK
#define PHASE_MASK 0x3ff
#endif
#define PM(k) ((PHASE_MASK >> (k)) & 1)
    for (int ph = ph_lo; ph < ph_hi; ++ph) {
        { int t_ = threadIdx.x; asm volatile("" : "+v"(t_)); C.tid = t_; C.lane = t_ & 63; C.wave = __builtin_amdgcn_readfirstlane(t_ >> 6); }
        ArgsP ap = (ArgsP)__builtin_amdgcn_kernarg_segment_ptr(); asm volatile("" : "+s"(ap)); C.a = ap;
        unsigned char* ws = ap->ws; unsigned char* wb = ws + WS_W;
        bf16_t* XBF = (bf16_t*)(ws + WS_XBF); bf16_t* ACT = (bf16_t*)(ws + WS_ACT); bf16_t* PB = (bf16_t*)(ws + WS_P); bf16_t* YB = (bf16_t*)(ws + WS_Y);
        float* SSQA = (float*)(ws + WS_SSQ); float* SSQB = SSQA + (size_t)MTOK * 16; float* SSQC = SSQB + (size_t)MTOK * 16;
        if (ph == 0) { if (PM(9)) { convert_layer_weights(C, 0); prologue_x(C); } }
        else {
            const int l = (ph - 1) / 9, sp = (ph - 1) % 9;
            pg8::StaticOrder S;
            switch (sp) {
            case 0: if (PM(0)) { pg8::Gemm g{XBF, (const bf16_t*)(wb + W_GU1), MTOK, NGU, DM}; S.init(MTOK, NGU, C.G, C.bid); pg8::EpiFfnUp E{ACT, SSQA};
                      pg8::gemm_phase<pg8::EpiFfnUp, pg8::StaticOrder, true, true>(C.lds, g, S, E, C.tid); } break;
            case 1: if (PM(1)) { pg8::Gemm g{ACT, (const bf16_t*)(wb + W_D1), MTOK, DM, FF}; S.init(MTOK, DM, C.G, C.bid); pg8::EpiResid E{l == 0 ? ap->in[I_X] : ap->out, ap->out, XBF, SSQB, 0.5f};
                      pg8::gemm_phase<pg8::EpiResid, pg8::StaticOrder, true, true>(C.lds, g, S, E, C.tid); } break;
            case 2: if (PM(2)) { pg8::Gemm g{XBF, (const bf16_t*)(wb + W_IN), MTOK, NIN, DM}; S.init(MTOK, NIN, C.G, C.bid); pg8::EpiRowScaleBf16 E{PB, NIN, SSQB};
                      pg8::gemm_phase<pg8::EpiRowScaleBf16, pg8::StaticOrder, true, true>(C.lds, g, S, E, C.tid); } break;
            case 3: if (PM(3)) prep_phase(C, l); break;
            case 4: if (PM(4)) mixers_phase(C, l); break;
            case 5: if (PM(5)) { pg8::Gemm g{YB, (const bf16_t*)(wb + W_OUT), MTOK, DM, DM}; S.init(MTOK, DM, C.G, C.bid); pg8::EpiResid E{ap->out, ap->out, XBF, SSQC, 1.0f};
                      pg8::gemm_phase<pg8::EpiResid, pg8::StaticOrder, true, true>(C.lds, g, S, E, C.tid); } break;
            case 6: if (PM(6)) { pg8::Gemm g{XBF, (const bf16_t*)(wb + W_GU2), MTOK, NGU, DM}; S.init(MTOK, NGU, C.G, C.bid); pg8::EpiFfnUp E{ACT, SSQC};
                      pg8::gemm_phase<pg8::EpiFfnUp, pg8::StaticOrder, true, true>(C.lds, g, S, E, C.tid); } break;
            case 7: if (PM(7)) { pg8::Gemm g{ACT, (const bf16_t*)(wb + W_D2), MTOK, DM, FF}; S.init(MTOK, DM, C.G, C.bid); pg8::EpiResid E{ap->out, ap->out, XBF, SSQA, 0.5f};
                      pg8::gemm_phase<pg8::EpiResid, pg8::StaticOrder, true, true>(C.lds, g, S, E, C.tid); } break;
            case 8: if (PM(8)) convert_layer_weights(C, l + 1); break;
            }
        }
        if (ph + 1 < ph_hi) xcd_barrier(bar);
    }
}

extern "C" void kernel_launch(void* const* d_in, const int* in_sizes, int n_in, void* d_out, int out_size, void* d_ws, size_t ws_size, hipStream_t stream) {
    static int grid = 0;
    if (grid == 0) {
        if (n_in != 28 || out_size != MTOK * DM || ws_size < WS_END) { fprintf(stderr, "kernel_launch: unexpected shapes (n_in %d out %d ws %zu)\n", n_in, out_size, ws_size); grid = -1; return; }
        int dev = 0, cus = 0, per_cu = 0;
        if (hipGetDevice(&dev) != hipSuccess || hipDeviceGetAttribute(&cus, hipDeviceAttributeMultiprocessorCount, dev) != hipSuccess) { grid = -1; return; }
        if (hipFuncSetAttribute((const void*)fwd_kernel, hipFuncAttributeMaxDynamicSharedMemorySize, LDS_BYTES) != hipSuccess) { fprintf(stderr, "kernel_launch: hipFuncSetAttribute failed\n"); grid = -1; return; }
        if (hipOccupancyMaxActiveBlocksPerMultiprocessor(&per_cu, (const void*)fwd_kernel, 512, LDS_BYTES) != hipSuccess || per_cu < 1) { fprintf(stderr, "kernel_launch: occupancy query says %d\n", per_cu); per_cu = 1; }
        (void)hipGetLastError();
        grid = cus;
    }
    if (grid < 0) return;
    (void)hipMemsetAsync((char*)d_ws + WS_CTL, 0, CTL_ZERO_BYTES, stream);
    Args a{};
    for (int i = 0; i < 28; ++i) a.in[i] = (const float*)d_in[i];
    a.out = (float*)d_out; a.ws = (unsigned char*)d_ws;
#if MK_N_LAUNCHES == 1
    a.ph_lo = 0; a.ph_hi = NPHASE;
    void* kargs[] = {&a};
    hipError_t e = hipLaunchCooperativeKernel((const void*)fwd_kernel, dim3(grid), dim3(512), kargs, LDS_BYTES, stream);
    if (e != hipSuccess) fprintf(stderr, "kernel_launch: cooperative launch failed: %s\n", hipGetErrorString(e));
#else
    for (int ph = 0; ph < NPHASE; ++ph) { a.ph_lo = ph; a.ph_hi = ph + 1; hipLaunchKernelGGL(fwd_kernel, dim3(grid), dim3(512), LDS_BYTES, stream, a); }
#endif
}
```

```cpp
#include <hip/hip_runtime.h>
#include <cstdio>
#include <cstdint>


#ifndef PROBE_DUP
#define PROBE_DUP 0
#endif
#ifndef MK_N_LAUNCHES
#define MK_N_LAUNCHES 1
#endif

#define LAS __attribute__((address_space(3)))
#define GAS __attribute__((address_space(1)))
typedef unsigned short bf16_t;
typedef short bf16x8 __attribute__((ext_vector_type(8)));
typedef float f32x4 __attribute__((ext_vector_type(4)));
typedef float f32x16 __attribute__((ext_vector_type(16)));
typedef float f32x2 __attribute__((ext_vector_type(2)));
typedef unsigned u32x4 __attribute__((ext_vector_type(4)));
typedef unsigned u32x2 __attribute__((ext_vector_type(2)));

constexpr int BATCH = 2, SEQ = 8192, DM = 1024, FF = 2816, MTOK = BATCH * SEQ;
constexpr int NGU = 2 * FF;
constexpr int NIN = 3328;
constexpr int PQ = 0, PK = 512, PV = 640, PQI = 768, PKI = 1280, PWI = 1344, PGB = 1352, PGA = 1356;
constexpr int PRW = 1408;
constexpr int PGD = 2304;
constexpr float NORM_EPS = 1e-6f;

constexpr size_t MiB = 1u << 20;
constexpr size_t WS_CTL = 0, CTL_ZERO_BYTES = 64 * 1024;
constexpr size_t WS_ROPE = 64 * 1024;
constexpr size_t WS_W = 3 * MiB;
constexpr size_t W_GU1 = 0, W_D1 = 11 * MiB, W_IN = W_D1 + 5632 * 1024, W_OUT = W_IN + (size_t)NIN * DM * 2, W_GU2 = W_OUT + 2 * MiB, W_D2 = W_GU2 + 11 * MiB, W_END = W_D2 + 5632 * 1024;
constexpr size_t WS_XBF = 45 * MiB;
constexpr size_t WS_BIG = 77 * MiB;
constexpr size_t WS_P = WS_BIG, WS_Y = WS_BIG + 104 * MiB, WS_ACT = WS_BIG;
constexpr size_t WS_SSQ = 213 * MiB;
constexpr size_t WS_VF = 216 * MiB;
constexpr size_t WS_END = 224 * MiB;
static_assert(W_END <= 42 * MiB && WS_W + W_END <= WS_XBF && WS_Y + 32 * MiB <= WS_SSQ, "ws map");

constexpr int CW_BAR = 1024;
constexpr int CW_WORK = 8192;

constexpr int LDS_MISC = 154 * 1024;
constexpr int LDS_BYTES = 155 * 1024;

__device__ __forceinline__ unsigned f2bf(float f) { unsigned u = __builtin_bit_cast(unsigned, f); return (u + 0x7fffu + ((u >> 16) & 1u)) >> 16; }
__device__ __forceinline__ unsigned pk2(float lo, float hi) { return f2bf(lo) | (f2bf(hi) << 16); }
__device__ __forceinline__ float bf2f(unsigned short h) { return __builtin_bit_cast(float, (unsigned)h << 16); }
__device__ __forceinline__ float bflo(unsigned w) { return __builtin_bit_cast(float, w << 16); }
__device__ __forceinline__ float bfhi(unsigned w) { return __builtin_bit_cast(float, w & 0xffff0000u); }
__device__ __forceinline__ float wave_sum_shfl(float v) {
#pragma unroll
    for (int o = 1; o < 64; o <<= 1) v += __shfl_xor(v, o);
    return v;
}
__device__ __forceinline__ float dpp_f(float v, int ctrl_quad  ) { return v; }
#define DPP_ADD(v, ctrl) v += __builtin_bit_cast(float, __builtin_amdgcn_update_dpp(0, __builtin_bit_cast(int, v), ctrl, 0xf, 0xf, true))
__device__ __forceinline__ float wave_sum(float v) {
    DPP_ADD(v, 0xB1); DPP_ADD(v, 0x4E); DPP_ADD(v, 0x141); DPP_ADD(v, 0x140);
    const int vi = __builtin_bit_cast(int, v);
    return (__builtin_bit_cast(float, __builtin_amdgcn_readlane(vi, 0)) + __builtin_bit_cast(float, __builtin_amdgcn_readlane(vi, 16))) +
           (__builtin_bit_cast(float, __builtin_amdgcn_readlane(vi, 32)) + __builtin_bit_cast(float, __builtin_amdgcn_readlane(vi, 48)));
}
__device__ __forceinline__ float sigmoidf_(float x) { return 1.f / (1.f + __expf(-x)); }
__device__ __forceinline__ float siluf_(float x) { return x / (1.f + __expf(-x)); }
__device__ __forceinline__ float softplusf_(float x) { return x > 20.f ? x : log1pf(__expf(x)); }

namespace pg8 {
constexpr int BM = 256, BK = 64, HALF = 128, HTB = HALF * BK * 2, STAGE_BYTES = 8 * HTB, NXCD = 8, WGM = 8;
__host__ __device__ __forceinline__ int lds_byte(int r, int c) { const int st = (r >> 4) * 2 + (c >> 5), rr = r & 15, cc = c & 31, ob = rr * 64 + cc * 2; return st * 1024 + (ob ^ (((ob >> 9) & 1) << 5)); }
__host__ __device__ __forceinline__ void stage_rc(int b, int& R, int& C) { const int st = b / 1024, sb = b % 1024, swz = sb ^ (((sb >> 9) & 1) << 5); R = (st >> 1) * 16 + swz / 64; C = (st & 1) * 32 + (swz % 64) / 2; }
__host__ __device__ __forceinline__ int perm32(int rho) { const int n = rho >> 4, i = rho & 15; return 8 * (i >> 2) + 4 * n + (i & 3); }
struct Unit { int pm, pn; };
struct Gemm { const bf16_t* A; const bf16_t* Bt; int M, N, K; };
struct StaticOrder {
    int nM, nN, nwg, G, c;
    __host__ __device__ void init(int M, int N, int G_, int c_) { nM = M / BM; nN = N / BM; nwg = nM * nN; G = G_; c = c_; }
    __host__ __device__ bool next(int i, Unit& u) const {
        const long L = (long)i * G + c; if (L >= nwg) return false;
        int wgid = (int)L; { const int q = nwg / NXCD, r = nwg % NXCD, xcd = wgid % NXCD, off = wgid / NXCD; wgid = (xcd < r ? xcd * (q + 1) : r * (q + 1) + (xcd - r) * q) + off; }
        const int nig = WGM * nN, gid = wgid / nig, fm = gid * WGM, gsz = (nM - fm) < WGM ? (nM - fm) : WGM;
        u.pm = fm + ((wgid % nig) % gsz); u.pn = (wgid % nig) / gsz; return true;
    }
};
__device__ __forceinline__ unsigned cvt_pk_bf16(float lo, float hi) { unsigned r; asm volatile("v_cvt_pk_bf16_f32 %0, %1, %2" : "=v"(r) : "v"(lo), "v"(hi)); return r; }

__device__ __forceinline__ float row_rstd(const float* ssq, int row, int fq) {
    const f32x4 v = *(const f32x4*)(ssq + (size_t)row * 16 + 4 * fq);
    float s = (v[0] + v[1]) + (v[2] + v[3]);
    s += __shfl_xor(s, 16); s += __shfl_xor(s, 32);
    return rsqrtf(s * (1.0f / DM) + NORM_EPS);
}
struct EpiFfnUp {
    static constexpr bool PERM = true;
    bf16_t* O; const float* ssq;
    __device__ __forceinline__ void operator()(const f32x4 (&acc)[2][2][4][2], const Unit& u, int wr, int wc, int fr, int fq) const {
        const int row0 = u.pm * BM + wr * 64 + fr; const int col0 = u.pn * HALF + wc * 32 + 8 * fq;
#pragma unroll
        for (int ai = 0; ai < 2; ++ai)
#pragma unroll
            for (int m = 0; m < 4; ++m) { const int row = row0 + ai * HALF + m * 16; const float rs = row_rstd(ssq, row, fq);
                float o[8];
#pragma unroll
                for (int n = 0; n < 2; ++n)
#pragma unroll
                    for (int e = 0; e < 4; ++e) { const float g = acc[ai][0][m][n][e] * rs, up = acc[ai][1][m][n][e] * rs;
                        o[n * 4 + e] = g * __builtin_amdgcn_rcpf(1.f + __builtin_amdgcn_exp2f(-1.4426950408889634f * g)) * up; }
                u32x4 w; w.x = cvt_pk_bf16(o[0], o[1]); w.y = cvt_pk_bf16(o[2], o[3]); w.z = cvt_pk_bf16(o[4], o[5]); w.w = cvt_pk_bf16(o[6], o[7]);
                *(u32x4*)(O + (size_t)row * FF + col0) = w; asm volatile("" ::: "memory"); }
    }
};
struct EpiRowScaleBf16 {
    static constexpr bool PERM = true;
    bf16_t* O; int ldc; const float* ssq;
    __device__ __forceinline__ void operator()(const f32x4 (&acc)[2][2][4][2], const Unit& u, int wr, int wc, int fr, int fq) const {
        const int row0 = u.pm * BM + wr * 64 + fr; const int col0 = u.pn * BM + wc * 32 + 8 * fq;
#pragma unroll
        for (int ai = 0; ai < 2; ++ai)
#pragma unroll
            for (int m = 0; m < 4; ++m) { const int row = row0 + ai * HALF + m * 16; const float rs = row_rstd(ssq, row, fq);
#pragma unroll
                for (int bj = 0; bj < 2; ++bj) { const f32x4 v0 = acc[ai][bj][m][0] * rs, v1 = acc[ai][bj][m][1] * rs;
                    u32x4 w; w.x = cvt_pk_bf16(v0[0], v0[1]); w.y = cvt_pk_bf16(v0[2], v0[3]); w.z = cvt_pk_bf16(v1[0], v1[1]); w.w = cvt_pk_bf16(v1[2], v1[3]);
                    *(u32x4*)(O + (size_t)row * ldc + col0 + bj * HALF) = w; } asm volatile("" ::: "memory"); }
    }
};
struct EpiResid {
    static constexpr bool PERM = false;
    const float* xin; float* xout; bf16_t* xbf; float* ssq; float alpha;
    __device__ __forceinline__ void operator()(const f32x4 (&acc)[2][2][4][2], const Unit& u, int wr, int wc, int fr, int fq) const {
        const int row0 = u.pm * BM + wr * 64 + fr; const int col0 = u.pn * BM + wc * 32 + 4 * fq;
#pragma unroll
        for (int ai = 0; ai < 2; ++ai)
#pragma unroll
            for (int m = 0; m < 4; ++m) { const int row = row0 + ai * HALF + m * 16; const size_t off = (size_t)row * DM + col0; float s = 0.f;
#pragma unroll
                for (int bj = 0; bj < 2; ++bj)
#pragma unroll
                    for (int n = 0; n < 2; ++n) { const size_t o2 = off + bj * HALF + n * 16; const f32x4 xi = *(const f32x4*)(xin + o2); const f32x4 v = xi + acc[ai][bj][m][n] * alpha;
                        *(f32x4*)(xout + o2) = v; u32x2 w; w.x = cvt_pk_bf16(v[0], v[1]); w.y = cvt_pk_bf16(v[2], v[3]); *(u32x2*)(xbf + o2) = w;
                        s += (v[0] * v[0] + v[1] * v[1]) + (v[2] * v[2] + v[3] * v[3]); }
                s += __shfl_xor(s, 16); s += __shfl_xor(s, 32);
                if (fq == 0) ssq[(size_t)row * 16 + u.pn * 4 + wc] = s; }
    }
};

template <class Epi, class Sched, bool ALIGN_EPI = false, bool SP2 = false>
__device__ __forceinline__ void gemm_phase(LAS unsigned char* lds, const Gemm g, const Sched& S, const Epi& E, const int tid) {
    const int wid = __builtin_amdgcn_readfirstlane(tid >> 6), lane = tid & 63, wr = wid >> 2, wc = wid & 3, fr = lane & 15, fq = lane >> 4;
    const int K = g.K, nt = K / BK;
    unsigned voffA[2], voffB[2];
#pragma unroll
    for (int i = 0; i < 2; ++i) { int R, C; stage_rc(tid * 16 + i * 8192, R, C); const int Rb = Epi::PERM ? ((R & ~31) + perm32(R & 31)) : R;
        voffA[i] = (unsigned)(R * K + C) * 2u; voffB[i] = (unsigned)(Rb * K + C) * 2u; }
    const size_t kstep = (size_t)(BK * 2);
    const size_t hstep = (size_t)HALF * K * 2;
    const size_t tstep = 2 * hstep;
    const unsigned ldsw = (unsigned)wid * 1024u;
    const int aoff = lds_byte(wr * 64 + fr, fq * 8), boff = lds_byte(wc * 32 + fr, fq * 8);
#define PG8_SA(b, h) (((b) * 2 + (h)) * HTB)
#define PG8_SB(b, h) ((4 + (b) * 2 + (h)) * HTB)
#define PG8_STAGE(bufoff, gbase, voff) do { _Pragma("unroll") for (int _i = 0; _i < 2; ++_i) \
        __builtin_amdgcn_global_load_lds((const unsigned*)((const char*)(gbase) + (voff)[_i]), (LAS unsigned*)(lds + (bufoff) + ldsw + _i * 8192), 16, 0, 0); } while (0)
#define PG8_LDA(dst, b, h) do { _Pragma("unroll") for (int m = 0; m < 4; ++m) _Pragma("unroll") for (int k = 0; k < 2; ++k) dst[m][k] = *(const LAS bf16x8*)(lds + PG8_SA(b, h) + aoff + m * 2048 + k * 1024); } while (0)
#define PG8_LDB(dst, b, h) do { _Pragma("unroll") for (int n = 0; n < 2; ++n) _Pragma("unroll") for (int k = 0; k < 2; ++k) dst[n][k] = *(const LAS bf16x8*)(lds + PG8_SB(b, h) + boff + n * 2048 + k * 1024); } while (0)
#define PG8_MMA(ai, bj, At, Bt) do { __builtin_amdgcn_s_setprio(1); _Pragma("unroll") for (int m = 0; m < 4; ++m) _Pragma("unroll") for (int n = 0; n < 2; ++n) _Pragma("unroll") for (int k = 0; k < 2; ++k) \
        acc[ai][bj][m][n] = __builtin_amdgcn_mfma_f32_16x16x32_bf16(Bt[n][k], At[m][k], acc[ai][bj][m][n], 0, 0, 0); __builtin_amdgcn_s_setprio(0); } while (0)
#define PG8_WAIT_V(n) asm volatile("s_waitcnt vmcnt(" #n ")" ::: "memory")
#define PG8_WAIT_L(n) asm volatile("s_waitcnt lgkmcnt(" #n ")" ::: "memory")
#define PG8_BAR __builtin_amdgcn_s_barrier()
#define PG8_SCHED __builtin_amdgcn_sched_barrier(0)
    Unit cur, nxt; int ui = 0;
    if (!S.next(0, cur)) return;
    f32x4 acc[2][2][4][2];
#pragma unroll
    for (int a = 0; a < 2; ++a)
#pragma unroll
        for (int b = 0; b < 2; ++b)
#pragma unroll
            for (int m = 0; m < 4; ++m)
#pragma unroll
                for (int n = 0; n < 2; ++n) acc[a][b][m][n] = (f32x4){0.f, 0.f, 0.f, 0.f};
    bf16x8 At[4][2], B0[2][2], B1[2][2];
    const char* cA = (const char*)g.A + (size_t)cur.pm * tstep; const char* cB = (const char*)g.Bt + (size_t)cur.pn * tstep;
    if constexpr (SP2) {
        PG8_STAGE(PG8_SB(0, 0), cB, voffB); PG8_STAGE(PG8_SB(0, 1), cB + hstep, voffB); PG8_STAGE(PG8_SA(0, 0), cA, voffA); PG8_STAGE(PG8_SA(0, 1), cA + hstep, voffA);
        if (wr == 1) PG8_BAR;
        PG8_WAIT_V(2); PG8_BAR;
        PG8_STAGE(PG8_SB(1, 0), cB + kstep, voffB); PG8_STAGE(PG8_SA(1, 0), cA + kstep, voffA); PG8_STAGE(PG8_SB(1, 1), cB + hstep + kstep, voffB);
        PG8_WAIT_V(6); PG8_BAR;
    } else {
        PG8_STAGE(PG8_SB(0, 0), cB, voffB); PG8_STAGE(PG8_SA(0, 0), cA, voffA); PG8_STAGE(PG8_SB(0, 1), cB + hstep, voffB); PG8_STAGE(PG8_SA(0, 1), cA + hstep, voffA);
        if (wr == 1) PG8_BAR;
        PG8_WAIT_V(4); PG8_BAR;
        PG8_STAGE(PG8_SB(1, 0), cB + kstep, voffB); PG8_STAGE(PG8_SA(1, 0), cA + kstep, voffA); PG8_STAGE(PG8_SB(1, 1), cB + hstep + kstep, voffB);
        PG8_WAIT_V(6); PG8_BAR;
    }
    for (;;) {
        const bool has_next = S.next(ui + 1, nxt);
        const char* nA = has_next ? (const char*)g.A + (size_t)nxt.pm * tstep : cA; const char* nB = has_next ? (const char*)g.Bt + (size_t)nxt.pn * tstep : cB;
        for (int t = 0; t < nt; t += 2) {
            const bool last = (t == nt - 2);
            const char* a1 = cA + (size_t)(t + 1) * kstep;
            const char* a2 = last ? nA : cA + (size_t)(t + 2) * kstep; const char* b2 = last ? nB : cB + (size_t)(t + 2) * kstep;
            const char* a3 = a2 + kstep; const char* b3 = b2 + kstep;
            if constexpr (SP2) {
            PG8_LDB(B0, 0, 0); PG8_LDB(B1, 0, 1); PG8_SCHED; PG8_LDA(At, 0, 0); PG8_STAGE(PG8_SA(1, 1), a1 + hstep, voffA);
            PG8_WAIT_V(8); PG8_WAIT_L(0); PG8_BAR; PG8_MMA(0, 0, At, B0); PG8_MMA(0, 1, At, B1); PG8_BAR; PG8_SCHED;
            PG8_LDA(At, 0, 1); PG8_STAGE(PG8_SB(0, 0), b2, voffB); PG8_STAGE(PG8_SB(0, 1), b2 + hstep, voffB); PG8_STAGE(PG8_SA(0, 0), a2, voffA);
            PG8_WAIT_V(8); PG8_WAIT_L(0); PG8_BAR; PG8_MMA(1, 0, At, B0); PG8_MMA(1, 1, At, B1); PG8_BAR; PG8_SCHED;
            PG8_LDB(B0, 1, 0); PG8_LDB(B1, 1, 1); PG8_SCHED; PG8_LDA(At, 1, 0); PG8_STAGE(PG8_SA(0, 1), a2 + hstep, voffA);
            PG8_WAIT_V(8); PG8_WAIT_L(0); PG8_BAR; PG8_MMA(0, 0, At, B0); PG8_MMA(0, 1, At, B1); PG8_BAR; PG8_SCHED;
            PG8_LDA(At, 1, 1); PG8_STAGE(PG8_SB(1, 0), b3, voffB); PG8_STAGE(PG8_SB(1, 1), b3 + hstep, voffB); PG8_STAGE(PG8_SA(1, 0), a3, voffA);
            PG8_WAIT_V(8); PG8_WAIT_L(0); PG8_BAR; PG8_MMA(1, 0, At, B0); PG8_MMA(1, 1, At, B1); PG8_BAR; PG8_SCHED;
            } else {
            PG8_LDB(B0, 0, 0); PG8_SCHED; PG8_LDA(At, 0, 0); PG8_STAGE(PG8_SA(1, 1), a1 + hstep, voffA);
            PG8_WAIT_L(8); PG8_BAR; PG8_WAIT_L(0); PG8_MMA(0, 0, At, B0); PG8_BAR; PG8_SCHED;
            PG8_LDB(B1, 0, 1); PG8_STAGE(PG8_SB(0, 0), b2, voffB);
            PG8_BAR; PG8_WAIT_L(0); PG8_MMA(0, 1, At, B1); PG8_BAR;
            PG8_LDA(At, 0, 1); PG8_STAGE(PG8_SA(0, 0), a2, voffA);
            PG8_BAR; PG8_WAIT_L(0); PG8_MMA(1, 0, At, B0); PG8_BAR; PG8_SCHED;
            PG8_STAGE(PG8_SB(0, 1), b2 + hstep, voffB);
            PG8_WAIT_V(6); PG8_BAR; PG8_MMA(1, 1, At, B1); PG8_BAR;
            PG8_LDB(B0, 1, 0); PG8_SCHED; PG8_LDA(At, 1, 0); PG8_STAGE(PG8_SA(0, 1), a2 + hstep, voffA);
            PG8_WAIT_L(8); PG8_BAR; PG8_WAIT_L(0); PG8_MMA(0, 0, At, B0); PG8_BAR; PG8_SCHED;
            PG8_LDB(B1, 1, 1); PG8_STAGE(PG8_SB(1, 0), b3, voffB);
            PG8_BAR; PG8_WAIT_L(0); PG8_MMA(0, 1, At, B1); PG8_BAR;
            PG8_LDA(At, 1, 1); PG8_STAGE(PG8_SA(1, 0), a3, voffA);
            PG8_BAR; PG8_WAIT_L(0); PG8_MMA(1, 0, At, B0); PG8_BAR; PG8_SCHED;
            PG8_STAGE(PG8_SB(1, 1), b3 + hstep, voffB);
            PG8_WAIT_V(6); PG8_BAR; PG8_MMA(1, 1, At, B1); PG8_BAR;
            }
        }
        if constexpr (ALIGN_EPI) { if (wr == 0) PG8_BAR; }
        E(acc, cur, wr, wc, fr, fq);
        if (!has_next) break;
#pragma unroll
        for (int a = 0; a < 2; ++a)
#pragma unroll
            for (int b = 0; b < 2; ++b)
#pragma unroll
                for (int m = 0; m < 4; ++m)
#pragma unroll
                    for (int n = 0; n < 2; ++n) acc[a][b][m][n] = (f32x4){0.f, 0.f, 0.f, 0.f};
        cur = nxt; cA = nA; cB = nB; ++ui;
        if constexpr (ALIGN_EPI) { if (wr == 1) PG8_BAR; }
    }
    PG8_WAIT_V(0);
    if constexpr (!ALIGN_EPI) { if (wr == 0) PG8_BAR; }
    PG8_BAR;
#undef PG8_SA
#undef PG8_SB
#undef PG8_STAGE
#undef PG8_LDA
#undef PG8_LDB
#undef PG8_MMA
#undef PG8_WAIT_V
#undef PG8_WAIT_L
#undef PG8_BAR
#undef PG8_SCHED
}
}

#define XB_TMO      128
#define XB_XCNT(j)  (256  + 64 * (j))
#define XB_XSUB(j)  (1280 + 64 * (j))
#define XB_XGEN(j)  (2304 + 64 * (j))
#define XB_TOP      3328
#define XB_TOPGEN   3392
#define XCD_BAR_WORDS 3456
#define XB_SPIN_CAP (1u << 20)
__device__ __forceinline__ unsigned xb_ld(unsigned* p)              { return __hip_atomic_load(p, __ATOMIC_RELAXED, __HIP_MEMORY_SCOPE_AGENT); }
__device__ __forceinline__ unsigned xb_add(unsigned* p, unsigned v) { return __hip_atomic_fetch_add(p, v, __ATOMIC_RELAXED, __HIP_MEMORY_SCOPE_AGENT); }
__device__ __forceinline__ unsigned xb_xcc_id() { return (unsigned)__builtin_amdgcn_s_getreg((3 << 11) | 20) & 0xFu; }
#define XB_SPIN(cond, bar) do { unsigned _sp = 0; while (cond) { __builtin_amdgcn_s_sleep(1); \
    if ((++_sp & 255u) == 0u) { if (xb_ld(&(bar)[XB_TMO])) break; if (_sp > XB_SPIN_CAP) { atomicAdd(&(bar)[XB_TMO], 1u); break; } } } } while (0)
struct XcdBarrier { unsigned* bar; unsigned x; volatile LAS unsigned* st; };
__device__ __forceinline__ XcdBarrier xcd_barrier_post(unsigned* bar, volatile LAS unsigned* st) {
    XcdBarrier b; b.bar = bar; b.x = xb_xcc_id(); b.st = st;
    if (threadIdx.x == 0) (void)xb_add(&bar[XB_XCNT(b.x)], 1u);
    return b;
}
__device__ __forceinline__ void xcd_barrier_complete(unsigned* bar, unsigned x, unsigned& nloc, unsigned& nx) {
    const unsigned G = gridDim.x * gridDim.y * gridDim.z;
    unsigned sum, cnt, mine, sp = 0u;
    for (;;) {
        sum = 0u; cnt = 0u; mine = 0u;
#pragma unroll
        for (unsigned j = 0; j < 16; ++j) { const unsigned c = xb_ld(&bar[XB_XCNT(j)]); sum += c; cnt += (c > 0u) ? 1u : 0u; mine = (j == x) ? c : mine; }
        if (sum == G) break;
        __builtin_amdgcn_s_sleep(1);
        if ((++sp & 255u) == 0u) { if (xb_ld(&bar[XB_TMO])) break; if (sp > XB_SPIN_CAP) { atomicAdd(&bar[XB_TMO], 1u); break; } }
    }
    nloc = mine > 0u ? mine : 1u; nx = cnt > 0u ? cnt : 1u;
}
__device__ __forceinline__ void xcd_barrier(const XcdBarrier& b) {
    asm volatile("s_waitcnt vmcnt(0)" ::: "memory");
    __syncthreads();
    if (threadIdx.x == 0) {
        unsigned* bar = b.bar;
        __builtin_amdgcn_s_waitcnt(0);
        unsigned nloc = b.st[0], nx = b.st[1];
        if (nloc == 0u) { xcd_barrier_complete(bar, b.x, nloc, nx); b.st[0] = nloc; b.st[1] = nx; }
        const unsigned old = xb_add(&bar[XB_XSUB(b.x)], 1u);
        const unsigned gen = old / nloc;
        if (old + 1u == (gen + 1u) * nloc) {
            __builtin_amdgcn_fence(__ATOMIC_RELEASE, "agent");
            asm volatile("s_waitcnt vmcnt(0)" ::: "memory");
            const unsigned og = xb_add(&bar[XB_TOP], 1u);
            const unsigned tg = og / nx;
            if (og + 1u == (tg + 1u) * nx) xb_add(&bar[XB_TOPGEN], 1u);
            else XB_SPIN(xb_ld(&bar[XB_TOPGEN]) == tg, bar);
            __builtin_amdgcn_fence(__ATOMIC_ACQUIRE, "agent");
            xb_add(&bar[XB_XGEN(b.x)], 1u);
            asm volatile("s_waitcnt vmcnt(0)" ::: "memory");
        } else {
            XB_SPIN(xb_ld(&bar[XB_XGEN(b.x)]) == gen, bar);
            __builtin_amdgcn_fence(__ATOMIC_ACQUIRE, "agent");
            asm volatile("s_waitcnt vmcnt(0)" ::: "memory");
        }
    }
    __syncthreads();
}

struct Args { const float* in[28]; float* out; unsigned char* ws; int ph_lo, ph_hi, sub, pad; };
enum { I_X = 0, I_FFN_NORM, I_WG, I_WU, I_WD, I_MIX_NORM, I_WIN, I_WOUT, I_QN, I_KN, I_MU, I_W0, I_WUP, I_A0, I_AUP, I_GUP, I_KK, I_KA, I_RK, I_GNW, I_GNB, I_V0, I_VDOWN, I_VUP, I_CONV, I_ALOG, I_DTB, I_ONORM };

typedef const __attribute__((address_space(4))) Args* ArgsP;
struct Ctx {
    LAS unsigned char* lds;
    int tid, lane, wave, G, bid;
    ArgsP a;
};

template <class Get>
__device__ __forceinline__ void cvt_item(Get get, int K, bf16_t* WT, LAS float* scr, int kb, int nb, int lane) {
    const int k0 = 64 * kb, n0 = 32 * nb;
#pragma unroll 8
    for (int i = 0; i < 32; ++i) { const int kk = 2 * i + (lane >> 5); scr[kk * 33 + (lane & 31)] = get(k0 + kk, n0 + (lane & 31)); }
    asm volatile("s_waitcnt lgkmcnt(0)" ::: "memory");
    const int c = lane & 7;
#pragma unroll
    for (int j = 0; j < 4; ++j) { const int n = (lane >> 3) + 8 * j; const LAS float* s = scr + (8 * c) * 33 + n;
        u32x4 o; o.x = pk2(s[0 * 33], s[1 * 33]); o.y = pk2(s[2 * 33], s[3 * 33]); o.z = pk2(s[4 * 33], s[5 * 33]); o.w = pk2(s[6 * 33], s[7 * 33]);
        *(u32x4*)(WT + (size_t)(n0 + n) * K + k0 + 8 * c) = o; }
    asm volatile("s_waitcnt lgkmcnt(0)" ::: "memory");
}
__device__ __forceinline__ int win_cmap(int nn) {
    if (nn < 1352) return nn;
    if (nn < 1356) return 3272 + (nn - 1352);
    if (nn < 1360) return 3276 + (nn - 1356);
    if (nn < 1408) return -1;
    if (nn < 2304) return 1352 + (nn - 1408);
    return 2248 + (nn - 2304);
}
__device__ __forceinline__ void convert_layer_weights(const Ctx& C, int l) {
    const ArgsP Ap = C.a;
    LAS float* scr = (LAS float*)(C.lds + C.wave * 16384);
    unsigned char* wb = Ap->ws + WS_W;
    const int gw = C.bid * 8 + C.wave, NGW = C.G * 8;
    constexpr int I_GU = (DM / 64) * (NGU / 32), I_D = (FF / 64) * (DM / 32), I_IN = (DM / 64) * (NIN / 32), I_OUT = (DM / 64) * (DM / 32);
    constexpr int NIT = 2 * I_GU + 2 * I_D + I_IN + I_OUT;
    for (int it = gw; it < NIT; it += NGW) {
        int r = it;
        if (r < 2 * I_GU) { const int f = r / I_GU; r -= f * I_GU; const int nblk = NGU / 32, kb = r / nblk, nb = r % nblk;
            const float* wg = Ap->in[I_WG] + (size_t)(l * 2 + f) * DM * FF; const float* wu = Ap->in[I_WU] + (size_t)(l * 2 + f) * DM * FF; const float* gv = Ap->in[I_FFN_NORM] + (size_t)(l * 2 + f) * DM;
            auto get = [=](int k, int nn) -> float { const int pn = nn >> 8, bj = (nn >> 7) & 1, j = nn & 127; const float* w = bj ? wu : wg; return w[(size_t)k * FF + pn * 128 + j] * gv[k]; };
            cvt_item(get, DM, (bf16_t*)(wb + (f ? W_GU2 : W_GU1)), scr, kb, nb, C.lane); continue; }
        r -= 2 * I_GU;
        if (r < 2 * I_D) { const int f = r / I_D; r -= f * I_D; const int nblk = DM / 32, kb = r / nblk, nb = r % nblk;
            const float* wd = Ap->in[I_WD] + (size_t)(l * 2 + f) * FF * DM;
            auto get = [=](int k, int nn) -> float { return wd[(size_t)k * DM + nn]; };
            cvt_item(get, FF, (bf16_t*)(wb + (f ? W_D2 : W_D1)), scr, kb, nb, C.lane); continue; }
        r -= 2 * I_D;
        if (r < I_IN) { const int nblk = NIN / 32, kb = r / nblk, nb = r % nblk;
            const float* wi = Ap->in[I_WIN] + (size_t)l * DM * 3280; const float* gv = Ap->in[I_MIX_NORM] + (size_t)l * DM;
            auto get = [=](int k, int nn) -> float { const int c = win_cmap(nn); return c < 0 ? 0.f : wi[(size_t)k * 3280 + c] * gv[k]; };
            cvt_item(get, DM, (bf16_t*)(wb + W_IN), scr, kb, nb, C.lane); continue; }
        r -= I_IN;
        { const int nblk = DM / 32, kb = r / nblk, nb = r % nblk;
            const float* wo = Ap->in[I_WOUT] + (size_t)l * DM * DM;
            auto get = [=](int k, int nn) -> float { return wo[(size_t)k * DM + nn]; };
            cvt_item(get, DM, (bf16_t*)(wb + W_OUT), scr, kb, nb, C.lane); }
    }
}

__device__ const float ROPE_INV_HI[32] = {1.000000000e+00f, 7.498942018e-01f, 5.623413324e-01f, 4.216965139e-01f, 3.162277639e-01f, 2.371373773e-01f, 1.778279394e-01f, 1.333521456e-01f, 1.000000015e-01f, 7.498942316e-02f, 5.623413250e-02f, 4.216964915e-02f, 3.162277490e-02f, 2.371373773e-02f, 1.778279431e-02f, 1.333521400e-02f, 9.999999776e-03f, 7.498942316e-03f, 5.623413250e-03f, 4.216964822e-03f, 3.162277630e-03f, 2.371373819e-03f, 1.778279431e-03f, 1.333521446e-03f, 1.000000047e-03f, 7.498941850e-04f, 5.623413017e-04f, 4.216965172e-04f, 3.162277571e-04f, 2.371373703e-04f, 1.778279402e-04f, 1.333521504e-04f};
__device__ const float ROPE_INV_LO[32] = {0.000000000e+00f, 7.576931971e-09f, -7.245258615e-09f, -1.046263787e-08f, 2.125617904e-09f, -6.695950017e-09f, 1.612756151e-09f, -2.336302707e-09f, -1.490116142e-09f, -2.222539042e-09f, 2.053218012e-11f, 1.188910415e-09f, 1.702677888e-09f, -6.695949906e-10f, -2.112534175e-10f, 3.251632574e-10f, 2.235174129e-10f, -2.222539097e-10f, 2.053217839e-12f, 2.120233017e-10f, 3.056940465e-11f, -1.135256264e-10f, -2.112534106e-11f, -1.404980212e-11f, -4.749745042e-11f, 2.434073776e-11f, 2.348838658e-11f, -1.372226725e-11f, 8.877706729e-12f, 2.889693693e-13f, 7.978488746e-13f, -7.225746477e-12f};
__device__ __forceinline__ void prologue_x(const Ctx& C) {
    const ArgsP Ap = C.a;
    const float* x = Ap->in[I_X]; bf16_t* xbf = (bf16_t*)(Ap->ws + WS_XBF); float* ssq = (float*)(Ap->ws + WS_SSQ);
    const int gw = C.bid * 8 + C.wave, NGW = C.G * 8;
    for (int m = gw; m < MTOK; m += NGW) {
        const f32x4* xr = (const f32x4*)(x + (size_t)m * DM) + C.lane;
        f32x4 v[4]; float s = 0.f;
#pragma unroll
        for (int j = 0; j < 4; ++j) { v[j] = xr[64 * j]; s += (v[j][0] * v[j][0] + v[j][1] * v[j][1]) + (v[j][2] * v[j][2] + v[j][3] * v[j][3]); }
        s = wave_sum(s);
        u32x2* o8 = (u32x2*)(xbf + (size_t)m * DM) + C.lane;
#pragma unroll
        for (int j = 0; j < 4; ++j) { u32x2 w; w.x = pk2(v[j][0], v[j][1]); w.y = pk2(v[j][2], v[j][3]); o8[64 * j] = w; }
        if (C.lane < 16) ssq[(size_t)m * 16 + C.lane] = (C.lane == 0) ? s : 0.f;
    }
    f32x2* cs = (f32x2*)(Ap->ws + WS_ROPE);
    const int gt = C.bid * 512 + C.tid, NT = C.G * 512;
    for (int e = gt; e < SEQ * 32; e += NT) {
        const int pos = e >> 5, i = e & 31;
        const float fpos = (float)pos, ih = ROPE_INV_HI[i], il = ROPE_INV_LO[i];
        const float ph = fpos * ih; const float pe = fmaf(fpos, ih, -ph) + fpos * il;
        const float k = rintf(ph * 0.15915494309189535f);
        float r = fmaf(-k, 6.2831854820251465f, ph); r = fmaf(-k, -1.7484555e-07f, r); r += pe;
        const float r2 = r * r;
        float ts = 1.f, tc = 1.f;
        ts = 1.f - ts * r2 * (1.f / (18.f * 19.f)); ts = 1.f - ts * r2 * (1.f / (16.f * 17.f)); ts = 1.f - ts * r2 * (1.f / (14.f * 15.f)); ts = 1.f - ts * r2 * (1.f / (12.f * 13.f));
        ts = 1.f - ts * r2 * (1.f / (10.f * 11.f)); ts = 1.f - ts * r2 * (1.f / (8.f * 9.f)); ts = 1.f - ts * r2 * (1.f / (6.f * 7.f)); ts = 1.f - ts * r2 * (1.f / (4.f * 5.f)); ts = 1.f - ts * r2 * (1.f / (2.f * 3.f));
        tc = 1.f - tc * r2 * (1.f / (19.f * 20.f)); tc = 1.f - tc * r2 * (1.f / (17.f * 18.f)); tc = 1.f - tc * r2 * (1.f / (15.f * 16.f)); tc = 1.f - tc * r2 * (1.f / (13.f * 14.f)); tc = 1.f - tc * r2 * (1.f / (11.f * 12.f));
        tc = 1.f - tc * r2 * (1.f / (9.f * 10.f)); tc = 1.f - tc * r2 * (1.f / (7.f * 8.f)); tc = 1.f - tc * r2 * (1.f / (5.f * 6.f)); tc = 1.f - tc * r2 * (1.f / (3.f * 4.f)); tc = 1.f - tc * r2 * (1.f / (1.f * 2.f));
        cs[e] = (f32x2){tc, ts * r};
    }
}

__device__ __forceinline__ void prep_phase(const Ctx& C, int l) {
    const ArgsP Ap = C.a;
    bf16_t* P = (bf16_t*)(Ap->ws + WS_P);
    const f32x2* cs = (const f32x2*)(Ap->ws + WS_ROPE);
    const float* qn = Ap->in[I_QN] + l * 64; const float* kn = Ap->in[I_KN] + l * 64;
    {
        const int gw = C.bid * 8 + C.wave, NGW = C.G * 8; const int hl = C.lane >> 5, i = C.lane & 31;
        for (int rep = 0; rep < ((PROBE_DUP & 128) ? 2 : 1); ++rep)
        for (int m = gw; m < MTOK; m += NGW) {
            const int pos = m & (SEQ - 1); const f32x2 c = cs[pos * 32 + i];
            bf16_t* row = P + (size_t)m * NIN;
#pragma unroll 1
            for (int hp = 0; hp < 10; ++hp) {
                const int hd = hp * 2 + hl; if (hd >= 19) continue;
                int col; const float* nw = nullptr; float sc = 1.f;
                if (hd < 8) { col = PQ + hd * 64; nw = qn; sc = 0.125f; } else if (hd < 10) { col = PK + (hd - 8) * 64; nw = kn; } else if (hd < 18) { col = PQI + (hd - 10) * 64; } else { col = PKI; }
                float x1 = bf2f(row[col + i]), x2 = bf2f(row[col + 32 + i]);
                if (nw) { float ss = x1 * x1 + x2 * x2;
#pragma unroll
                    for (int o = 1; o < 32; o <<= 1) ss += __shfl_xor(ss, o);
                    const float rs = rsqrtf(ss * (1.f / 64.f) + NORM_EPS) * sc; x1 = x1 * rs * nw[i]; x2 = x2 * rs * nw[i + 32]; }
                const float o1 = x1 * c[0] - x2 * c[1], o2 = x2 * c[0] + x1 * c[1];
                if ((PROBE_DUP & 128) && rep == 0) { bf16_t* dr = (bf16_t*)(Ap->ws + WS_Y) + (size_t)m * DM + (col & 1023); dr[i] = (bf16_t)f2bf(o1); dr[32 + i] = (bf16_t)f2bf(o2); }
                else { row[col + i] = (bf16_t)f2bf(o1); row[col + 32 + i] = (bf16_t)f2bf(o2); }
            }
        }
    }
    {
        bf16_t* LO = (bf16_t*)(Ap->ws + WS_XBF);
        LAS float* in128 = (LAS float*)C.lds;
        LAS float* vt = (LAS float*)(C.lds + 32768);
        LAS float* vd = (LAS float*)(C.lds + 32768 + 65536);
        const float* mu = Ap->in[I_MU] + l * 896;
        const int c0 = C.tid & 255, half = C.tid >> 8;
        for (int rep = 0; rep < ((PROBE_DUP & 64) ? 2 : 1); ++rep)
        for (int tile = C.bid; tile < MTOK / 64; tile += C.G) {
            const int m0 = tile * 64;
            int c = c0; asm volatile("" : "+v"(c));
            __syncthreads();
            for (int e = C.tid; e < 64 * 128; e += 512) { const int t = e >> 7, j = e & 127; const int m = m0 + t; const bf16_t* row = P + (size_t)m * NIN + PRW + 768;
                const float cur = bf2f(row[j]); const float prev = (m & (SEQ - 1)) ? bf2f(row[j - NIN]) : 0.f; float h = cur + (prev - cur) * mu[768 + j];
                if (j < 32) h = tanhf(h); else if (j >= 64) h = sigmoidf_(h);
                in128[e] = h; }
            if (l > 0) {
                for (int e = C.tid; e < 64 * 256; e += 512) { const int t = e >> 8, j = e & 255; const int m = m0 + t; const bf16_t* row = P + (size_t)m * NIN + PRW + 512;
                    const float cur = bf2f(row[j]); const float prev = (m & (SEQ - 1)) ? bf2f(row[j - NIN]) : 0.f; vt[e] = cur + (prev - cur) * mu[512 + j]; }
                __syncthreads();
                const float* vdn = Ap->in[I_VDOWN] + (size_t)(l - 1) * 256 * 32;
                for (int e = C.tid; e < 64 * 32; e += 512) { const int t = e >> 5, j = e & 31; float s = 0.f;
                    for (int k = 0; k < 256; ++k) s += vt[t * 256 + k] * vdn[k * 32 + j];
                    vd[e] = s; }
            }
            __syncthreads();
            const int tb = half * 32;
            { const float* wup = Ap->in[I_WUP] + (size_t)l * 32 * 256; float w[32];
#pragma unroll
              for (int j = 0; j < 32; ++j) w[j] = wup[j * 256 + c];
              const float w0 = Ap->in[I_W0][l * 256 + c];
              asm volatile("" ::: "memory");
#pragma unroll 1
              for (int t = tb; t < tb + 32; ++t) { float s = w0;
#pragma unroll
                  for (int j = 0; j < 32; ++j) s += in128[t * 128 + j] * w[j];
                  const float wlog = -softplusf_(-s) - 0.5f; LO[(size_t)(m0 + t) * 1024 + c] = (bf16_t)f2bf(-__expf(wlog)); } }
            { const float* aup = Ap->in[I_AUP] + (size_t)l * 32 * 256; float w[32];
#pragma unroll
              for (int j = 0; j < 32; ++j) w[j] = aup[j * 256 + c];
              const float a0 = Ap->in[I_A0][l * 256 + c];
              asm volatile("" ::: "memory");
#pragma unroll 1
              for (int t = tb; t < tb + 32; ++t) { float s = a0;
#pragma unroll
                  for (int j = 0; j < 32; ++j) s += in128[t * 128 + 32 + j] * w[j];
                  LO[(size_t)(m0 + t) * 1024 + 256 + c] = (bf16_t)f2bf(sigmoidf_(s)); } }
            { const float* gup = Ap->in[I_GUP] + (size_t)l * 64 * 256; float w[64];
#pragma unroll
              for (int j = 0; j < 64; ++j) w[j] = gup[j * 256 + c];
              asm volatile("" ::: "memory");
#pragma unroll 1
              for (int t = tb; t < tb + 32; ++t) { float s = 0.f;
#pragma unroll
                  for (int j = 0; j < 64; ++j) s += in128[t * 128 + 64 + j] * w[j];
                  LO[(size_t)(m0 + t) * 1024 + 512 + c] = (bf16_t)f2bf(s); } }
            if (l > 0) { const float* vup = Ap->in[I_VUP] + (size_t)(l - 1) * 32 * 256; float w[32];
#pragma unroll
              for (int j = 0; j < 32; ++j) w[j] = vup[j * 256 + c];
              const float v0 = Ap->in[I_V0][(l - 1) * 256 + c];
              asm volatile("" ::: "memory");
#pragma unroll 1
              for (int t = tb; t < tb + 32; ++t) { float s = v0;
#pragma unroll
                  for (int j = 0; j < 32; ++j) s += vd[t * 32 + j] * w[j];
                  LO[(size_t)(m0 + t) * 1024 + 768 + c] = (bf16_t)f2bf(sigmoidf_(s)); } }
        }
        __syncthreads();
    }
}

constexpr int CK_ST = 144, CK_MAT = 64 * CK_ST, CK_FS = 68;
template <int MODE> struct CkL {
    static constexpr int YA = 0, XB = CK_MAT, XK = 2 * CK_MAT;
    static constexpr int YR = 3 * CK_MAT, ATS = 4 * CK_MAT, RTS = 5 * CK_MAT;
    static constexpr int B0 = MODE == 0 ? 3 * CK_MAT : 6 * CK_MAT;
    static constexpr int VT = B0, BBT = B0 + CK_MAT, KBT = B0 + 2 * CK_MAT, MBR = BBT, MKR = KBT, NAK = B0 + 3 * CK_MAT, WBF = B0 + 4 * CK_MAT;
    static constexpr int S0 = WBF + CK_MAT;
    static constexpr int F0 = MODE == 0 ? B0 + 6 * CK_MAT : B0 + 6 * CK_MAT;
    static constexpr int NAB = F0;
    static constexpr int Z = NAB + 64 * CK_FS * 4;
    static constexpr int TJ = Z + (MODE == 0 ? 128 : 64) * CK_FS * 4;
    static constexpr int SC = TJ + 4096;
    static constexpr int END = SC + (3 * 64 + 512) * 4;
};
static_assert(CkL<0>::END <= LDS_MISC && CkL<1>::END <= LDS_MISC, "chunk lds");

constexpr size_t WS_PST = 224 * MiB, WS_DS = 240 * MiB;
constexpr int CW_CNTA = 12288, CW_FLAGB = 14336;

__device__ __forceinline__ void mm2(f32x4 (&c)[2], const LAS unsigned char* A, const LAS unsigned char* B, int tm, int tn0, int lane) {
    const int r = lane & 15, g = lane >> 4;
#pragma unroll
    for (int s = 0; s < 2; ++s) {
        const bf16x8 a = *(const LAS bf16x8*)(A + (tm * 16 + r) * CK_ST + (32 * s + 8 * g) * 2);
#pragma unroll
        for (int q = 0; q < 2; ++q) { const bf16x8 b = *(const LAS bf16x8*)(B + ((tn0 + q) * 16 + r) * CK_ST + (32 * s + 8 * g) * 2);
            c[q] = __builtin_amdgcn_mfma_f32_16x16x32_bf16(a, b, c[q], 0, 0, 0); }
    }
}
__device__ __forceinline__ void st_bf(LAS unsigned char* base, int row, int col, float v) { *(LAS bf16_t*)(base + row * CK_ST + col * 2) = (bf16_t)f2bf(v); }
__device__ __forceinline__ void st8_bf(LAS unsigned char* base, int row, int col0, const float (&v)[8]) {
    u32x4 w; w.x = pk2(v[0], v[1]); w.y = pk2(v[2], v[3]); w.z = pk2(v[4], v[5]); w.w = pk2(v[6], v[7]); *(LAS u32x4*)(base + row * CK_ST + col0 * 2) = w; }

struct CkTok { float v[8], p0[8], p1[8]; };
template <int MODE> __device__ __forceinline__ void ck_store_tok(LAS unsigned char* lds, int t, int lane, float ya, float xb, float xk, float yr, float ats, float rts) {
    typedef CkL<MODE> L;
    st_bf(lds + L::YA, t, lane, ya); st_bf(lds + L::XB, t, lane, xb); st_bf(lds + L::XK, t, lane, xk);
    if (MODE == 1) { st_bf(lds + L::YR, t, lane, yr); st_bf(lds + L::ATS, t, lane, ats); st_bf(lds + L::RTS, t, lane, rts); }
}

template <int MODE>
__device__ __forceinline__ void rwkv_prep(const Ctx& C, int l, int b, int h, int n, CkTok& K, LAS unsigned char* lds) {
    typedef CkL<MODE> L; LAS float* Gs = (LAS float*)(lds + L::SC); LAS float* Bs = Gs + 64; LAS float* Gam = Gs + 128; LAS float* wsum = Gs + 192; LAS float* Z = (LAS float*)(lds + L::Z);
    const ArgsP Ap = C.a; const int lane = C.lane, w = C.wave, ch = h * 64 + lane;
    const bf16_t* P = (const bf16_t*)(Ap->ws + WS_P); const bf16_t* LO = (const bf16_t*)(Ap->ws + WS_XBF); bf16_t* VF = (bf16_t*)(Ap->ws + WS_VF);
    const float* mu = Ap->in[I_MU] + l * 896;
    const float mu_r = mu[ch], mu_k = mu[256 + ch], mu_v = mu[512 + ch];
    const float k_k = Ap->in[I_KK][l * 256 + ch], k_a = Ap->in[I_KA][l * 256 + ch], r_k = Ap->in[I_RK][l * 256 + ch];
    const int tq0 = n * 64 + 8 * w;
    const size_t m0 = (size_t)b * SEQ + tq0;
    float rp = 0.f, kp = 0.f, vp = 0.f;
    if (tq0 > 0) { const bf16_t* row = P + (m0 - 1) * NIN + PRW; rp = bf2f(row[ch]); kp = bf2f(row[256 + ch]); vp = bf2f(row[512 + ch]); }
    float lw[8], as[8], bs_[8], k2[8], rr[8];
#pragma unroll
    for (int tt = 0; tt < 8; ++tt) {
        const size_t m = m0 + tt; const bf16_t* row = P + m * NIN + PRW; const bf16_t* lo = LO + m * 1024;
        const float rc = bf2f(row[ch]), kc = bf2f(row[256 + ch]), vc = bf2f(row[512 + ch]);
        const float r = rc + (rp - rc) * mu_r, k = kc + (kp - kc) * mu_k; float v = vc + (vp - vc) * mu_v;
        rp = rc; kp = kc; vp = vc;
        const float wl = bf2f(lo[ch]), a = bf2f(lo[256 + ch]);
        if (l == 0) { if (MODE == 0) VF[m * 256 + ch] = (bf16_t)f2bf(v); }
        else { const float vg = bf2f(lo[768 + ch]); const float vf = bf2f(VF[m * 256 + ch]); v = v + (vf - v) * vg; }
        const float kkp = k * k_k; const float n2 = wave_sum(kkp * kkp); const float kk = kkp * rsqrtf(n2 + 1e-12f);
#if defined(SELFCHECK)
        { const float n2b = wave_sum_shfl(kkp * kkp); if (!(fabsf(n2 - n2b) <= 1e-4f * fabsf(n2b) + 1e-20f)) *((unsigned*)(Ap->ws + WS_CTL) + 16) = 1u; }
#endif
        k2[tt] = k * (1.f + (a - 1.f) * k_a); as[tt] = -kk; bs_[tt] = kk * a; rr[tt] = r; lw[tt] = wl; K.v[tt] = v;
        if (MODE == 1) { K.p0[tt] = wave_sum(r * k2[tt] * r_k); K.p1[tt] = bf2f(lo[512 + ch]); }
    }
    float g[8]; g[0] = lw[0];
#pragma unroll
    for (int tt = 1; tt < 8; ++tt) g[tt] = g[tt - 1] + lw[tt];
    wsum[w * 64 + lane] = g[7];
    __syncthreads();
    float pre = 0.f, tot = 0.f;
#pragma unroll
    for (int ww = 0; ww < 8; ++ww) { const float s = wsum[ww * 64 + lane]; tot += s; if (ww < w) pre += s; }
    float bb[8], kb[8], at[8];
#pragma unroll
    for (int tt = 0; tt < 8; ++tt) {
        const float G = pre + g[tt], Gp = G - lw[tt];
        const float eG = __expf(G), eGi = __expf(-G), eGp = __expf(Gp), eT = __expf(tot - G);
        const float ya = as[tt] * eGp, yr = rr[tt] * eG;
        ck_store_tok<MODE>(lds, 8 * w + tt, lane, ya, bs_[tt] * eGi, k2[tt] * eGi, yr, ya, yr);
        bb[tt] = bs_[tt] * eT; kb[tt] = k2[tt] * eT; at[tt] = ya;
    }
    st8_bf(lds + L::VT, lane, 8 * w, K.v);
    if (MODE == 0) { st8_bf(lds + L::BBT, lane, 8 * w, bb); st8_bf(lds + L::KBT, lane, 8 * w, kb);
#pragma unroll
        for (int tt = 0; tt < 8; ++tt) Z[(64 + lane) * CK_FS + 8 * w + tt] = at[tt];
        if (w == 0) Gam[lane] = __expf(tot); }
    if (lane < 8) { Gs[8 * w + lane] = 0.f; Bs[8 * w + lane] = 1.f; }
}
template <int MODE>
__device__ __forceinline__ void gdn_prep(const Ctx& C, int l, int b, int h, int n, CkTok& K, LAS unsigned char* lds) {
    typedef CkL<MODE> L; LAS float* Gs = (LAS float*)(lds + L::SC); LAS float* Bs = Gs + 64; LAS float* Gam = Gs + 128; LAS float* wsum = Gs + 192; LAS float* Z = (LAS float*)(lds + L::Z);
    const ArgsP Ap = C.a; const int lane = C.lane, w = C.wave, ch = h * 64 + lane;
    const bf16_t* P = (const bf16_t*)(Ap->ws + WS_P);
    const float* cw = Ap->in[I_CONV] + (size_t)l * 4 * 768;
    float wq[4], wk[4], wv[4];
#pragma unroll
    for (int j = 0; j < 4; ++j) { wq[j] = cw[j * 768 + ch]; wk[j] = cw[j * 768 + 256 + ch]; wv[j] = cw[j * 768 + 512 + ch]; }
    const float nexpa = -__expf(Ap->in[I_ALOG][l * 4 + h]), dtb = Ap->in[I_DTB][l * 4 + h];
    const int tq0 = n * 64 + 8 * w; const size_t m0 = (size_t)b * SEQ + tq0;
    float xq[3], xk[3], xv[3];
#pragma unroll
    for (int d = 0; d < 3; ++d) { const int t = tq0 - 3 + d; xq[d] = 0.f; xk[d] = 0.f; xv[d] = 0.f;
        if (t >= 0) { const bf16_t* rr = P + (m0 - 3 + d) * NIN + PGD; xq[d] = bf2f(rr[ch]); xk[d] = bf2f(rr[256 + ch]); xv[d] = bf2f(rr[512 + ch]); } }
    float lw[8], kr[8], qr[8], be[8];
#pragma unroll
    for (int tt = 0; tt < 8; ++tt) {
        const size_t m = m0 + tt; const bf16_t* row = P + m * NIN;
        const float cq = bf2f(row[PGD + ch]), ck = bf2f(row[PGD + 256 + ch]), cv = bf2f(row[PGD + 512 + ch]);
        float sq = wq[0] * xq[0] + wq[1] * xq[1] + wq[2] * xq[2] + wq[3] * cq;
        float sk = wk[0] * xk[0] + wk[1] * xk[1] + wk[2] * xk[2] + wk[3] * ck;
        float sv = wv[0] * xv[0] + wv[1] * xv[1] + wv[2] * xv[2] + wv[3] * cv;
        xq[0] = xq[1]; xq[1] = xq[2]; xq[2] = cq; xk[0] = xk[1]; xk[1] = xk[2]; xk[2] = ck; xv[0] = xv[1]; xv[1] = xv[2]; xv[2] = cv;
        sq = siluf_(sq); sk = siluf_(sk); sv = siluf_(sv);
        qr[tt] = sq * rsqrtf(wave_sum(sq * sq) + 1e-6f) * 0.125f; kr[tt] = sk * rsqrtf(wave_sum(sk * sk) + 1e-6f); K.v[tt] = sv;
        be[tt] = sigmoidf_(bf2f(row[PGB + h])); lw[tt] = nexpa * softplusf_(bf2f(row[PGA + h]) + dtb);
        if (MODE == 1) { K.p0[tt] = siluf_(bf2f(row[PGD + 768 + ch])); K.p1[tt] = 0.f; }
    }
    float g[8]; g[0] = lw[0];
#pragma unroll
    for (int tt = 1; tt < 8; ++tt) g[tt] = g[tt - 1] + lw[tt];
    wsum[w * 64 + lane] = g[7];
    __syncthreads();
    float pre = 0.f, tot = 0.f;
#pragma unroll
    for (int ww = 0; ww < 8; ++ww) { const float s = wsum[ww * 64 + lane]; tot += s; if (ww < w) pre += s; }
    float bb[8], kb[8], at[8];
#pragma unroll
    for (int tt = 0; tt < 8; ++tt) {
        const float G = pre + g[tt]; const float eG = __expf(G), eT = __expf(tot - G);
        ck_store_tok<MODE>(lds, 8 * w + tt, lane, kr[tt], -kr[tt], kr[tt], qr[tt], kr[tt] * eG, qr[tt] * eG);
        bb[tt] = -be[tt] * kr[tt] * eT; kb[tt] = -bb[tt]; at[tt] = kr[tt] * eG;
        if (lane == tt) { Gs[8 * w + tt] = G; Bs[8 * w + tt] = be[tt]; }
    }
    st8_bf(lds + L::VT, lane, 8 * w, K.v);
    if (MODE == 0) { st8_bf(lds + L::BBT, lane, 8 * w, bb); st8_bf(lds + L::KBT, lane, 8 * w, kb);
#pragma unroll
        for (int tt = 0; tt < 8; ++tt) Z[(64 + lane) * CK_FS + 8 * w + tt] = at[tt];
        if (w == 0) Gam[lane] = __expf(tot); }
}

template <int MODE, bool PUBLISH = true>
__device__ __forceinline__ void chunk_item(const Ctx& C, int l, int combo, int n) {
    typedef CkL<MODE> L;
    int lane_o = C.lane; asm volatile("" : "+v"(lane_o));
    const ArgsP Ap = C.a; const int lane = lane_o, w = C.wave, tid = w * 64 + lane, r16 = lane & 15, g4 = lane >> 4;
    const int mix = combo >> 3, bh = combo & 7, b = bh >> 2, h = bh & 3;
    LAS unsigned char* lds = C.lds;
    LAS float* NAB = (LAS float*)(lds + L::NAB); LAS float* Z = (LAS float*)(lds + L::Z); LAS float* TJ = (LAS float*)(lds + L::TJ);
    LAS float* Gs = (LAS float*)(lds + L::SC); LAS float* Bs = Gs + 64; LAS float* Gam = Gs + 128; LAS float* wsum = Gs + 192;
    bf16_t* PSTg = (bf16_t*)(Ap->ws + WS_PST) + ((size_t)combo * 128 + n) * 4096;
    bf16_t* DSg = (bf16_t*)(Ap->ws + WS_DS) + ((size_t)combo * 128 + n) * 4096;
    __syncthreads();
    CkTok K;
    Ctx C2 = C; C2.lane = lane; C2.tid = tid;
    if (mix == 0) rwkv_prep<MODE>(C2, l, b, h, n, K, lds); else gdn_prep<MODE>(C2, l, b, h, n, K, lds);
    if (MODE == 1) {
        const int vi = tid >> 3, c8 = (tid & 7) * 8;
        u32x4 v = (u32x4){0u, 0u, 0u, 0u};
        if (n > 0) v = *(const u32x4*)(DSg - 4096 + vi * 64 + c8);
        *(LAS u32x4*)(lds + L::S0 + vi * CK_ST + c8 * 2) = v;
    }
    __syncthreads();
    const int tm = w >> 1, tn0 = 2 * (w & 1);
    {
        f32x4 cab[2] = {{0.f, 0.f, 0.f, 0.f}, {0.f, 0.f, 0.f, 0.f}}, cak[2] = {{0.f, 0.f, 0.f, 0.f}, {0.f, 0.f, 0.f, 0.f}};
        mm2(cab, lds + L::YA, lds + L::XB, tm, tn0, lane); mm2(cak, lds + L::YA, lds + L::XK, tm, tn0, lane);
        f32x4 cbr[2] = {{0.f, 0.f, 0.f, 0.f}, {0.f, 0.f, 0.f, 0.f}}, ckr[2] = {{0.f, 0.f, 0.f, 0.f}, {0.f, 0.f, 0.f, 0.f}};
        if (MODE == 1) { mm2(cbr, lds + L::YR, lds + L::XB, tm, tn0, lane); mm2(ckr, lds + L::YR, lds + L::XK, tm, tn0, lane); }
#pragma unroll
        for (int q = 0; q < 2; ++q) { const int i = 16 * (tn0 + q) + r16; const float gi = Gs[i], bi = Bs[i];
#pragma unroll
            for (int rg = 0; rg < 4; ++rg) { const int t = 16 * tm + 4 * g4 + rg; const float f = (i <= t) ? bi * __expf(Gs[t] - gi) : 0.f; const float fs = (i < t) ? f : 0.f;
                NAB[t * CK_FS + i] = cab[q][rg] * fs; st_bf(lds + L::NAK, t, i, cak[q][rg] * fs);
                if (MODE == 1) { st_bf(lds + L::MBR, t, i, cbr[q][rg] * f); st_bf(lds + L::MKR, t, i, ckr[q][rg] * f); } } }
    }
    __syncthreads();
    {
        f32x4 cx[2] = {{0.f, 0.f, 0.f, 0.f}, {0.f, 0.f, 0.f, 0.f}};
        mm2(cx, lds + L::VT, lds + L::NAK, tm, tn0, lane);
        if (MODE == 1) mm2(cx, lds + L::S0, lds + L::ATS, tm, tn0, lane);
#pragma unroll
        for (int q = 0; q < 2; ++q)
#pragma unroll
            for (int rg = 0; rg < 4; ++rg) Z[(16 * tm + 4 * g4 + rg) * CK_FS + 16 * (tn0 + q) + r16] = cx[q][rg];
    }
    if (w == 0) {
        const int J = g4, r = r16; float T[16];
#pragma unroll
        for (int c = 0; c < 16; ++c) { float s = (c == r) ? 1.f : 0.f;
#pragma unroll
            for (int mm = 0; mm < 16; ++mm) if (mm < c) s += T[mm] * NAB[(16 * J + c) * CK_FS + 16 * J + mm];
            T[c] = s; }
#pragma unroll
        for (int c = 0; c < 16; ++c) TJ[J * 256 + r * 16 + c] = T[c];
    }
    __syncthreads();
    if (MODE == 0 || w < 4) {
        const int r0 = 16 * w;
#pragma unroll
        for (int J = 0; J < 4; ++J) {
            f32x4 acc;
#pragma unroll
            for (int rg = 0; rg < 4; ++rg) acc[rg] = Z[(r0 + 4 * g4 + rg) * CK_FS + 16 * J + r16];
#pragma unroll
            for (int I = 0; I < 4; ++I) if (I < J) {
#pragma unroll
                for (int q = 0; q < 4; ++q) { const float a = Z[(r0 + r16) * CK_FS + 16 * I + 4 * q + g4]; const float bq = NAB[(16 * J + r16) * CK_FS + 16 * I + 4 * q + g4];
                    acc = __builtin_amdgcn_mfma_f32_16x16x4f32(a, bq, acc, 0, 0, 0); } }
#pragma unroll
            for (int rg = 0; rg < 4; ++rg) Z[(r0 + 4 * g4 + rg) * CK_FS + 16 * J + r16] = acc[rg];
            f32x4 wv = {0.f, 0.f, 0.f, 0.f};
#pragma unroll
            for (int q = 0; q < 4; ++q) { const float a = Z[(r0 + r16) * CK_FS + 16 * J + 4 * q + g4]; const float bq = TJ[J * 256 + (4 * q + g4) * 16 + r16];
                wv = __builtin_amdgcn_mfma_f32_16x16x4f32(a, bq, wv, 0, 0, 0); }
#pragma unroll
            for (int rg = 0; rg < 4; ++rg) { Z[(r0 + 4 * g4 + rg) * CK_FS + 16 * J + r16] = wv[rg]; st_bf(lds + L::WBF, r0 + 4 * g4 + rg, 16 * J + r16, wv[rg]); }
        }
    }
    __syncthreads();
    if (MODE == 0) {
        f32x4 cp[2] = {{0.f, 0.f, 0.f, 0.f}, {0.f, 0.f, 0.f, 0.f}};
        mm2(cp, lds + L::WBF + 64 * CK_ST, lds + L::BBT, tm, tn0, lane);
        f32x4 cd[2] = {{0.f, 0.f, 0.f, 0.f}, {0.f, 0.f, 0.f, 0.f}};
        mm2(cd, lds + L::BBT, lds + L::WBF, tm, tn0, lane); mm2(cd, lds + L::KBT, lds + L::VT, tm, tn0, lane);
#pragma unroll
        for (int q = 0; q < 2; ++q) { const int jp = 16 * (tn0 + q) + r16, j0 = 16 * tm + 4 * g4; f32x4 v = cp[q];
#pragma unroll
            for (int rg = 0; rg < 4; ++rg) if (j0 + rg == jp) v[rg] += Gam[jp];
            const unsigned long long o = (unsigned long long)pk2(v[0], v[1]) | ((unsigned long long)pk2(v[2], v[3]) << 32);
            __hip_atomic_store((unsigned long long*)(PSTg + jp * 64 + j0), o, __ATOMIC_RELAXED, __HIP_MEMORY_SCOPE_AGENT);
            const int vi = jp; const unsigned long long o2 = (unsigned long long)pk2(cd[q][0], cd[q][1]) | ((unsigned long long)pk2(cd[q][2], cd[q][3]) << 32);
            __hip_atomic_store((unsigned long long*)(DSg + vi * 64 + j0), o2, __ATOMIC_RELAXED, __HIP_MEMORY_SCOPE_AGENT); }
        asm volatile("s_waitcnt vmcnt(0)" ::: "memory");
        __syncthreads();
        if (PUBLISH && tid == 0) {
            __hip_atomic_fetch_add((unsigned*)(Ap->ws + WS_CTL) + CW_CNTA + 64 * (16 * l + combo), 1u, __ATOMIC_RELAXED, __HIP_MEMORY_SCOPE_AGENT); }
    } else {
        f32x4 cy[2] = {{0.f, 0.f, 0.f, 0.f}, {0.f, 0.f, 0.f, 0.f}};
        mm2(cy, lds + L::RTS, lds + L::S0, tm, tn0, lane); mm2(cy, lds + L::MBR, lds + L::WBF, tm, tn0, lane); mm2(cy, lds + L::MKR, lds + L::VT, tm, tn0, lane);
#pragma unroll
        for (int q = 0; q < 2; ++q)
#pragma unroll
            for (int rg = 0; rg < 4; ++rg) Z[(16 * tm + 4 * g4 + rg) * CK_FS + 16 * (tn0 + q) + r16] = cy[q][rg];
        __syncthreads();
        bf16_t* Y = (bf16_t*)(Ap->ws + WS_Y);
        const int ch = h * 64 + lane; const size_t m0 = (size_t)b * SEQ + n * 64 + 8 * w;
        if (mix == 0) { const float gn_w = Ap->in[I_GNW][l * 256 + ch], gn_b = Ap->in[I_GNB][l * 256 + ch];
#pragma unroll
            for (int tt = 0; tt < 8; ++tt) { const float y = Z[(8 * w + tt) * CK_FS + lane]; const float mean = wave_sum(y) * (1.f / 64.f); const float d = y - mean; const float var = wave_sum(d * d) * (1.f / 64.f);
                const float yn = d * rsqrtf(var + 64e-5f) * gn_w + gn_b; Y[(m0 + tt) * DM + 512 + ch] = (bf16_t)f2bf((yn + K.p0[tt] * K.v[tt]) * K.p1[tt]); } }
        else { const float onw = Ap->in[I_ONORM][l * 64 + lane];
#pragma unroll
            for (int tt = 0; tt < 8; ++tt) { const float o = Z[(8 * w + tt) * CK_FS + lane]; const float rs = rsqrtf(wave_sum(o * o) * (1.f / 64.f) + NORM_EPS);
                Y[(m0 + tt) * DM + 768 + ch] = (bf16_t)f2bf(o * rs * onw * K.p0[tt]); } }
    }
}

__device__ __forceinline__ void chunk_phaseB(const Ctx& C, int l, int combo, int vt) {
    const ArgsP Ap = C.a; const int lane = C.lane, w = C.wave, r16 = lane & 15, g4 = lane >> 4;
    unsigned* ctl = (unsigned*)(Ap->ws + WS_CTL);
    if (C.tid == 0) { unsigned sp = 0; while (__hip_atomic_load(ctl + CW_CNTA + 64 * (16 * l + combo), __ATOMIC_RELAXED, __HIP_MEMORY_SCOPE_AGENT) < 128u) { __builtin_amdgcn_s_sleep(2); if (++sp > (1u << 24)) break; }
        __builtin_amdgcn_fence(__ATOMIC_ACQUIRE, "agent"); asm volatile("s_waitcnt vmcnt(0)" ::: "memory"); }
    __syncthreads();
    if (w != 0) return;
    const bf16_t* PSTg = (const bf16_t*)(Ap->ws + WS_PST) + (size_t)combo * 128 * 4096;
    bf16_t* DSg = (bf16_t*)(Ap->ws + WS_DS) + (size_t)combo * 128 * 4096;
    f32x4 st[4];
#pragma unroll
    for (int m = 0; m < 4; ++m) st[m] = (f32x4){0.f, 0.f, 0.f, 0.f};
    u32x2 pa[3][4][2][2], dd[3][4];
#define CKB_LOAD(sg, nn) do { const bf16_t* ps = PSTg + (size_t)(nn) * 4096; const bf16_t* ds = DSg + (size_t)(nn) * 4096; \
        _Pragma("unroll") for (int m = 0; m < 4; ++m) { dd[sg][m] = *(const u32x2*)(ds + (16 * vt + r16) * 64 + 16 * m + 4 * g4); \
            _Pragma("unroll") for (int s = 0; s < 2; ++s) { pa[sg][m][s][0] = *(const u32x2*)(ps + (16 * m + r16) * 64 + 32 * s + 4 * g4); pa[sg][m][s][1] = *(const u32x2*)(ps + (16 * m + r16) * 64 + 32 * s + 16 + 4 * g4); } } } while (0)
#define CKB_STEP(sg, nn) do { bf16x8 bb[2]; \
        _Pragma("unroll") for (int s = 0; s < 2; ++s) { u32x4 t4; t4.x = pk2(st[2 * s][0], st[2 * s][1]); t4.y = pk2(st[2 * s][2], st[2 * s][3]); t4.z = pk2(st[2 * s + 1][0], st[2 * s + 1][1]); t4.w = pk2(st[2 * s + 1][2], st[2 * s + 1][3]); bb[s] = __builtin_bit_cast(bf16x8, t4); } \
        f32x4 nw[4]; \
        _Pragma("unroll") for (int m = 0; m < 4; ++m) { f32x4 c = {bflo(dd[sg][m].x), bfhi(dd[sg][m].x), bflo(dd[sg][m].y), bfhi(dd[sg][m].y)}; \
            _Pragma("unroll") for (int s = 0; s < 2; ++s) { u32x4 a4; a4.x = pa[sg][m][s][0].x; a4.y = pa[sg][m][s][0].y; a4.z = pa[sg][m][s][1].x; a4.w = pa[sg][m][s][1].y; \
                c = __builtin_amdgcn_mfma_f32_16x16x32_bf16(__builtin_bit_cast(bf16x8, a4), bb[s], c, 0, 0, 0); } \
            nw[m] = c; } \
        asm volatile("" ::: "memory"); CKB_LOAD(sg, ((nn) + 3 < 128 ? (nn) + 3 : 127)); asm volatile("" ::: "memory"); __builtin_amdgcn_sched_barrier(0); \
        _Pragma("unroll") for (int m = 0; m < 4; ++m) { st[m] = nw[m]; u32x2 o; o.x = pk2(nw[m][0], nw[m][1]); o.y = pk2(nw[m][2], nw[m][3]); if (!dry) __hip_atomic_store((unsigned long long*)(DSg + (size_t)(nn) * 4096 + (16 * vt + r16) * 64 + 16 * m + 4 * g4), (unsigned long long)o.x | ((unsigned long long)o.y << 32), __ATOMIC_RELAXED, __HIP_MEMORY_SCOPE_AGENT); } } while (0)
    for (int pass = ((PROBE_DUP & 1024) ? 0 : 1); pass < 2; ++pass) {
    const bool dry = (pass == 0);
#pragma unroll
    for (int m = 0; m < 4; ++m) st[m] = (f32x4){0.f, 0.f, 0.f, 0.f};
    CKB_LOAD(0, 0); CKB_LOAD(1, 1); CKB_LOAD(2, 2); asm volatile("" ::: "memory"); __builtin_amdgcn_sched_barrier(0);
#pragma unroll 1
    for (int n = 0; n < 126; n += 3) { CKB_STEP(0, n); CKB_STEP(1, n + 1); CKB_STEP(2, n + 2); }
    CKB_STEP(0, 126); CKB_STEP(1, 127);
    if (dry) { float s = 0.f; _Pragma("unroll") for (int m = 0; m < 4; ++m) s += st[m][0] + st[m][1] + st[m][2] + st[m][3]; if (s == 123.456f) *(float*)(DSg) = s; }
    }
#undef CKB_STEP
#undef CKB_LOAD
    asm volatile("s_waitcnt vmcnt(0)" ::: "memory");
    if (lane == 0) __hip_atomic_fetch_add(ctl + CW_FLAGB + 64 * (16 * l + combo), 1u, __ATOMIC_RELAXED, __HIP_MEMORY_SCOPE_AGENT);
}

constexpr int DS_CAP = 1024;
constexpr int DS_KI = 128 * 1024, DS_KIROW = 144, DS_KIBUF = 64 * DS_KIROW, DS_HIST = DS_KI + 2 * DS_KIBUF;
static_assert(DS_HIST + 8 * 1024 <= LDS_MISC, "dsa lds");

__device__ __forceinline__ unsigned wave_select256(LAS unsigned* list, int n, LAS unsigned* hist, int lane, unsigned* bad = nullptr) {
    unsigned k[16];
#pragma unroll
    for (int j = 0; j < 16; ++j) { const int i = j * 64 + lane; k[j] = (i < n) ? list[i] : 0u; }
    unsigned prefix = 0u, mask = 0u; int rem = 256;
#pragma unroll 1
    for (int pass = 0; pass < 4; ++pass) {
        const int sh = 24 - 8 * pass;
        *(LAS u32x4*)(hist + 4 * lane) = (u32x4){0u, 0u, 0u, 0u};
        asm volatile("s_waitcnt lgkmcnt(0)" ::: "memory");
#pragma unroll
        for (int j = 0; j < 16; ++j) { const int i = j * 64 + lane; if (i < n && ((k[j] ^ prefix) & mask) == 0u) __hip_atomic_fetch_add((LAS unsigned*)&hist[(k[j] >> sh) & 255u], 1u, __ATOMIC_RELAXED, __HIP_MEMORY_SCOPE_WORKGROUP); }
        asm volatile("s_waitcnt lgkmcnt(0)" ::: "memory");
        const u32x4 hv = *(const LAS u32x4*)(hist + 4 * lane);
        const int tl = (int)(hv[0] + hv[1] + hv[2] + hv[3]);
        int inc = tl;
        inc += __builtin_amdgcn_update_dpp(0, inc, 0x101, 0xf, 0xf, true); inc += __builtin_amdgcn_update_dpp(0, inc, 0x102, 0xf, 0xf, true);
        inc += __builtin_amdgcn_update_dpp(0, inc, 0x104, 0xf, 0xf, true); inc += __builtin_amdgcn_update_dpp(0, inc, 0x108, 0xf, 0xf, true);
        { const int t1 = __builtin_amdgcn_readlane(inc, 16), t2 = __builtin_amdgcn_readlane(inc, 32), t3 = __builtin_amdgcn_readlane(inc, 48); const int rw = lane >> 4;
          inc += (rw == 0) ? (t1 + t2 + t3) : (rw == 1) ? (t2 + t3) : (rw == 2) ? t3 : 0; }
#if defined(SELFCHECK)
        { int chk = tl;
#pragma unroll
          for (int o = 1; o < 64; o <<= 1) { const int v = __shfl_down(chk, o); if (lane + o < 64) chk += v; }
          if (__any(chk != inc)) *bad = 1u; }
#endif
        const int suf = inc - tl;
        const int s3 = suf + (int)hv[3], s2 = s3 + (int)hv[2], s1 = s2 + (int)hv[1], s0 = s1 + (int)hv[0];
        int digit = -1, above = 0;
        if (s3 >= rem && suf < rem) { digit = 4 * lane + 3; above = suf; }
        else if (s2 >= rem && s3 < rem) { digit = 4 * lane + 2; above = s3; }
        else if (s1 >= rem && s2 < rem) { digit = 4 * lane + 1; above = s2; }
        else if (s0 >= rem && s1 < rem) { digit = 4 * lane + 0; above = s1; }
        const unsigned long long bal = __ballot(digit >= 0);
        const int src = (int)__builtin_ctzll(bal | (1ull << 63));
        digit = __shfl(digit, src); above = __shfl(above, src);
        prefix |= (unsigned)digit << sh; mask |= 0xffu << sh; rem -= above;
    }
    int run = 0;
#pragma unroll
    for (int j = 0; j < 16; ++j) { const int i = j * 64 + lane; const bool keep = (i < n) && (k[j] >= prefix);
        const unsigned long long bal = __ballot(keep);
        const int pos = run + (int)__builtin_amdgcn_mbcnt_hi((unsigned)(bal >> 32), __builtin_amdgcn_mbcnt_lo((unsigned)bal, 0u));
        if (keep) list[pos] = k[j];
        run += (int)__builtin_popcountll(bal); }
    asm volatile("s_waitcnt lgkmcnt(0)" ::: "memory");
    return prefix;
}

typedef short v4i16_t __attribute__((ext_vector_type(4)));
__device__ __forceinline__ u32x2 lds_tr16(const LAS unsigned char* p) { return __builtin_bit_cast(u32x2, __builtin_amdgcn_ds_read_tr16_b64_v4i16((LAS v4i16_t*)p)); }
__device__ __forceinline__ float key_floor(unsigned th) {
    if (th == 0u) return -INFINITY;
    const unsigned u = th & 0xffffe000u; return __builtin_bit_cast(float, (u & 0x80000000u) ? (u & 0x7fffffffu) : ~u);
}
constexpr int DS_VROW = 288;

__device__ __forceinline__ void dsa_item(const Ctx& C, int b, int qt) {
    const ArgsP Ap = C.a;
    const bf16_t* P = (const bf16_t*)(Ap->ws + WS_P); bf16_t* Y = (bf16_t*)(Ap->ws + WS_Y);
    int lane_o = C.lane; asm volatile("" : "+v"(lane_o));
    const int lane = lane_o, w = C.wave, tid = w * 64 + lane, hl = lane >> 5, l32 = lane & 31, r16 = lane & 15, g4 = lane >> 4;
    const int t0 = qt * 32;
    const size_t mb = (size_t)b * SEQ;
    LAS unsigned* cand = (LAS unsigned*)(C.lds) + w * 4 * DS_CAP;
    LAS unsigned* hist = (LAS unsigned*)(C.lds + DS_HIST) + w * 256;
#if defined(SELFCHECK)
    unsigned* bad = (unsigned*)(Ap->ws + WS_CTL) + 16;
#else
    unsigned* bad = nullptr;
#endif
    bf16x8 af[4];
    { const int rho = l32; const int qq = 2 * ((rho >> 2) & 1) + (rho >> 4), hd = (rho & 3) + 4 * ((rho >> 3) & 1);
      const bf16_t* src = P + (mb + t0 + 4 * w + qq) * NIN + PQI + hd * 64 + 8 * hl;
#pragma unroll
      for (int s = 0; s < 4; ++s) af[s] = *(const bf16x8*)(src + 16 * s); }
    float wA[8], wB[8];
    { const bf16_t* ra = P + (mb + t0 + 4 * w + 2 * hl) * NIN + PWI; const u32x4 va = *(const u32x4*)ra, vb = *(const u32x4*)(ra + NIN);
#pragma unroll
      for (int i = 0; i < 4; ++i) { wA[2 * i] = bflo(va[i]); wA[2 * i + 1] = bfhi(va[i]); wB[2 * i] = bflo(vb[i]); wB[2 * i + 1] = bfhi(vb[i]); } }
    const int tA = t0 + 4 * w + 2 * hl, tB = tA + 1;
    int cnt0 = 0, cnt1 = 0, cnt2 = 0, cnt3 = 0; unsigned th0 = 0u, th1 = 0u, th2 = 0u, th3 = 0u;
    const int NT = (t0 + 32 + 63) >> 6;
    for (int rep_i = 0; rep_i < ((PROBE_DUP & 256) ? 2 : 1); ++rep_i) {
    cnt0 = cnt1 = cnt2 = cnt3 = 0; th0 = th1 = th2 = th3 = 0u;
    const bf16_t* kisrc = P + (mb + (tid >> 3)) * NIN + PKI + 8 * (tid & 7);
    LAS unsigned char* kib = C.lds + DS_KI; const int kiw = (tid >> 3) * DS_KIROW + (tid & 7) * 16;
    __syncthreads();
    { const u32x4 v = *(const u32x4*)kisrc; *(LAS u32x4*)(kib + kiw) = v; }
    __syncthreads();
#pragma unroll 1
    for (int kt = 0; kt < NT; ++kt) {
        u32x4 nxt = (u32x4){0u, 0u, 0u, 0u};
        if (kt + 1 < NT) nxt = *(const u32x4*)(kisrc + (size_t)(kt + 1) * 64 * NIN);
        if (cnt0 > DS_CAP - 64) { th0 = wave_select256(cand + 0 * DS_CAP, cnt0, hist, lane, bad); cnt0 = 256; }
        if (cnt1 > DS_CAP - 64) { th1 = wave_select256(cand + 1 * DS_CAP, cnt1, hist, lane, bad); cnt1 = 256; }
        if (cnt2 > DS_CAP - 64) { th2 = wave_select256(cand + 2 * DS_CAP, cnt2, hist, lane, bad); cnt2 = 256; }
        if (cnt3 > DS_CAP - 64) { th3 = wave_select256(cand + 3 * DS_CAP, cnt3, hist, lane, bad); cnt3 = 256; }
        const unsigned thA = hl ? th2 : th0, thB = hl ? th3 : th1;
        const float fA = key_floor(thA), fB = key_floor(thB);
        const LAS unsigned char* kb = kib + (kt & 1) * DS_KIBUF;
#pragma unroll
        for (int nt = 0; nt < 2; ++nt) {
            f32x16 c = {};
#pragma unroll
            for (int s = 0; s < 4; ++s) { const bf16x8 bfr = *(const LAS bf16x8*)(kb + (nt * 32 + l32) * DS_KIROW + (16 * s + 8 * hl) * 2);
                c = __builtin_amdgcn_mfma_f32_32x32x16_bf16(af[s], bfr, c, 0, 0, 0); }
            float sA = 0.f, sB = 0.f;
#pragma unroll
            for (int i = 0; i < 8; ++i) { sA = fmaf(fmaxf(c[i], 0.f), wA[i], sA); sB = fmaf(fmaxf(c[8 + i], 0.f), wB[i], sB); }
            const int sidx = kt * 64 + nt * 32 + l32;
            const bool cA = (sidx <= tA) && (sA >= fA), cB = (sidx <= tB) && (sB >= fB);
            if (__any(cA || cB)) {
                unsigned uA = __builtin_bit_cast(unsigned, sA), uB = __builtin_bit_cast(unsigned, sB);
                uA = (uA & 0x80000000u) ? ~uA : (uA | 0x80000000u); uB = (uB & 0x80000000u) ? ~uB : (uB | 0x80000000u);
                const unsigned keyA = (uA & 0xffffe000u) | (unsigned)(8191 - sidx), keyB = (uB & 0xffffe000u) | (unsigned)(8191 - sidx);
                const bool pA = cA && (keyA > thA), pB = cB && (keyB > thB);
                { const unsigned long long bal = __ballot(pA); const unsigned lo = (unsigned)bal, hi = (unsigned)(bal >> 32);
                  const int pos = hl ? (cnt2 + (int)__builtin_amdgcn_mbcnt_hi(hi, 0u)) : (cnt0 + (int)__builtin_amdgcn_mbcnt_lo(lo, 0u));
                  if (pA) cand[(hl ? 2 : 0) * DS_CAP + pos] = keyA;
                  cnt0 += __builtin_popcount(lo); cnt2 += __builtin_popcount(hi); }
                { const unsigned long long bal = __ballot(pB); const unsigned lo = (unsigned)bal, hi = (unsigned)(bal >> 32);
                  const int pos = hl ? (cnt3 + (int)__builtin_amdgcn_mbcnt_hi(hi, 0u)) : (cnt1 + (int)__builtin_amdgcn_mbcnt_lo(lo, 0u));
                  if (pB) cand[(hl ? 3 : 1) * DS_CAP + pos] = keyB;
                  cnt1 += __builtin_popcount(lo); cnt3 += __builtin_popcount(hi); }
            }
        }
        if (kt + 1 < NT) *(LAS u32x4*)(kib + ((kt + 1) & 1) * DS_KIBUF + kiw) = nxt;
        __syncthreads();
    }
    if (cnt0 > 256) { wave_select256(cand + 0 * DS_CAP, cnt0, hist, lane, bad); cnt0 = 256; }
    if (cnt1 > 256) { wave_select256(cand + 1 * DS_CAP, cnt1, hist, lane, bad); cnt1 = 256; }
    if (cnt2 > 256) { wave_select256(cand + 2 * DS_CAP, cnt2, hist, lane, bad); cnt2 = 256; }
    if (cnt3 > 256) { wave_select256(cand + 3 * DS_CAP, cnt3, hist, lane, bad); cnt3 = 256; }
    }
    { u32x4 t1 = *(const LAS u32x4*)(cand + 1 * DS_CAP + 4 * lane), t2 = *(const LAS u32x4*)(cand + 2 * DS_CAP + 4 * lane), t3 = *(const LAS u32x4*)(cand + 3 * DS_CAP + 4 * lane);
      *(LAS u32x4*)(cand + 256 + 4 * lane) = t1; *(LAS u32x4*)(cand + 512 + 4 * lane) = t2; *(LAS u32x4*)(cand + 768 + 4 * lane) = t3; }
    LAS unsigned char* vt = (LAS unsigned char*)(cand + 1024);
#pragma unroll 1
    for (int qq_i = 0; qq_i < ((PROBE_DUP & 512) ? 8 : 4); ++qq_i) {
        const int qq = qq_i & 3;
        const int nsel = qq == 0 ? cnt0 : qq == 1 ? cnt1 : qq == 2 ? cnt2 : cnt3;
        const LAS unsigned* lst = cand + qq * 256;
        const size_t mq = mb + t0 + 4 * w + qq;
        const bf16_t* qrow = P + mq * NIN + PQ;
        bf16x8 bq0[2], bq1[2];
#pragma unroll
        for (int s = 0; s < 2; ++s) { bq0[s] = (bf16x8){0, 0, 0, 0, 0, 0, 0, 0}; bq1[s] = bq0[s];
            if (r16 < 8) { const bf16x8 v = *(const bf16x8*)(qrow + r16 * 64 + 32 * s + 8 * g4); if (r16 < 4) bq0[s] = v; else bq1[s] = v; } }
        u32x4 vg[8];
        const bf16_t* vsrc = P + mb * NIN + PV + 8 * r16;
#pragma unroll
        for (int j = 0; j < 8; ++j) { const int idx = 8191 - (int)(lst[g4 + 4 * j] & 8191u); vg[j] = *(const u32x4*)(vsrc + (size_t)idx * NIN); }
        f32x4 sc[16];
#pragma unroll
        for (int kt = 0; kt < 16; ++kt) {
            const int idx = 8191 - (int)(lst[16 * kt + r16] & 8191u);
            const bf16_t* krow = P + (mb + idx) * NIN + PK + 8 * g4;
            const bf16x8 k00 = *(const bf16x8*)krow, k01 = *(const bf16x8*)(krow + 32), k10 = *(const bf16x8*)(krow + 64), k11 = *(const bf16x8*)(krow + 96);
            f32x4 c = {0.f, 0.f, 0.f, 0.f};
            c = __builtin_amdgcn_mfma_f32_16x16x32_bf16(k00, bq0[0], c, 0, 0, 0); c = __builtin_amdgcn_mfma_f32_16x16x32_bf16(k01, bq0[1], c, 0, 0, 0);
            c = __builtin_amdgcn_mfma_f32_16x16x32_bf16(k10, bq1[0], c, 0, 0, 0); c = __builtin_amdgcn_mfma_f32_16x16x32_bf16(k11, bq1[1], c, 0, 0, 0);
            sc[kt] = c;
        }
        if (nsel < 256) {
#pragma unroll
            for (int kt = 0; kt < 16; ++kt)
#pragma unroll
                for (int rg = 0; rg < 4; ++rg) if (16 * kt + 4 * g4 + rg >= nsel) sc[kt][rg] = -INFINITY;
        }
        float mx = -INFINITY;
#pragma unroll
        for (int kt = 0; kt < 16; ++kt) mx = fmaxf(fmaxf(mx, fmaxf(sc[kt][0], sc[kt][1])), fmaxf(sc[kt][2], sc[kt][3]));
        mx = fmaxf(mx, __shfl_xor(mx, 16)); mx = fmaxf(mx, __shfl_xor(mx, 32));
        float sm = 0.f;
#pragma unroll
        for (int kt = 0; kt < 16; ++kt)
#pragma unroll
            for (int rg = 0; rg < 4; ++rg) { const float p = __expf(sc[kt][rg] - mx); sc[kt][rg] = p; sm += p; }
        sm += __shfl_xor(sm, 16); sm += __shfl_xor(sm, 32);
        const float inv = 1.f / sm;
        u32x4 pb[8];
#pragma unroll
        for (int s = 0; s < 8; ++s) { pb[s].x = pk2(sc[2 * s][0], sc[2 * s][1]); pb[s].y = pk2(sc[2 * s][2], sc[2 * s][3]); pb[s].z = pk2(sc[2 * s + 1][0], sc[2 * s + 1][1]); pb[s].w = pk2(sc[2 * s + 1][2], sc[2 * s + 1][3]); }
        const bool isg0 = r16 < 4, isg1 = (r16 >= 4) && (r16 < 8);
        f32x4 o[4];
#pragma unroll
        for (int mt = 0; mt < 4; ++mt) o[mt] = (f32x4){0.f, 0.f, 0.f, 0.f};
        const int trb = (4 * g4 + (r16 >> 2)) * DS_VROW + 8 * (r16 & 3);
#pragma unroll 1
        for (int s = 0; s < 8; ++s) {
#pragma unroll
            for (int j = 0; j < 8; ++j) *(LAS u32x4*)(vt + (g4 + 4 * j) * DS_VROW + r16 * 16) = vg[j];
            if (s + 1 < 8) {
#pragma unroll
                for (int j = 0; j < 8; ++j) { const int idx = 8191 - (int)(lst[32 * (s + 1) + g4 + 4 * j] & 8191u); vg[j] = *(const u32x4*)(vsrc + (size_t)idx * NIN); } }
            const u32x4 z4 = {0u, 0u, 0u, 0u};
            const u32x4 ps = pb[s];
            const bf16x8 p0 = __builtin_bit_cast(bf16x8, isg0 ? ps : z4), p1 = __builtin_bit_cast(bf16x8, isg1 ? ps : z4);
#pragma unroll
            for (int mt = 0; mt < 4; ++mt) {
                const u32x2 a00 = lds_tr16(vt + trb + mt * 32), a01 = lds_tr16(vt + trb + 16 * DS_VROW + mt * 32);
                const u32x2 a10 = lds_tr16(vt + trb + 128 + mt * 32), a11 = lds_tr16(vt + trb + 16 * DS_VROW + 128 + mt * 32);
                const u32x4 A0 = {a00.x, a00.y, a01.x, a01.y}, A1 = {a10.x, a10.y, a11.x, a11.y};
                o[mt] = __builtin_amdgcn_mfma_f32_16x16x32_bf16(__builtin_bit_cast(bf16x8, A0), p0, o[mt], 0, 0, 0);
                o[mt] = __builtin_amdgcn_mfma_f32_16x16x32_bf16(__builtin_bit_cast(bf16x8, A1), p1, o[mt], 0, 0, 0);
            }
        }
        if (r16 < 8) {
#pragma unroll
            for (int mt = 0; mt < 4; ++mt) { u32x2 ov; ov.x = pk2(o[mt][0] * inv, o[mt][1] * inv); ov.y = pk2(o[mt][2] * inv, o[mt][3] * inv);
                *(u32x2*)(Y + mq * DM + r16 * 64 + 16 * mt + 4 * g4) = ov; }
        }
    }
}

__device__ __forceinline__ void mixers_phase(const Ctx& C, int l) {
    const ArgsP Ap = C.a;
    unsigned* ctl = (unsigned*)(Ap->ws + WS_CTL);
    const int sub = Ap->sub;
    if (sub < 0 || sub == 0)
    for (int it = C.bid; it < 2048; it += C.G) { if (PROBE_DUP & 2) chunk_item<0, false>(C, l, it & 15, it >> 4); chunk_item<0>(C, l, it & 15, it >> 4); }
    if ((sub < 0 || sub == 1) && C.bid < 64) chunk_phaseB(C, l, C.bid >> 2, C.bid & 3);
    if (!(sub < 0 || sub == 2)) return;
    unsigned* work = ctl + CW_WORK + 64 * l;
    volatile LAS unsigned* misc = (volatile LAS unsigned*)(C.lds + LDS_MISC);
    bool bready = false;
    for (;;) {
        __syncthreads();
        if (C.tid == 0) misc[0] = __hip_atomic_fetch_add(work, 1u, __ATOMIC_RELAXED, __HIP_MEMORY_SCOPE_AGENT);
        __syncthreads();
        const int it = (int)misc[0];
        if (it >= 512 + 2048) break;
        if (it < 512) { dsa_item(C, it & 1, 255 - (it >> 1)); if (PROBE_DUP & 1) dsa_item(C, it & 1, 255 - (it >> 1)); continue; }
        if (!bready) {
            if (C.tid == 0) { unsigned sp = 0; for (;;) { unsigned ok = 1u;
                    for (int c = 0; c < 16; ++c) ok &= (__hip_atomic_load(ctl + CW_FLAGB + 64 * (16 * l + c), __ATOMIC_RELAXED, __HIP_MEMORY_SCOPE_AGENT) >= 4u) ? 1u : 0u;
                    if (ok || ++sp > (1u << 24)) break; __builtin_amdgcn_s_sleep(2); }
                __builtin_amdgcn_fence(__ATOMIC_ACQUIRE, "agent"); asm volatile("s_waitcnt vmcnt(0)" ::: "memory"); }
            __syncthreads(); bready = true; }
        const int ci = it - 512;
        chunk_item<1>(C, l, ci & 15, ci >> 4);
        if (PROBE_DUP & 4) chunk_item<1>(C, l, ci & 15, ci >> 4);
    }
    __syncthreads();
}

constexpr int NPHASE = 18;
__global__ void __launch_bounds__(512, 2) fwd_kernel(Args args_unused) {
    extern __shared__ __attribute__((aligned(16))) unsigned char lds_raw[];
    ArgsP ap0 = (ArgsP)__builtin_amdgcn_kernarg_segment_ptr();
    Ctx C; C.lds = (LAS unsigned char*)lds_raw; C.tid = threadIdx.x; C.lane = C.tid & 63; C.wave = __builtin_amdgcn_readfirstlane(C.tid >> 6); C.G = gridDim.x; C.bid = blockIdx.x; C.a = ap0;
    volatile LAS unsigned* misc = (volatile LAS unsigned*)(C.lds + LDS_MISC);
    if (C.tid < 64) misc[C.tid] = 0u;
    __syncthreads();
    const int ph_lo = ap0->ph_lo, ph_hi = ap0->ph_hi;
    XcdBarrier bar; bar.bar = (unsigned*)(ap0->ws + WS_CTL) + CW_BAR; bar.x = 0; bar.st = nullptr;
    const bool fused = (ph_hi - ph_lo) > 1;
    if (fused) bar = xcd_barrier_post((unsigned*)(ap0->ws + WS_CTL) + CW_BAR, misc + 8);
#ifndef PHASE_MASK
#define PHASE_MASK 0x3ff
#endif
#define PM(k) ((PHASE_MASK >> (k)) & 1)
    for (int ph = ph_lo; ph < ph_hi; ++ph) {
        { int t_ = threadIdx.x; asm volatile("" : "+v"(t_)); C.tid = t_; C.lane = t_ & 63; C.wave = __builtin_amdgcn_readfirstlane(t_ >> 6); }
        ArgsP ap = (ArgsP)__builtin_amdgcn_kernarg_segment_ptr(); asm volatile("" : "+s"(ap)); C.a = ap;
        unsigned char* ws = ap->ws; unsigned char* wb = ws + WS_W;
        bf16_t* XBF = (bf16_t*)(ws + WS_XBF); bf16_t* ACT = (bf16_t*)(ws + WS_ACT); bf16_t* PB = (bf16_t*)(ws + WS_P); bf16_t* YB = (bf16_t*)(ws + WS_Y);
        float* SSQA = (float*)(ws + WS_SSQ); float* SSQB = SSQA + (size_t)MTOK * 16; float* SSQC = SSQB + (size_t)MTOK * 16;
        if (ph == 0) { if (PM(9)) { convert_layer_weights(C, 0); prologue_x(C); if (PROBE_DUP & 32) { __syncthreads(); convert_layer_weights(C, 0); prologue_x(C); } } }
        else {
            const int l = (ph - 1) / 9, sp = (ph - 1) % 9;
            pg8::StaticOrder S;
            switch (sp) {
            case 0: if (PM(0)) { pg8::Gemm g{XBF, (const bf16_t*)(wb + W_GU1), MTOK, NGU, DM}; S.init(MTOK, NGU, C.G, C.bid); pg8::EpiFfnUp E{ACT, SSQA};
                      pg8::gemm_phase<pg8::EpiFfnUp, pg8::StaticOrder, true, true>(C.lds, g, S, E, C.tid); } break;
            case 1: if (PM(1)) { pg8::Gemm g{ACT, (const bf16_t*)(wb + W_D1), MTOK, DM, FF}; S.init(MTOK, DM, C.G, C.bid); pg8::EpiResid E{l == 0 ? ap->in[I_X] : ap->out, ap->out, XBF, SSQB, 0.5f};
                      pg8::gemm_phase<pg8::EpiResid, pg8::StaticOrder, true, true>(C.lds, g, S, E, C.tid); } break;
            case 2: if (PM(2)) { pg8::Gemm g{XBF, (const bf16_t*)(wb + W_IN), MTOK, NIN, DM}; S.init(MTOK, NIN, C.G, C.bid); pg8::EpiRowScaleBf16 E{PB, NIN, SSQB};
                      pg8::gemm_phase<pg8::EpiRowScaleBf16, pg8::StaticOrder, true, true>(C.lds, g, S, E, C.tid); } break;
            case 3: if (PM(3)) prep_phase(C, l); break;
            case 4: if (PM(4)) mixers_phase(C, l); break;
            case 5: if (PM(5)) { pg8::Gemm g{YB, (const bf16_t*)(wb + W_OUT), MTOK, DM, DM}; S.init(MTOK, DM, C.G, C.bid); pg8::EpiResid E{ap->out, ap->out, XBF, SSQC, 1.0f};
                      pg8::gemm_phase<pg8::EpiResid, pg8::StaticOrder, true, true>(C.lds, g, S, E, C.tid); } break;
            case 6: if (PM(6)) { pg8::Gemm g{XBF, (const bf16_t*)(wb + W_GU2), MTOK, NGU, DM}; S.init(MTOK, NGU, C.G, C.bid); pg8::EpiFfnUp E{ACT, SSQC};
                      pg8::gemm_phase<pg8::EpiFfnUp, pg8::StaticOrder, true, true>(C.lds, g, S, E, C.tid); } break;
            case 7: if (PM(7)) { pg8::Gemm g{ACT, (const bf16_t*)(wb + W_D2), MTOK, DM, FF}; S.init(MTOK, DM, C.G, C.bid); pg8::EpiResid E{ap->out, ap->out, XBF, SSQA, 0.5f};
                      pg8::gemm_phase<pg8::EpiResid, pg8::StaticOrder, true, true>(C.lds, g, S, E, C.tid); } break;
            case 8: if (PM(8)) convert_layer_weights(C, l + 1); break;
            }
        }
        if (ph + 1 < ph_hi) xcd_barrier(bar);
    }
#if defined(SELFCHECK)
    if (C.bid == 0 && threadIdx.x == 0 && ph_hi == NPHASE) { if (__hip_atomic_load((unsigned*)(ap0->ws + WS_CTL) + 16, __ATOMIC_RELAXED, __HIP_MEMORY_SCOPE_AGENT) != 0u) ap0->out[0] = __builtin_nanf(""); }
#endif
}

extern "C" void kernel_launch(void* const* d_in, const int* in_sizes, int n_in, void* d_out, int out_size, void* d_ws, size_t ws_size, hipStream_t stream) {
    static int grid = 0;
    if (grid == 0) {
        if (n_in != 28 || out_size != MTOK * DM || ws_size < WS_END) { fprintf(stderr, "kernel_launch: unexpected shapes (n_in %d out %d ws %zu)\n", n_in, out_size, ws_size); grid = -1; return; }
        int dev = 0, cus = 0, per_cu = 0;
        if (hipGetDevice(&dev) != hipSuccess || hipDeviceGetAttribute(&cus, hipDeviceAttributeMultiprocessorCount, dev) != hipSuccess) { grid = -1; return; }
        if (hipFuncSetAttribute((const void*)fwd_kernel, hipFuncAttributeMaxDynamicSharedMemorySize, LDS_BYTES) != hipSuccess) { fprintf(stderr, "kernel_launch: hipFuncSetAttribute failed\n"); grid = -1; return; }
        if (hipOccupancyMaxActiveBlocksPerMultiprocessor(&per_cu, (const void*)fwd_kernel, 512, LDS_BYTES) != hipSuccess || per_cu < 1) { fprintf(stderr, "kernel_launch: occupancy query says %d\n", per_cu); per_cu = 1; }
        (void)hipGetLastError();
        grid = cus;
    }
    if (grid < 0) return;
    (void)hipMemsetAsync((char*)d_ws + WS_CTL, 0, CTL_ZERO_BYTES, stream);
    Args a{};
    for (int i = 0; i < 28; ++i) a.in[i] = (const float*)d_in[i];
    a.out = (float*)d_out; a.ws = (unsigned char*)d_ws; a.sub = -1;
#if MK_N_LAUNCHES == 1
    a.ph_lo = 0; a.ph_hi = NPHASE;
    void* kargs[] = {&a};
    hipError_t e = hipLaunchCooperativeKernel((const void*)fwd_kernel, dim3(grid), dim3(512), kargs, LDS_BYTES, stream);
    if (e != hipSuccess) fprintf(stderr, "kernel_launch: cooperative launch failed: %s\n", hipGetErrorString(e));
#else
#ifndef PROBE_PH_DUP
#define PROBE_PH_DUP 0
#endif
#ifndef PROBE_SUB_DUP
#define PROBE_SUB_DUP 0
#endif
    for (int ph = 0; ph < NPHASE; ++ph) { a.ph_lo = ph; a.ph_hi = ph + 1;
        if (ph > 0 && (ph - 1) % 9 == 4) {
            if (PROBE_SUB_DUP & 8) { a.sub = 0; hipLaunchKernelGGL(fwd_kernel, dim3(grid), dim3(512), LDS_BYTES, stream, a); a.sub = 1; hipLaunchKernelGGL(fwd_kernel, dim3(grid), dim3(512), LDS_BYTES, stream, a); }
            for (int sb = 0; sb < 3; ++sb) { a.sub = sb; hipLaunchKernelGGL(fwd_kernel, dim3(grid), dim3(512), LDS_BYTES, stream, a);
                if ((PROBE_SUB_DUP >> sb) & 1) { if (sb == 2) (void)hipMemsetAsync((char*)d_ws + WS_CTL + CW_WORK * 4, 0, 1024, stream); hipLaunchKernelGGL(fwd_kernel, dim3(grid), dim3(512), LDS_BYTES, stream, a); } }
            a.sub = -1; continue; }
        hipLaunchKernelGGL(fwd_kernel, dim3(grid), dim3(512), LDS_BYTES, stream, a);
        if ((PROBE_PH_DUP >> ph) & 1) { (void)hipMemsetAsync((char*)d_ws + WS_CTL, 0, CTL_ZERO_BYTES, stream); hipLaunchKernelGGL(fwd_kernel, dim3(grid), dim3(512), LDS_BYTES, stream, a); } }
#endif
}
```

```cpp
#include <hip/hip_runtime.h>
#include <cstdio>
#include <cstdint>


#ifndef PROBE_CK
#define PROBE_CK 0
#endif
#ifndef PROBE_DUP
#define PROBE_DUP 0
#endif
#ifndef MK_N_LAUNCHES
#define MK_N_LAUNCHES 1
#endif

#define LAS __attribute__((address_space(3)))
#define GAS __attribute__((address_space(1)))
typedef unsigned short bf16_t;
typedef short bf16x8 __attribute__((ext_vector_type(8)));
typedef float f32x4 __attribute__((ext_vector_type(4)));
typedef float f32x16 __attribute__((ext_vector_type(16)));
typedef float f32x2 __attribute__((ext_vector_type(2)));
typedef unsigned u32x4 __attribute__((ext_vector_type(4)));
typedef unsigned u32x2 __attribute__((ext_vector_type(2)));

constexpr int BATCH = 2, SEQ = 8192, DM = 1024, FF = 2816, MTOK = BATCH * SEQ;
constexpr int NGU = 2 * FF;
constexpr int NIN = 3328;
constexpr int PQ = 0, PK = 512, PV = 640, PQI = 768, PKI = 1280, PWI = 1344, PGB = 1352, PGA = 1356;
constexpr int PRW = 1408;
constexpr int PGD = 2304;
constexpr float NORM_EPS = 1e-6f;

constexpr size_t MiB = 1u << 20;
constexpr size_t WS_CTL = 0, CTL_ZERO_BYTES = 64 * 1024;
constexpr size_t WS_ROPE = 64 * 1024;
constexpr size_t WS_W = 3 * MiB;
constexpr size_t W_GU1 = 0, W_D1 = 11 * MiB, W_IN = W_D1 + 5632 * 1024, W_OUT = W_IN + (size_t)NIN * DM * 2, W_GU2 = W_OUT + 2 * MiB, W_D2 = W_GU2 + 11 * MiB, W_END = W_D2 + 5632 * 1024;
constexpr size_t WS_XBF = 45 * MiB;
constexpr size_t WS_BIG = 77 * MiB;
constexpr size_t WS_P = WS_BIG, WS_Y = WS_BIG + 104 * MiB, WS_ACT = WS_BIG;
constexpr size_t WS_SSQ = 213 * MiB;
constexpr size_t WS_VF = 216 * MiB;
constexpr size_t WS_END = 224 * MiB;
static_assert(W_END <= 42 * MiB && WS_W + W_END <= WS_XBF && WS_Y + 32 * MiB <= WS_SSQ, "ws map");

constexpr int CW_BAR = 1024;
constexpr int CW_WORK = 8192;

constexpr int LDS_MISC = 154 * 1024;
constexpr int LDS_BYTES = 155 * 1024;

typedef __bf16 hwbf16x2 __attribute__((ext_vector_type(2)));
__device__ __forceinline__ unsigned pk2(float lo, float hi) { const f32x2 v = {lo, hi}; return __builtin_bit_cast(unsigned, __builtin_convertvector(v, hwbf16x2)); }
__device__ __forceinline__ unsigned f2bf(float f) { return pk2(f, 0.f) & 0xffffu; }
__device__ __forceinline__ float bf2f(unsigned short h) { return __builtin_bit_cast(float, (unsigned)h << 16); }
__device__ __forceinline__ float bflo(unsigned w) { return __builtin_bit_cast(float, w << 16); }
__device__ __forceinline__ float bfhi(unsigned w) { return __builtin_bit_cast(float, w & 0xffff0000u); }
__device__ __forceinline__ float wave_sum_shfl(float v) {
#pragma unroll
    for (int o = 1; o < 64; o <<= 1) v += __shfl_xor(v, o);
    return v;
}
__device__ __forceinline__ float dpp_f(float v, int ctrl_quad  ) { return v; }
#define DPP_ADD(v, ctrl) v += __builtin_bit_cast(float, __builtin_amdgcn_update_dpp(0, __builtin_bit_cast(int, v), ctrl, 0xf, 0xf, true))
__device__ __forceinline__ float wave_sum(float v) {
    DPP_ADD(v, 0xB1); DPP_ADD(v, 0x4E); DPP_ADD(v, 0x141); DPP_ADD(v, 0x140);
    const int vi = __builtin_bit_cast(int, v);
    return (__builtin_bit_cast(float, __builtin_amdgcn_readlane(vi, 0)) + __builtin_bit_cast(float, __builtin_amdgcn_readlane(vi, 16))) +
           (__builtin_bit_cast(float, __builtin_amdgcn_readlane(vi, 32)) + __builtin_bit_cast(float, __builtin_amdgcn_readlane(vi, 48)));
}
__device__ __forceinline__ float sigmoidf_(float x) { return __builtin_amdgcn_rcpf(1.f + __expf(-x)); }
__device__ __forceinline__ float siluf_(float x) { return x * __builtin_amdgcn_rcpf(1.f + __expf(-x)); }
__device__ __forceinline__ float softplusf_(float x) { return x > 20.f ? x : __logf(1.f + __expf(x)); }

namespace pg8 {
constexpr int BM = 256, BK = 64, HALF = 128, HTB = HALF * BK * 2, STAGE_BYTES = 8 * HTB, NXCD = 8, WGM = 8;
__host__ __device__ __forceinline__ int lds_byte(int r, int c) { const int st = (r >> 4) * 2 + (c >> 5), rr = r & 15, cc = c & 31, ob = rr * 64 + cc * 2; return st * 1024 + (ob ^ (((ob >> 9) & 1) << 5)); }
__host__ __device__ __forceinline__ void stage_rc(int b, int& R, int& C) { const int st = b / 1024, sb = b % 1024, swz = sb ^ (((sb >> 9) & 1) << 5); R = (st >> 1) * 16 + swz / 64; C = (st & 1) * 32 + (swz % 64) / 2; }
__host__ __device__ __forceinline__ int perm32(int rho) { const int n = rho >> 4, i = rho & 15; return 8 * (i >> 2) + 4 * n + (i & 3); }
struct Unit { int pm, pn; };
struct Gemm { const bf16_t* A; const bf16_t* Bt; int M, N, K; };
struct StaticOrder {
    int nM, nN, nwg, G, c;
    __host__ __device__ void init(int M, int N, int G_, int c_) { nM = M / BM; nN = N / BM; nwg = nM * nN; G = G_; c = c_; }
    __host__ __device__ bool next(int i, Unit& u) const {
        const long L = (long)i * G + c; if (L >= nwg) return false;
        int wgid = (int)L; { const int q = nwg / NXCD, r = nwg % NXCD, xcd = wgid % NXCD, off = wgid / NXCD; wgid = (xcd < r ? xcd * (q + 1) : r * (q + 1) + (xcd - r) * q) + off; }
        const int nig = WGM * nN, gid = wgid / nig, fm = gid * WGM, gsz = (nM - fm) < WGM ? (nM - fm) : WGM;
        u.pm = fm + ((wgid % nig) % gsz); u.pn = (wgid % nig) / gsz; return true;
    }
};
__device__ __forceinline__ unsigned cvt_pk_bf16(float lo, float hi) { unsigned r; asm volatile("v_cvt_pk_bf16_f32 %0, %1, %2" : "=v"(r) : "v"(lo), "v"(hi)); return r; }

__device__ __forceinline__ float row_rstd(const float* ssq, int row, int fq) {
    const f32x4 v = *(const f32x4*)(ssq + (size_t)row * 16 + 4 * fq);
    float s = (v[0] + v[1]) + (v[2] + v[3]);
    s += __shfl_xor(s, 16); s += __shfl_xor(s, 32);
    return rsqrtf(s * (1.0f / DM) + NORM_EPS);
}
struct EpiFfnUp {
    static constexpr bool PERM = true;
    bf16_t* O; const float* ssq;
    __device__ __forceinline__ void operator()(const f32x4 (&acc)[2][2][4][2], const Unit& u, int wr, int wc, int fr, int fq) const {
        const int row0 = u.pm * BM + wr * 64 + fr; const int col0 = u.pn * HALF + wc * 32 + 8 * fq;
#pragma unroll
        for (int ai = 0; ai < 2; ++ai)
#pragma unroll
            for (int m = 0; m < 4; ++m) { const int row = row0 + ai * HALF + m * 16; const float rs = row_rstd(ssq, row, fq);
                float o[8];
#pragma unroll
                for (int n = 0; n < 2; ++n)
#pragma unroll
                    for (int e = 0; e < 4; ++e) { const float g = acc[ai][0][m][n][e] * rs, up = acc[ai][1][m][n][e] * rs;
                        o[n * 4 + e] = g * __builtin_amdgcn_rcpf(1.f + __builtin_amdgcn_exp2f(-1.4426950408889634f * g)) * up; }
                u32x4 w; w.x = cvt_pk_bf16(o[0], o[1]); w.y = cvt_pk_bf16(o[2], o[3]); w.z = cvt_pk_bf16(o[4], o[5]); w.w = cvt_pk_bf16(o[6], o[7]);
                *(u32x4*)(O + (size_t)row * FF + col0) = w; asm volatile("" ::: "memory"); }
    }
};
struct EpiRowScaleBf16 {
    static constexpr bool PERM = true;
    bf16_t* O; int ldc; const float* ssq;
    __device__ __forceinline__ void operator()(const f32x4 (&acc)[2][2][4][2], const Unit& u, int wr, int wc, int fr, int fq) const {
        const int row0 = u.pm * BM + wr * 64 + fr; const int col0 = u.pn * BM + wc * 32 + 8 * fq;
#pragma unroll
        for (int ai = 0; ai < 2; ++ai)
#pragma unroll
            for (int m = 0; m < 4; ++m) { const int row = row0 + ai * HALF + m * 16; const float rs = row_rstd(ssq, row, fq);
#pragma unroll
                for (int bj = 0; bj < 2; ++bj) { const f32x4 v0 = acc[ai][bj][m][0] * rs, v1 = acc[ai][bj][m][1] * rs;
                    u32x4 w; w.x = cvt_pk_bf16(v0[0], v0[1]); w.y = cvt_pk_bf16(v0[2], v0[3]); w.z = cvt_pk_bf16(v1[0], v1[1]); w.w = cvt_pk_bf16(v1[2], v1[3]);
                    *(u32x4*)(O + (size_t)row * ldc + col0 + bj * HALF) = w; } asm volatile("" ::: "memory"); }
    }
};
struct EpiResid {
    static constexpr bool PERM = false;
    const float* xin; float* xout; bf16_t* xbf; float* ssq; float alpha;
    __device__ __forceinline__ void operator()(const f32x4 (&acc)[2][2][4][2], const Unit& u, int wr, int wc, int fr, int fq) const {
        const int row0 = u.pm * BM + wr * 64 + fr; const int col0 = u.pn * BM + wc * 32 + 4 * fq;
#pragma unroll
        for (int ai = 0; ai < 2; ++ai)
#pragma unroll
            for (int m = 0; m < 4; ++m) { const int row = row0 + ai * HALF + m * 16; const size_t off = (size_t)row * DM + col0; float s = 0.f;
#pragma unroll
                for (int bj = 0; bj < 2; ++bj)
#pragma unroll
                    for (int n = 0; n < 2; ++n) { const size_t o2 = off + bj * HALF + n * 16; const f32x4 xi = *(const f32x4*)(xin + o2); const f32x4 v = xi + acc[ai][bj][m][n] * alpha;
                        *(f32x4*)(xout + o2) = v; u32x2 w; w.x = cvt_pk_bf16(v[0], v[1]); w.y = cvt_pk_bf16(v[2], v[3]); *(u32x2*)(xbf + o2) = w;
                        s += (v[0] * v[0] + v[1] * v[1]) + (v[2] * v[2] + v[3] * v[3]); }
                s += __shfl_xor(s, 16); s += __shfl_xor(s, 32);
                if (fq == 0) ssq[(size_t)row * 16 + u.pn * 4 + wc] = s; }
    }
};

template <class Epi, class Sched, bool ALIGN_EPI = false, bool SP2 = false>
__device__ __forceinline__ void gemm_phase(LAS unsigned char* lds, const Gemm g, const Sched& S, const Epi& E, const int tid) {
    const int wid = __builtin_amdgcn_readfirstlane(tid >> 6), lane = tid & 63, wr = wid >> 2, wc = wid & 3, fr = lane & 15, fq = lane >> 4;
    const int K = g.K, nt = K / BK;
    unsigned voffA[2], voffB[2];
#pragma unroll
    for (int i = 0; i < 2; ++i) { int R, C; stage_rc(tid * 16 + i * 8192, R, C); const int Rb = Epi::PERM ? ((R & ~31) + perm32(R & 31)) : R;
        voffA[i] = (unsigned)(R * K + C) * 2u; voffB[i] = (unsigned)(Rb * K + C) * 2u; }
    const size_t kstep = (size_t)(BK * 2);
    const size_t hstep = (size_t)HALF * K * 2;
    const size_t tstep = 2 * hstep;
    const unsigned ldsw = (unsigned)wid * 1024u;
    const int aoff = lds_byte(wr * 64 + fr, fq * 8), boff = lds_byte(wc * 32 + fr, fq * 8);
#define PG8_SA(b, h) (((b) * 2 + (h)) * HTB)
#define PG8_SB(b, h) ((4 + (b) * 2 + (h)) * HTB)
#define PG8_STAGE(bufoff, gbase, voff) do { _Pragma("unroll") for (int _i = 0; _i < 2; ++_i) \
        __builtin_amdgcn_global_load_lds((const unsigned*)((const char*)(gbase) + (voff)[_i]), (LAS unsigned*)(lds + (bufoff) + ldsw + _i * 8192), 16, 0, 0); } while (0)
#define PG8_LDA(dst, b, h) do { _Pragma("unroll") for (int m = 0; m < 4; ++m) _Pragma("unroll") for (int k = 0; k < 2; ++k) dst[m][k] = *(const LAS bf16x8*)(lds + PG8_SA(b, h) + aoff + m * 2048 + k * 1024); } while (0)
#define PG8_LDB(dst, b, h) do { _Pragma("unroll") for (int n = 0; n < 2; ++n) _Pragma("unroll") for (int k = 0; k < 2; ++k) dst[n][k] = *(const LAS bf16x8*)(lds + PG8_SB(b, h) + boff + n * 2048 + k * 1024); } while (0)
#define PG8_MMA(ai, bj, At, Bt) do { __builtin_amdgcn_s_setprio(1); _Pragma("unroll") for (int m = 0; m < 4; ++m) _Pragma("unroll") for (int n = 0; n < 2; ++n) _Pragma("unroll") for (int k = 0; k < 2; ++k) \
        acc[ai][bj][m][n] = __builtin_amdgcn_mfma_f32_16x16x32_bf16(Bt[n][k], At[m][k], acc[ai][bj][m][n], 0, 0, 0); __builtin_amdgcn_s_setprio(0); } while (0)
#define PG8_WAIT_V(n) asm volatile("s_waitcnt vmcnt(" #n ")" ::: "memory")
#define PG8_WAIT_L(n) asm volatile("s_waitcnt lgkmcnt(" #n ")" ::: "memory")
#define PG8_BAR __builtin_amdgcn_s_barrier()
#define PG8_SCHED __builtin_amdgcn_sched_barrier(0)
    Unit cur, nxt; int ui = 0;
    if (!S.next(0, cur)) return;
    f32x4 acc[2][2][4][2];
#pragma unroll
    for (int a = 0; a < 2; ++a)
#pragma unroll
        for (int b = 0; b < 2; ++b)
#pragma unroll
            for (int m = 0; m < 4; ++m)
#pragma unroll
                for (int n = 0; n < 2; ++n) acc[a][b][m][n] = (f32x4){0.f, 0.f, 0.f, 0.f};
    bf16x8 At[4][2], B0[2][2], B1[2][2];
    const char* cA = (const char*)g.A + (size_t)cur.pm * tstep; const char* cB = (const char*)g.Bt + (size_t)cur.pn * tstep;
    if constexpr (SP2) {
        PG8_STAGE(PG8_SB(0, 0), cB, voffB); PG8_STAGE(PG8_SB(0, 1), cB + hstep, voffB); PG8_STAGE(PG8_SA(0, 0), cA, voffA); PG8_STAGE(PG8_SA(0, 1), cA + hstep, voffA);
        if (wr == 1) PG8_BAR;
        PG8_WAIT_V(2); PG8_BAR;
        PG8_STAGE(PG8_SB(1, 0), cB + kstep, voffB); PG8_STAGE(PG8_SA(1, 0), cA + kstep, voffA); PG8_STAGE(PG8_SB(1, 1), cB + hstep + kstep, voffB);
        PG8_WAIT_V(6); PG8_BAR;
    } else {
        PG8_STAGE(PG8_SB(0, 0), cB, voffB); PG8_STAGE(PG8_SA(0, 0), cA, voffA); PG8_STAGE(PG8_SB(0, 1), cB + hstep, voffB); PG8_STAGE(PG8_SA(0, 1), cA + hstep, voffA);
        if (wr == 1) PG8_BAR;
        PG8_WAIT_V(4); PG8_BAR;
        PG8_STAGE(PG8_SB(1, 0), cB + kstep, voffB); PG8_STAGE(PG8_SA(1, 0), cA + kstep, voffA); PG8_STAGE(PG8_SB(1, 1), cB + hstep + kstep, voffB);
        PG8_WAIT_V(6); PG8_BAR;
    }
    for (;;) {
        const bool has_next = S.next(ui + 1, nxt);
        const char* nA = has_next ? (const char*)g.A + (size_t)nxt.pm * tstep : cA; const char* nB = has_next ? (const char*)g.Bt + (size_t)nxt.pn * tstep : cB;
        for (int t = 0; t < nt; t += 2) {
            const bool last = (t == nt - 2);
            const char* a1 = cA + (size_t)(t + 1) * kstep;
            const char* a2 = last ? nA : cA + (size_t)(t + 2) * kstep; const char* b2 = last ? nB : cB + (size_t)(t + 2) * kstep;
            const char* a3 = a2 + kstep; const char* b3 = b2 + kstep;
            if constexpr (SP2) {
            PG8_LDB(B0, 0, 0); PG8_LDB(B1, 0, 1); PG8_SCHED; PG8_LDA(At, 0, 0); PG8_STAGE(PG8_SA(1, 1), a1 + hstep, voffA);
            PG8_WAIT_V(8); PG8_WAIT_L(0); PG8_BAR; PG8_MMA(0, 0, At, B0); PG8_MMA(0, 1, At, B1); PG8_BAR; PG8_SCHED;
            PG8_LDA(At, 0, 1); PG8_STAGE(PG8_SB(0, 0), b2, voffB); PG8_STAGE(PG8_SB(0, 1), b2 + hstep, voffB); PG8_STAGE(PG8_SA(0, 0), a2, voffA);
            PG8_WAIT_V(8); PG8_WAIT_L(0); PG8_BAR; PG8_MMA(1, 0, At, B0); PG8_MMA(1, 1, At, B1); PG8_BAR; PG8_SCHED;
            PG8_LDB(B0, 1, 0); PG8_LDB(B1, 1, 1); PG8_SCHED; PG8_LDA(At, 1, 0); PG8_STAGE(PG8_SA(0, 1), a2 + hstep, voffA);
            PG8_WAIT_V(8); PG8_WAIT_L(0); PG8_BAR; PG8_MMA(0, 0, At, B0); PG8_MMA(0, 1, At, B1); PG8_BAR; PG8_SCHED;
            PG8_LDA(At, 1, 1); PG8_STAGE(PG8_SB(1, 0), b3, voffB); PG8_STAGE(PG8_SB(1, 1), b3 + hstep, voffB); PG8_STAGE(PG8_SA(1, 0), a3, voffA);
            PG8_WAIT_V(8); PG8_WAIT_L(0); PG8_BAR; PG8_MMA(1, 0, At, B0); PG8_MMA(1, 1, At, B1); PG8_BAR; PG8_SCHED;
            } else {
            PG8_LDB(B0, 0, 0); PG8_SCHED; PG8_LDA(At, 0, 0); PG8_STAGE(PG8_SA(1, 1), a1 + hstep, voffA);
            PG8_WAIT_L(8); PG8_BAR; PG8_WAIT_L(0); PG8_MMA(0, 0, At, B0); PG8_BAR; PG8_SCHED;
            PG8_LDB(B1, 0, 1); PG8_STAGE(PG8_SB(0, 0), b2, voffB);
            PG8_BAR; PG8_WAIT_L(0); PG8_MMA(0, 1, At, B1); PG8_BAR;
            PG8_LDA(At, 0, 1); PG8_STAGE(PG8_SA(0, 0), a2, voffA);
            PG8_BAR; PG8_WAIT_L(0); PG8_MMA(1, 0, At, B0); PG8_BAR; PG8_SCHED;
            PG8_STAGE(PG8_SB(0, 1), b2 + hstep, voffB);
            PG8_WAIT_V(6); PG8_BAR; PG8_MMA(1, 1, At, B1); PG8_BAR;
            PG8_LDB(B0, 1, 0); PG8_SCHED; PG8_LDA(At, 1, 0); PG8_STAGE(PG8_SA(0, 1), a2 + hstep, voffA);
            PG8_WAIT_L(8); PG8_BAR; PG8_WAIT_L(0); PG8_MMA(0, 0, At, B0); PG8_BAR; PG8_SCHED;
            PG8_LDB(B1, 1, 1); PG8_STAGE(PG8_SB(1, 0), b3, voffB);
            PG8_BAR; PG8_WAIT_L(0); PG8_MMA(0, 1, At, B1); PG8_BAR;
            PG8_LDA(At, 1, 1); PG8_STAGE(PG8_SA(1, 0), a3, voffA);
            PG8_BAR; PG8_WAIT_L(0); PG8_MMA(1, 0, At, B0); PG8_BAR; PG8_SCHED;
            PG8_STAGE(PG8_SB(1, 1), b3 + hstep, voffB);
            PG8_WAIT_V(6); PG8_BAR; PG8_MMA(1, 1, At, B1); PG8_BAR;
            }
        }
        if constexpr (ALIGN_EPI) { if (wr == 0) PG8_BAR; }
        E(acc, cur, wr, wc, fr, fq);
        if (!has_next) break;
#pragma unroll
        for (int a = 0; a < 2; ++a)
#pragma unroll
            for (int b = 0; b < 2; ++b)
#pragma unroll
                for (int m = 0; m < 4; ++m)
#pragma unroll
                    for (int n = 0; n < 2; ++n) acc[a][b][m][n] = (f32x4){0.f, 0.f, 0.f, 0.f};
        cur = nxt; cA = nA; cB = nB; ++ui;
        if constexpr (ALIGN_EPI) { if (wr == 1) PG8_BAR; }
    }
    PG8_WAIT_V(0);
    if constexpr (!ALIGN_EPI) { if (wr == 0) PG8_BAR; }
    PG8_BAR;
#undef PG8_SA
#undef PG8_SB
#undef PG8_STAGE
#undef PG8_LDA
#undef PG8_LDB
#undef PG8_MMA
#undef PG8_WAIT_V
#undef PG8_WAIT_L
#undef PG8_BAR
#undef PG8_SCHED
}
}

#define XB_TMO      128
#define XB_XCNT(j)  (256  + 64 * (j))
#define XB_XSUB(j)  (1280 + 64 * (j))
#define XB_XGEN(j)  (2304 + 64 * (j))
#define XB_TOP      3328
#define XB_TOPGEN   3392
#define XCD_BAR_WORDS 3456
#define XB_SPIN_CAP (1u << 20)
__device__ __forceinline__ unsigned xb_ld(unsigned* p)              { return __hip_atomic_load(p, __ATOMIC_RELAXED, __HIP_MEMORY_SCOPE_AGENT); }
__device__ __forceinline__ unsigned xb_add(unsigned* p, unsigned v) { return __hip_atomic_fetch_add(p, v, __ATOMIC_RELAXED, __HIP_MEMORY_SCOPE_AGENT); }
__device__ __forceinline__ unsigned xb_xcc_id() { return (unsigned)__builtin_amdgcn_s_getreg((3 << 11) | 20) & 0xFu; }
#define XB_SPIN(cond, bar) do { unsigned _sp = 0; while (cond) { __builtin_amdgcn_s_sleep(1); \
    if ((++_sp & 255u) == 0u) { if (xb_ld(&(bar)[XB_TMO])) break; if (_sp > XB_SPIN_CAP) { atomicAdd(&(bar)[XB_TMO], 1u); break; } } } } while (0)
struct XcdBarrier { unsigned* bar; unsigned x; volatile LAS unsigned* st; };
__device__ __forceinline__ XcdBarrier xcd_barrier_post(unsigned* bar, volatile LAS unsigned* st) {
    XcdBarrier b; b.bar = bar; b.x = xb_xcc_id(); b.st = st;
    if (threadIdx.x == 0) (void)xb_add(&bar[XB_XCNT(b.x)], 1u);
    return b;
}
__device__ __forceinline__ void xcd_barrier_complete(unsigned* bar, unsigned x, unsigned& nloc, unsigned& nx) {
    const unsigned G = gridDim.x * gridDim.y * gridDim.z;
    unsigned sum, cnt, mine, sp = 0u;
    for (;;) {
        sum = 0u; cnt = 0u; mine = 0u;
#pragma unroll
        for (unsigned j = 0; j < 16; ++j) { const unsigned c = xb_ld(&bar[XB_XCNT(j)]); sum += c; cnt += (c > 0u) ? 1u : 0u; mine = (j == x) ? c : mine; }
        if (sum == G) break;
        __builtin_amdgcn_s_sleep(1);
        if ((++sp & 255u) == 0u) { if (xb_ld(&bar[XB_TMO])) break; if (sp > XB_SPIN_CAP) { atomicAdd(&bar[XB_TMO], 1u); break; } }
    }
    nloc = mine > 0u ? mine : 1u; nx = cnt > 0u ? cnt : 1u;
}
__device__ __forceinline__ void xcd_barrier(const XcdBarrier& b) {
    asm volatile("s_waitcnt vmcnt(0)" ::: "memory");
    __syncthreads();
    if (threadIdx.x == 0) {
        unsigned* bar = b.bar;
        __builtin_amdgcn_s_waitcnt(0);
        unsigned nloc = b.st[0], nx = b.st[1];
        if (nloc == 0u) { xcd_barrier_complete(bar, b.x, nloc, nx); b.st[0] = nloc; b.st[1] = nx; }
        const unsigned old = xb_add(&bar[XB_XSUB(b.x)], 1u);
        const unsigned gen = old / nloc;
        if (old + 1u == (gen + 1u) * nloc) {
            __builtin_amdgcn_fence(__ATOMIC_RELEASE, "agent");
            asm volatile("s_waitcnt vmcnt(0)" ::: "memory");
            const unsigned og = xb_add(&bar[XB_TOP], 1u);
            const unsigned tg = og / nx;
            if (og + 1u == (tg + 1u) * nx) xb_add(&bar[XB_TOPGEN], 1u);
            else XB_SPIN(xb_ld(&bar[XB_TOPGEN]) == tg, bar);
            __builtin_amdgcn_fence(__ATOMIC_ACQUIRE, "agent");
            xb_add(&bar[XB_XGEN(b.x)], 1u);
            asm volatile("s_waitcnt vmcnt(0)" ::: "memory");
        } else {
            XB_SPIN(xb_ld(&bar[XB_XGEN(b.x)]) == gen, bar);
            __builtin_amdgcn_fence(__ATOMIC_ACQUIRE, "agent");
            asm volatile("s_waitcnt vmcnt(0)" ::: "memory");
        }
    }
    __syncthreads();
}

struct Args { const float* in[28]; float* out; unsigned char* ws; int ph_lo, ph_hi, sub, pad; };
enum { I_X = 0, I_FFN_NORM, I_WG, I_WU, I_WD, I_MIX_NORM, I_WIN, I_WOUT, I_QN, I_KN, I_MU, I_W0, I_WUP, I_A0, I_AUP, I_GUP, I_KK, I_KA, I_RK, I_GNW, I_GNB, I_V0, I_VDOWN, I_VUP, I_CONV, I_ALOG, I_DTB, I_ONORM };

typedef const __attribute__((address_space(4))) Args* ArgsP;
struct Ctx {
    LAS unsigned char* lds;
    int tid, lane, wave, G, bid;
    ArgsP a;
};

template <class Get>
__device__ __forceinline__ void cvt_item(Get get, int K, bf16_t* WT, LAS float* scr, int kb, int nb, int lane) {
    const int k0 = 64 * kb, n0 = 32 * nb;
#pragma unroll 8
    for (int i = 0; i < 32; ++i) { const int kk = 2 * i + (lane >> 5); scr[kk * 33 + (lane & 31)] = get(k0 + kk, n0 + (lane & 31)); }
    asm volatile("s_waitcnt lgkmcnt(0)" ::: "memory");
    const int c = lane & 7;
#pragma unroll
    for (int j = 0; j < 4; ++j) { const int n = (lane >> 3) + 8 * j; const LAS float* s = scr + (8 * c) * 33 + n;
        u32x4 o; o.x = pk2(s[0 * 33], s[1 * 33]); o.y = pk2(s[2 * 33], s[3 * 33]); o.z = pk2(s[4 * 33], s[5 * 33]); o.w = pk2(s[6 * 33], s[7 * 33]);
        *(u32x4*)(WT + (size_t)(n0 + n) * K + k0 + 8 * c) = o; }
    asm volatile("s_waitcnt lgkmcnt(0)" ::: "memory");
}
__device__ __forceinline__ int win_cmap(int nn) {
    if (nn < 1352) return nn;
    if (nn < 1356) return 3272 + (nn - 1352);
    if (nn < 1360) return 3276 + (nn - 1356);
    if (nn < 1408) return -1;
    if (nn < 2304) return 1352 + (nn - 1408);
    return 2248 + (nn - 2304);
}
__device__ __forceinline__ void convert_layer_weights(const Ctx& C, int l) {
    const ArgsP Ap = C.a;
    LAS float* scr = (LAS float*)(C.lds + C.wave * 16384);
    unsigned char* wb = Ap->ws + WS_W;
    const int gw = C.bid * 8 + C.wave, NGW = C.G * 8;
    constexpr int I_GU = (DM / 64) * (NGU / 32), I_D = (FF / 64) * (DM / 32), I_IN = (DM / 64) * (NIN / 32), I_OUT = (DM / 64) * (DM / 32);
    constexpr int NIT = 2 * I_GU + 2 * I_D + I_IN + I_OUT;
    for (int it = gw; it < NIT; it += NGW) {
        int r = it;
        if (r < 2 * I_GU) { const int f = r / I_GU; r -= f * I_GU; const int nblk = NGU / 32, kb = r / nblk, nb = r % nblk;
            const float* wg = Ap->in[I_WG] + (size_t)(l * 2 + f) * DM * FF; const float* wu = Ap->in[I_WU] + (size_t)(l * 2 + f) * DM * FF; const float* gv = Ap->in[I_FFN_NORM] + (size_t)(l * 2 + f) * DM;
            auto get = [=](int k, int nn) -> float { const int pn = nn >> 8, bj = (nn >> 7) & 1, j = nn & 127; const float* w = bj ? wu : wg; return w[(size_t)k * FF + pn * 128 + j] * gv[k]; };
            cvt_item(get, DM, (bf16_t*)(wb + (f ? W_GU2 : W_GU1)), scr, kb, nb, C.lane); continue; }
        r -= 2 * I_GU;
        if (r < 2 * I_D) { const int f = r / I_D; r -= f * I_D; const int nblk = DM / 32, kb = r / nblk, nb = r % nblk;
            const float* wd = Ap->in[I_WD] + (size_t)(l * 2 + f) * FF * DM;
            auto get = [=](int k, int nn) -> float { return wd[(size_t)k * DM + nn]; };
            cvt_item(get, FF, (bf16_t*)(wb + (f ? W_D2 : W_D1)), scr, kb, nb, C.lane); continue; }
        r -= 2 * I_D;
        if (r < I_IN) { const int nblk = NIN / 32, kb = r / nblk, nb = r % nblk;
            const float* wi = Ap->in[I_WIN] + (size_t)l * DM * 3280; const float* gv = Ap->in[I_MIX_NORM] + (size_t)l * DM;
            auto get = [=](int k, int nn) -> float { const int c = win_cmap(nn); return c < 0 ? 0.f : wi[(size_t)k * 3280 + c] * gv[k]; };
            cvt_item(get, DM, (bf16_t*)(wb + W_IN), scr, kb, nb, C.lane); continue; }
        r -= I_IN;
        { const int nblk = DM / 32, kb = r / nblk, nb = r % nblk;
            const float* wo = Ap->in[I_WOUT] + (size_t)l * DM * DM;
            auto get = [=](int k, int nn) -> float { return wo[(size_t)k * DM + nn]; };
            cvt_item(get, DM, (bf16_t*)(wb + W_OUT), scr, kb, nb, C.lane); }
    }
}

__device__ const float ROPE_INV_HI[32] = {1.000000000e+00f, 7.498942018e-01f, 5.623413324e-01f, 4.216965139e-01f, 3.162277639e-01f, 2.371373773e-01f, 1.778279394e-01f, 1.333521456e-01f, 1.000000015e-01f, 7.498942316e-02f, 5.623413250e-02f, 4.216964915e-02f, 3.162277490e-02f, 2.371373773e-02f, 1.778279431e-02f, 1.333521400e-02f, 9.999999776e-03f, 7.498942316e-03f, 5.623413250e-03f, 4.216964822e-03f, 3.162277630e-03f, 2.371373819e-03f, 1.778279431e-03f, 1.333521446e-03f, 1.000000047e-03f, 7.498941850e-04f, 5.623413017e-04f, 4.216965172e-04f, 3.162277571e-04f, 2.371373703e-04f, 1.778279402e-04f, 1.333521504e-04f};
__device__ const float ROPE_INV_LO[32] = {0.000000000e+00f, 7.576931971e-09f, -7.245258615e-09f, -1.046263787e-08f, 2.125617904e-09f, -6.695950017e-09f, 1.612756151e-09f, -2.336302707e-09f, -1.490116142e-09f, -2.222539042e-09f, 2.053218012e-11f, 1.188910415e-09f, 1.702677888e-09f, -6.695949906e-10f, -2.112534175e-10f, 3.251632574e-10f, 2.235174129e-10f, -2.222539097e-10f, 2.053217839e-12f, 2.120233017e-10f, 3.056940465e-11f, -1.135256264e-10f, -2.112534106e-11f, -1.404980212e-11f, -4.749745042e-11f, 2.434073776e-11f, 2.348838658e-11f, -1.372226725e-11f, 8.877706729e-12f, 2.889693693e-13f, 7.978488746e-13f, -7.225746477e-12f};
__device__ __forceinline__ void prologue_x(const Ctx& C) {
    const ArgsP Ap = C.a;
    const float* x = Ap->in[I_X]; bf16_t* xbf = (bf16_t*)(Ap->ws + WS_XBF); float* ssq = (float*)(Ap->ws + WS_SSQ);
    const int gw = C.bid * 8 + C.wave, NGW = C.G * 8;
    for (int m = gw; m < MTOK; m += NGW) {
        const f32x4* xr = (const f32x4*)(x + (size_t)m * DM) + C.lane;
        f32x4 v[4]; float s = 0.f;
#pragma unroll
        for (int j = 0; j < 4; ++j) { v[j] = xr[64 * j]; s += (v[j][0] * v[j][0] + v[j][1] * v[j][1]) + (v[j][2] * v[j][2] + v[j][3] * v[j][3]); }
        s = wave_sum(s);
        u32x2* o8 = (u32x2*)(xbf + (size_t)m * DM) + C.lane;
#pragma unroll
        for (int j = 0; j < 4; ++j) { u32x2 w; w.x = pk2(v[j][0], v[j][1]); w.y = pk2(v[j][2], v[j][3]); o8[64 * j] = w; }
        if (C.lane < 16) ssq[(size_t)m * 16 + C.lane] = (C.lane == 0) ? s : 0.f;
    }
    f32x2* cs = (f32x2*)(Ap->ws + WS_ROPE);
    const int gt = C.bid * 512 + C.tid, NT = C.G * 512;
    for (int e = gt; e < SEQ * 32; e += NT) {
        const int pos = e >> 5, i = e & 31;
        const float fpos = (float)pos, ih = ROPE_INV_HI[i], il = ROPE_INV_LO[i];
        const float ph = fpos * ih; const float pe = fmaf(fpos, ih, -ph) + fpos * il;
        const float k = rintf(ph * 0.15915494309189535f);
        float r = fmaf(-k, 6.2831854820251465f, ph); r = fmaf(-k, -1.7484555e-07f, r); r += pe;
        const float r2 = r * r;
        float ts = 1.f, tc = 1.f;
        ts = 1.f - ts * r2 * (1.f / (18.f * 19.f)); ts = 1.f - ts * r2 * (1.f / (16.f * 17.f)); ts = 1.f - ts * r2 * (1.f / (14.f * 15.f)); ts = 1.f - ts * r2 * (1.f / (12.f * 13.f));
        ts = 1.f - ts * r2 * (1.f / (10.f * 11.f)); ts = 1.f - ts * r2 * (1.f / (8.f * 9.f)); ts = 1.f - ts * r2 * (1.f / (6.f * 7.f)); ts = 1.f - ts * r2 * (1.f / (4.f * 5.f)); ts = 1.f - ts * r2 * (1.f / (2.f * 3.f));
        tc = 1.f - tc * r2 * (1.f / (19.f * 20.f)); tc = 1.f - tc * r2 * (1.f / (17.f * 18.f)); tc = 1.f - tc * r2 * (1.f / (15.f * 16.f)); tc = 1.f - tc * r2 * (1.f / (13.f * 14.f)); tc = 1.f - tc * r2 * (1.f / (11.f * 12.f));
        tc = 1.f - tc * r2 * (1.f / (9.f * 10.f)); tc = 1.f - tc * r2 * (1.f / (7.f * 8.f)); tc = 1.f - tc * r2 * (1.f / (5.f * 6.f)); tc = 1.f - tc * r2 * (1.f / (3.f * 4.f)); tc = 1.f - tc * r2 * (1.f / (1.f * 2.f));
        cs[e] = (f32x2){tc, ts * r};
    }
}

__device__ __forceinline__ void prep_phase(const Ctx& C, int l) {
    const ArgsP Ap = C.a;
    bf16_t* P = (bf16_t*)(Ap->ws + WS_P);
    const f32x2* cs = (const f32x2*)(Ap->ws + WS_ROPE);
    const float* qn = Ap->in[I_QN] + l * 64; const float* kn = Ap->in[I_KN] + l * 64;
    {
        const int gw = C.bid * 8 + C.wave, NGW = C.G * 8; const int hl = C.lane >> 5, i = C.lane & 31;
        for (int rep = 0; rep < ((PROBE_DUP & 128) ? 2 : 1); ++rep)
        for (int m = gw; m < MTOK; m += NGW) {
            const int pos = m & (SEQ - 1); const f32x2 c = cs[pos * 32 + i];
            bf16_t* row = P + (size_t)m * NIN;
#pragma unroll 1
            for (int hp = 0; hp < 10; ++hp) {
                const int hd = hp * 2 + hl; if (hd >= 19) continue;
                int col; const float* nw = nullptr; float sc = 1.f;
                if (hd < 8) { col = PQ + hd * 64; nw = qn; sc = 0.125f; } else if (hd < 10) { col = PK + (hd - 8) * 64; nw = kn; } else if (hd < 18) { col = PQI + (hd - 10) * 64; } else { col = PKI; }
                float x1 = bf2f(row[col + i]), x2 = bf2f(row[col + 32 + i]);
                if (nw) { float ss = x1 * x1 + x2 * x2;
#pragma unroll
                    for (int o = 1; o < 32; o <<= 1) ss += __shfl_xor(ss, o);
                    const float rs = rsqrtf(ss * (1.f / 64.f) + NORM_EPS) * sc; x1 = x1 * rs * nw[i]; x2 = x2 * rs * nw[i + 32]; }
                const float o1 = x1 * c[0] - x2 * c[1], o2 = x2 * c[0] + x1 * c[1];
                if ((PROBE_DUP & 128) && rep == 0) { bf16_t* dr = (bf16_t*)(Ap->ws + WS_Y) + (size_t)m * DM + (col & 1023); dr[i] = (bf16_t)f2bf(o1); dr[32 + i] = (bf16_t)f2bf(o2); }
                else { row[col + i] = (bf16_t)f2bf(o1); row[col + 32 + i] = (bf16_t)f2bf(o2); }
            }
        }
    }
    {
        bf16_t* LO = (bf16_t*)(Ap->ws + WS_XBF);
        LAS float* in128 = (LAS float*)C.lds;
        LAS float* vt = (LAS float*)(C.lds + 32768);
        LAS float* vd = (LAS float*)(C.lds + 32768 + 65536);
        const float* mu = Ap->in[I_MU] + l * 896;
        const int c0 = C.tid & 255, half = C.tid >> 8;
        for (int rep = 0; rep < ((PROBE_DUP & 64) ? 2 : 1); ++rep)
        for (int tile = C.bid; tile < MTOK / 64; tile += C.G) {
            const int m0 = tile * 64;
            int c = c0; asm volatile("" : "+v"(c));
            __syncthreads();
            for (int e = C.tid; e < 64 * 128; e += 512) { const int t = e >> 7, j = e & 127; const int m = m0 + t; const bf16_t* row = P + (size_t)m * NIN + PRW + 768;
                const float cur = bf2f(row[j]); const float prev = (m & (SEQ - 1)) ? bf2f(row[j - NIN]) : 0.f; float h = cur + (prev - cur) * mu[768 + j];
                if (j < 32) h = tanhf(h); else if (j >= 64) h = sigmoidf_(h);
                in128[e] = h; }
            if (l > 0) {
                for (int e = C.tid; e < 64 * 256; e += 512) { const int t = e >> 8, j = e & 255; const int m = m0 + t; const bf16_t* row = P + (size_t)m * NIN + PRW + 512;
                    const float cur = bf2f(row[j]); const float prev = (m & (SEQ - 1)) ? bf2f(row[j - NIN]) : 0.f; vt[e] = cur + (prev - cur) * mu[512 + j]; }
                __syncthreads();
                const float* vdn = Ap->in[I_VDOWN] + (size_t)(l - 1) * 256 * 32;
                for (int e = C.tid; e < 64 * 32; e += 512) { const int t = e >> 5, j = e & 31; float s = 0.f;
                    for (int k = 0; k < 256; ++k) s += vt[t * 256 + k] * vdn[k * 32 + j];
                    vd[e] = s; }
            }
            __syncthreads();
            const int tb = half * 32;
            { const float* wup = Ap->in[I_WUP] + (size_t)l * 32 * 256; float w[32];
#pragma unroll
              for (int j = 0; j < 32; ++j) w[j] = wup[j * 256 + c];
              const float w0 = Ap->in[I_W0][l * 256 + c];
              asm volatile("" ::: "memory");
#pragma unroll 1
              for (int t = tb; t < tb + 32; ++t) { float s = w0;
#pragma unroll
                  for (int j = 0; j < 32; ++j) s += in128[t * 128 + j] * w[j];
                  const float wlog = -softplusf_(-s) - 0.5f; LO[(size_t)(m0 + t) * 1024 + c] = (bf16_t)f2bf(-__expf(wlog)); } }
            { const float* aup = Ap->in[I_AUP] + (size_t)l * 32 * 256; float w[32];
#pragma unroll
              for (int j = 0; j < 32; ++j) w[j] = aup[j * 256 + c];
              const float a0 = Ap->in[I_A0][l * 256 + c];
              asm volatile("" ::: "memory");
#pragma unroll 1
              for (int t = tb; t < tb + 32; ++t) { float s = a0;
#pragma unroll
                  for (int j = 0; j < 32; ++j) s += in128[t * 128 + 32 + j] * w[j];
                  LO[(size_t)(m0 + t) * 1024 + 256 + c] = (bf16_t)f2bf(sigmoidf_(s)); } }
            { const float* gup = Ap->in[I_GUP] + (size_t)l * 64 * 256; float w[64];
#pragma unroll
              for (int j = 0; j < 64; ++j) w[j] = gup[j * 256 + c];
              asm volatile("" ::: "memory");
#pragma unroll 1
              for (int t = tb; t < tb + 32; ++t) { float s = 0.f;
#pragma unroll
                  for (int j = 0; j < 64; ++j) s += in128[t * 128 + 64 + j] * w[j];
                  LO[(size_t)(m0 + t) * 1024 + 512 + c] = (bf16_t)f2bf(s); } }
            if (l > 0) { const float* vup = Ap->in[I_VUP] + (size_t)(l - 1) * 32 * 256; float w[32];
#pragma unroll
              for (int j = 0; j < 32; ++j) w[j] = vup[j * 256 + c];
              const float v0 = Ap->in[I_V0][(l - 1) * 256 + c];
              asm volatile("" ::: "memory");
#pragma unroll 1
              for (int t = tb; t < tb + 32; ++t) { float s = v0;
#pragma unroll
                  for (int j = 0; j < 32; ++j) s += vd[t * 32 + j] * w[j];
                  LO[(size_t)(m0 + t) * 1024 + 768 + c] = (bf16_t)f2bf(sigmoidf_(s)); } }
        }
        __syncthreads();
    }
}

constexpr int CK_ST = 144, CK_MAT = 64 * CK_ST, CK_FS = 68;
template <int MODE> struct CkL {
    static constexpr int YA = 0, XB = CK_MAT, XK = 2 * CK_MAT;
    static constexpr int YR = 3 * CK_MAT, ATS = 4 * CK_MAT, RTS = 5 * CK_MAT;
    static constexpr int B0 = MODE == 0 ? 3 * CK_MAT : 6 * CK_MAT;
    static constexpr int VT = B0, BBT = B0 + CK_MAT, KBT = B0 + 2 * CK_MAT, MBR = BBT, MKR = KBT, NAK = B0 + 3 * CK_MAT, WBF = B0 + 4 * CK_MAT;
    static constexpr int S0 = WBF + CK_MAT;
    static constexpr int F0 = MODE == 0 ? B0 + 6 * CK_MAT : B0 + 6 * CK_MAT;
    static constexpr int NAB = F0;
    static constexpr int Z = NAB + 64 * CK_FS * 4;
    static constexpr int TJ = Z + (MODE == 0 ? 128 : 64) * CK_FS * 4;
    static constexpr int SC = TJ + 4096;
    static constexpr int END = SC + (3 * 64 + 512) * 4;
};
static_assert(CkL<0>::END <= LDS_MISC && CkL<1>::END <= LDS_MISC, "chunk lds");

constexpr size_t WS_PST = 224 * MiB, WS_DS = 240 * MiB;
constexpr int CW_CNTA = 12288, CW_FLAGB = 14336;

__device__ __forceinline__ void mm2(f32x4 (&c)[2], const LAS unsigned char* A, const LAS unsigned char* B, int tm, int tn0, int lane) {
    const int r = lane & 15, g = lane >> 4;
#pragma unroll
    for (int s = 0; s < 2; ++s) {
        const bf16x8 a = *(const LAS bf16x8*)(A + (tm * 16 + r) * CK_ST + (32 * s + 8 * g) * 2);
#pragma unroll
        for (int q = 0; q < 2; ++q) { const bf16x8 b = *(const LAS bf16x8*)(B + ((tn0 + q) * 16 + r) * CK_ST + (32 * s + 8 * g) * 2);
            c[q] = __builtin_amdgcn_mfma_f32_16x16x32_bf16(a, b, c[q], 0, 0, 0); }
    }
}
__device__ __forceinline__ void st_bf(LAS unsigned char* base, int row, int col, float v) { *(LAS bf16_t*)(base + row * CK_ST + col * 2) = (bf16_t)f2bf(v); }
__device__ __forceinline__ void st8_bf(LAS unsigned char* base, int row, int col0, const float (&v)[8]) {
    u32x4 w; w.x = pk2(v[0], v[1]); w.y = pk2(v[2], v[3]); w.z = pk2(v[4], v[5]); w.w = pk2(v[6], v[7]); *(LAS u32x4*)(base + row * CK_ST + col0 * 2) = w; }

struct CkTok { float v[8], p0[8], p1[8]; };
template <int MODE> __device__ __forceinline__ void ck_store_tok(LAS unsigned char* lds, int t, int lane, float ya, float xb, float xk, float yr, float ats, float rts) {
    typedef CkL<MODE> L;
    st_bf(lds + L::YA, t, lane, ya); st_bf(lds + L::XB, t, lane, xb); st_bf(lds + L::XK, t, lane, xk);
    if (MODE == 1) { st_bf(lds + L::YR, t, lane, yr); st_bf(lds + L::ATS, t, lane, ats); st_bf(lds + L::RTS, t, lane, rts); }
}

template <int MODE>
__device__ __forceinline__ void rwkv_prep(const Ctx& C, int l, int b, int h, int n, CkTok& K, LAS unsigned char* lds) {
    typedef CkL<MODE> L; LAS float* Gs = (LAS float*)(lds + L::SC); LAS float* Bs = Gs + 64; LAS float* Gam = Gs + 128; LAS float* wsum = Gs + 192; LAS float* Z = (LAS float*)(lds + L::Z);
    const ArgsP Ap = C.a; const int lane = C.lane, w = C.wave, ch = h * 64 + lane;
    const bf16_t* P = (const bf16_t*)(Ap->ws + WS_P); const bf16_t* LO = (const bf16_t*)(Ap->ws + WS_XBF); bf16_t* VF = (bf16_t*)(Ap->ws + WS_VF);
    const float* mu = Ap->in[I_MU] + l * 896;
    const float mu_r = mu[ch], mu_k = mu[256 + ch], mu_v = mu[512 + ch];
    const float k_k = Ap->in[I_KK][l * 256 + ch], k_a = Ap->in[I_KA][l * 256 + ch], r_k = Ap->in[I_RK][l * 256 + ch];
    const int tq0 = n * 64 + 8 * w;
    const size_t m0 = (size_t)b * SEQ + tq0;
    float rp = 0.f, kp = 0.f, vp = 0.f;
    if (tq0 > 0) { const bf16_t* row = P + (m0 - 1) * NIN + PRW; rp = bf2f(row[ch]); kp = bf2f(row[256 + ch]); vp = bf2f(row[512 + ch]); }
    bf16_t q_rc[8], q_kc[8], q_vc[8], q_wl[8], q_a[8], q_g[8], q_vg[8], q_vf[8];
#pragma unroll
    for (int tt = 0; tt < 8; ++tt) {
        const size_t m = m0 + tt; const bf16_t* row = P + m * NIN + PRW; const bf16_t* lo = LO + m * 1024;
        q_rc[tt] = row[ch]; q_kc[tt] = row[256 + ch]; q_vc[tt] = row[512 + ch]; q_wl[tt] = lo[ch]; q_a[tt] = lo[256 + ch];
        q_g[tt] = (MODE == 1) ? lo[512 + ch] : (bf16_t)0; q_vg[tt] = 0; q_vf[tt] = 0;
        if (l > 0) { q_vg[tt] = lo[768 + ch]; q_vf[tt] = VF[m * 256 + ch]; }
    }
    __builtin_amdgcn_sched_barrier(0);
    float lw[8], as[8], bs_[8], k2[8], rr[8];
#pragma unroll
    for (int tt = 0; tt < 8; ++tt) {
        const size_t m = m0 + tt;
        const float rc = bf2f(q_rc[tt]), kc = bf2f(q_kc[tt]), vc = bf2f(q_vc[tt]);
        const float r = rc + (rp - rc) * mu_r, k = kc + (kp - kc) * mu_k; float v = vc + (vp - vc) * mu_v;
        rp = rc; kp = kc; vp = vc;
        const float wl = bf2f(q_wl[tt]), a = bf2f(q_a[tt]);
        if (l == 0) { if (MODE == 0) VF[m * 256 + ch] = (bf16_t)f2bf(v); }
        else { const float vg = bf2f(q_vg[tt]); const float vf = bf2f(q_vf[tt]); v = v + (vf - v) * vg; }
        const float kkp = k * k_k; const float n2 = wave_sum(kkp * kkp); const float kk = kkp * rsqrtf(n2 + 1e-12f);
        k2[tt] = k * (1.f + (a - 1.f) * k_a); as[tt] = -kk; bs_[tt] = kk * a; rr[tt] = r; lw[tt] = wl; K.v[tt] = v;
        if (MODE == 1) { K.p0[tt] = wave_sum(r * k2[tt] * r_k); K.p1[tt] = bf2f(q_g[tt]); }
    }
    float g[8]; g[0] = lw[0];
#pragma unroll
    for (int tt = 1; tt < 8; ++tt) g[tt] = g[tt - 1] + lw[tt];
    wsum[w * 64 + lane] = g[7];
    __syncthreads();
    float pre = 0.f, tot = 0.f;
#pragma unroll
    for (int ww = 0; ww < 8; ++ww) { const float s = wsum[ww * 64 + lane]; tot += s; if (ww < w) pre += s; }
    float bb[8], kb[8], at[8]; float eGprev = __expf(pre); const float etot = __expf(tot);
#pragma unroll
    for (int tt = 0; tt < 8; ++tt) {
        const float G = pre + g[tt];
        const float eG = __expf(G), eGi = __builtin_amdgcn_rcpf(eG), eGp = eGprev, eT = etot * eGi;
        eGprev = eG;
        const float ya = as[tt] * eGp, yr = rr[tt] * eG;
        ck_store_tok<MODE>(lds, 8 * w + tt, lane, ya, bs_[tt] * eGi, k2[tt] * eGi, yr, ya, yr);
        bb[tt] = bs_[tt] * eT; kb[tt] = k2[tt] * eT; at[tt] = ya;
    }
    st8_bf(lds + L::VT, lane, 8 * w, K.v);
    if (MODE == 0) { st8_bf(lds + L::BBT, lane, 8 * w, bb); st8_bf(lds + L::KBT, lane, 8 * w, kb);
#pragma unroll
        for (int tt = 0; tt < 8; ++tt) Z[(64 + lane) * CK_FS + 8 * w + tt] = at[tt];
        if (w == 0) Gam[lane] = etot; }
    if (lane < 8) { Gs[8 * w + lane] = 0.f; Bs[8 * w + lane] = 1.f; }
}
template <int MODE>
__device__ __forceinline__ void gdn_prep(const Ctx& C, int l, int b, int h, int n, CkTok& K, LAS unsigned char* lds) {
    typedef CkL<MODE> L; LAS float* Gs = (LAS float*)(lds + L::SC); LAS float* Bs = Gs + 64; LAS float* Gam = Gs + 128; LAS float* wsum = Gs + 192; LAS float* Z = (LAS float*)(lds + L::Z);
    const ArgsP Ap = C.a; const int lane = C.lane, w = C.wave, ch = h * 64 + lane;
    const bf16_t* P = (const bf16_t*)(Ap->ws + WS_P);
    const float* cw = Ap->in[I_CONV] + (size_t)l * 4 * 768;
    float wq[4], wk[4], wv[4];
#pragma unroll
    for (int j = 0; j < 4; ++j) { wq[j] = cw[j * 768 + ch]; wk[j] = cw[j * 768 + 256 + ch]; wv[j] = cw[j * 768 + 512 + ch]; }
    const float nexpa = -__expf(Ap->in[I_ALOG][l * 4 + h]), dtb = Ap->in[I_DTB][l * 4 + h];
    const int tq0 = n * 64 + 8 * w; const size_t m0 = (size_t)b * SEQ + tq0;
    float xq[3], xk[3], xv[3];
#pragma unroll
    for (int d = 0; d < 3; ++d) { const int t = tq0 - 3 + d; xq[d] = 0.f; xk[d] = 0.f; xv[d] = 0.f;
        if (t >= 0) { const bf16_t* rr = P + (m0 - 3 + d) * NIN + PGD; xq[d] = bf2f(rr[ch]); xk[d] = bf2f(rr[256 + ch]); xv[d] = bf2f(rr[512 + ch]); } }
    bf16_t q_q[8], q_k[8], q_v[8], q_b[8], q_a[8], q_z[8];
#pragma unroll
    for (int tt = 0; tt < 8; ++tt) {
        const bf16_t* row = P + (m0 + tt) * NIN;
        q_q[tt] = row[PGD + ch]; q_k[tt] = row[PGD + 256 + ch]; q_v[tt] = row[PGD + 512 + ch]; q_b[tt] = row[PGB + h]; q_a[tt] = row[PGA + h];
        q_z[tt] = (MODE == 1) ? row[PGD + 768 + ch] : (bf16_t)0;
    }
    __builtin_amdgcn_sched_barrier(0);
    float lw[8], kr[8], qr[8], be[8];
#pragma unroll
    for (int tt = 0; tt < 8; ++tt) {
        const float cq = bf2f(q_q[tt]), ck = bf2f(q_k[tt]), cv = bf2f(q_v[tt]);
        float sq = wq[0] * xq[0] + wq[1] * xq[1] + wq[2] * xq[2] + wq[3] * cq;
        float sk = wk[0] * xk[0] + wk[1] * xk[1] + wk[2] * xk[2] + wk[3] * ck;
        float sv = wv[0] * xv[0] + wv[1] * xv[1] + wv[2] * xv[2] + wv[3] * cv;
        xq[0] = xq[1]; xq[1] = xq[2]; xq[2] = cq; xk[0] = xk[1]; xk[1] = xk[2]; xk[2] = ck; xv[0] = xv[1]; xv[1] = xv[2]; xv[2] = cv;
        sq = siluf_(sq); sk = siluf_(sk); sv = siluf_(sv);
        qr[tt] = sq * rsqrtf(wave_sum(sq * sq) + 1e-6f) * 0.125f; kr[tt] = sk * rsqrtf(wave_sum(sk * sk) + 1e-6f); K.v[tt] = sv;
        be[tt] = sigmoidf_(bf2f(q_b[tt])); lw[tt] = nexpa * softplusf_(bf2f(q_a[tt]) + dtb);
        if (MODE == 1) { K.p0[tt] = siluf_(bf2f(q_z[tt])); K.p1[tt] = 0.f; }
    }
    float g[8]; g[0] = lw[0];
#pragma unroll
    for (int tt = 1; tt < 8; ++tt) g[tt] = g[tt - 1] + lw[tt];
    wsum[w * 64 + lane] = g[7];
    __syncthreads();
    float pre = 0.f, tot = 0.f;
#pragma unroll
    for (int ww = 0; ww < 8; ++ww) { const float s = wsum[ww * 64 + lane]; tot += s; if (ww < w) pre += s; }
    float bb[8], kb[8], at[8];
#pragma unroll
    for (int tt = 0; tt < 8; ++tt) {
        const float G = pre + g[tt]; const float eG = __expf(G), eT = __expf(tot - G);
        ck_store_tok<MODE>(lds, 8 * w + tt, lane, kr[tt], -kr[tt], kr[tt], qr[tt], kr[tt] * eG, qr[tt] * eG);
        bb[tt] = -be[tt] * kr[tt] * eT; kb[tt] = -bb[tt]; at[tt] = kr[tt] * eG;
        if (lane == tt) { Gs[8 * w + tt] = G; Bs[8 * w + tt] = be[tt]; }
    }
    st8_bf(lds + L::VT, lane, 8 * w, K.v);
    if (MODE == 0) { st8_bf(lds + L::BBT, lane, 8 * w, bb); st8_bf(lds + L::KBT, lane, 8 * w, kb);
#pragma unroll
        for (int tt = 0; tt < 8; ++tt) Z[(64 + lane) * CK_FS + 8 * w + tt] = at[tt];
        if (w == 0) Gam[lane] = __expf(tot); }
}

template <int MODE, bool PUBLISH = true>
__device__ __forceinline__ void chunk_item(const Ctx& C, int l, int combo, int n) {
    typedef CkL<MODE> L;
    int lane_o = C.lane; asm volatile("" : "+v"(lane_o));
    const ArgsP Ap = C.a; const int lane = lane_o, w = C.wave, tid = w * 64 + lane, r16 = lane & 15, g4 = lane >> 4;
    const int mix = combo >> 3, bh = combo & 7, b = bh >> 2, h = bh & 3;
    LAS unsigned char* lds = C.lds;
    LAS float* NAB = (LAS float*)(lds + L::NAB); LAS float* Z = (LAS float*)(lds + L::Z); LAS float* TJ = (LAS float*)(lds + L::TJ);
    LAS float* Gs = (LAS float*)(lds + L::SC); LAS float* Bs = Gs + 64; LAS float* Gam = Gs + 128; LAS float* wsum = Gs + 192;
    bf16_t* PSTg = (bf16_t*)(Ap->ws + WS_PST) + ((size_t)combo * 128 + n) * 4096;
    bf16_t* DSg = (bf16_t*)(Ap->ws + WS_DS) + ((size_t)combo * 128 + n) * 4096;
    __syncthreads();
    CkTok K;
    Ctx C2 = C; C2.lane = lane; C2.tid = tid;
    for (int rp1 = 0; rp1 < (PROBE_CK == 1 ? 2 : 1); ++rp1) {
    if (rp1) __syncthreads();
    if (mix == 0) rwkv_prep<MODE>(C2, l, b, h, n, K, lds); else gdn_prep<MODE>(C2, l, b, h, n, K, lds);
    if (MODE == 1) {
        const int vi = tid >> 3, c8 = (tid & 7) * 8;
        u32x4 v = (u32x4){0u, 0u, 0u, 0u};
        if (n > 0) v = *(const u32x4*)(DSg - 4096 + vi * 64 + c8);
        *(LAS u32x4*)(lds + L::S0 + vi * CK_ST + c8 * 2) = v;
    }
    }
    __syncthreads();
    const int tm = w >> 1, tn0 = 2 * (w & 1);
    for (int rp2 = 0; rp2 < (PROBE_CK == 2 ? 2 : 1); ++rp2) {
        f32x4 cab[2] = {{0.f, 0.f, 0.f, 0.f}, {0.f, 0.f, 0.f, 0.f}}, cak[2] = {{0.f, 0.f, 0.f, 0.f}, {0.f, 0.f, 0.f, 0.f}};
        mm2(cab, lds + L::YA, lds + L::XB, tm, tn0, lane); mm2(cak, lds + L::YA, lds + L::XK, tm, tn0, lane);
        f32x4 cbr[2] = {{0.f, 0.f, 0.f, 0.f}, {0.f, 0.f, 0.f, 0.f}}, ckr[2] = {{0.f, 0.f, 0.f, 0.f}, {0.f, 0.f, 0.f, 0.f}};
        if (MODE == 1) { mm2(cbr, lds + L::YR, lds + L::XB, tm, tn0, lane); mm2(ckr, lds + L::YR, lds + L::XK, tm, tn0, lane); }
#pragma unroll
        for (int q = 0; q < 2; ++q) { const int i = 16 * (tn0 + q) + r16; const float gi = Gs[i], bi = Bs[i];
#pragma unroll
            for (int rg = 0; rg < 4; ++rg) { const int t = 16 * tm + 4 * g4 + rg; const float f = (i <= t) ? bi * __expf(Gs[t] - gi) : 0.f; const float fs = (i < t) ? f : 0.f;
                NAB[t * CK_FS + i] = cab[q][rg] * fs; st_bf(lds + L::NAK, t, i, cak[q][rg] * fs);
                if (MODE == 1) { st_bf(lds + L::MBR, t, i, cbr[q][rg] * f); st_bf(lds + L::MKR, t, i, ckr[q][rg] * f); } } }
    }
    __syncthreads();
    for (int rp3 = 0; rp3 < ((PROBE_CK == 3 || PROBE_CK == 4) ? 2 : 1); ++rp3) {
    if (rp3) __syncthreads();
    {
        f32x4 cx[2] = {{0.f, 0.f, 0.f, 0.f}, {0.f, 0.f, 0.f, 0.f}};
        mm2(cx, lds + L::VT, lds + L::NAK, tm, tn0, lane);
        if (MODE == 1) mm2(cx, lds + L::S0, lds + L::ATS, tm, tn0, lane);
#pragma unroll
        for (int q = 0; q < 2; ++q)
#pragma unroll
            for (int rg = 0; rg < 4; ++rg) Z[(16 * tm + 4 * g4 + rg) * CK_FS + 16 * (tn0 + q) + r16] = cx[q][rg];
    }
    if (w == 0) {
        const int J = g4, r = r16; float T[16];
#pragma unroll
        for (int c = 0; c < 16; ++c) { float s = (c == r) ? 1.f : 0.f;
#pragma unroll
            for (int mm = 0; mm < 16; ++mm) if (mm < c) s += T[mm] * NAB[(16 * J + c) * CK_FS + 16 * J + mm];
            T[c] = s; }
#pragma unroll
        for (int c = 0; c < 16; ++c) TJ[J * 256 + r * 16 + c] = T[c];
    }
    __syncthreads();
    if (PROBE_CK == 3 && rp3 == 0) continue;
    if (MODE == 0 || w < 4) {
        const int r0 = 16 * w;
#pragma unroll
        for (int J = 0; J < 4; ++J) {
            f32x4 acc;
#pragma unroll
            for (int rg = 0; rg < 4; ++rg) acc[rg] = Z[(r0 + 4 * g4 + rg) * CK_FS + 16 * J + r16];
#pragma unroll
            for (int I = 0; I < 4; ++I) if (I < J) {
#pragma unroll
                for (int q = 0; q < 4; ++q) { const float a = Z[(r0 + r16) * CK_FS + 16 * I + 4 * q + g4]; const float bq = NAB[(16 * J + r16) * CK_FS + 16 * I + 4 * q + g4];
                    acc = __builtin_amdgcn_mfma_f32_16x16x4f32(a, bq, acc, 0, 0, 0); } }
#pragma unroll
            for (int rg = 0; rg < 4; ++rg) Z[(r0 + 4 * g4 + rg) * CK_FS + 16 * J + r16] = acc[rg];
            f32x4 wv = {0.f, 0.f, 0.f, 0.f};
#pragma unroll
            for (int q = 0; q < 4; ++q) { const float a = Z[(r0 + r16) * CK_FS + 16 * J + 4 * q + g4]; const float bq = TJ[J * 256 + (4 * q + g4) * 16 + r16];
                wv = __builtin_amdgcn_mfma_f32_16x16x4f32(a, bq, wv, 0, 0, 0); }
#pragma unroll
            for (int rg = 0; rg < 4; ++rg) { Z[(r0 + 4 * g4 + rg) * CK_FS + 16 * J + r16] = wv[rg]; st_bf(lds + L::WBF, r0 + 4 * g4 + rg, 16 * J + r16, wv[rg]); }
        }
    }
    }
    __syncthreads();
    for (int rp5 = 0; rp5 < (PROBE_CK == 5 ? 2 : 1); ++rp5) {
    if (MODE == 0) {
        f32x4 cp[2] = {{0.f, 0.f, 0.f, 0.f}, {0.f, 0.f, 0.f, 0.f}};
        mm2(cp, lds + L::WBF + 64 * CK_ST, lds + L::BBT, tm, tn0, lane);
        f32x4 cd[2] = {{0.f, 0.f, 0.f, 0.f}, {0.f, 0.f, 0.f, 0.f}};
        mm2(cd, lds + L::BBT, lds + L::WBF, tm, tn0, lane); mm2(cd, lds + L::KBT, lds + L::VT, tm, tn0, lane);
#pragma unroll
        for (int q = 0; q < 2; ++q) { const int jp = 16 * (tn0 + q) + r16, j0 = 16 * tm + 4 * g4; f32x4 v = cp[q];
#pragma unroll
            for (int rg = 0; rg < 4; ++rg) if (j0 + rg == jp) v[rg] += Gam[jp];
            const unsigned long long o = (unsigned long long)pk2(v[0], v[1]) | ((unsigned long long)pk2(v[2], v[3]) << 32);
            __hip_atomic_store((unsigned long long*)(PSTg + jp * 64 + j0), o, __ATOMIC_RELAXED, __HIP_MEMORY_SCOPE_AGENT);
            const int vi = jp; const unsigned long long o2 = (unsigned long long)pk2(cd[q][0], cd[q][1]) | ((unsigned long long)pk2(cd[q][2], cd[q][3]) << 32);
            __hip_atomic_store((unsigned long long*)(DSg + vi * 64 + j0), o2, __ATOMIC_RELAXED, __HIP_MEMORY_SCOPE_AGENT); }
        asm volatile("s_waitcnt vmcnt(0)" ::: "memory");
        __syncthreads();
        if (PUBLISH && tid == 0 && rp5 == (PROBE_CK == 5 ? 1 : 0)) {
            __hip_atomic_fetch_add((unsigned*)(Ap->ws + WS_CTL) + CW_CNTA + 64 * (16 * l + combo), 1u, __ATOMIC_RELAXED, __HIP_MEMORY_SCOPE_AGENT); }
    } else {
        f32x4 cy[2] = {{0.f, 0.f, 0.f, 0.f}, {0.f, 0.f, 0.f, 0.f}};
        mm2(cy, lds + L::RTS, lds + L::S0, tm, tn0, lane); mm2(cy, lds + L::MBR, lds + L::WBF, tm, tn0, lane); mm2(cy, lds + L::MKR, lds + L::VT, tm, tn0, lane);
#pragma unroll
        for (int q = 0; q < 2; ++q)
#pragma unroll
            for (int rg = 0; rg < 4; ++rg) Z[(16 * tm + 4 * g4 + rg) * CK_FS + 16 * (tn0 + q) + r16] = cy[q][rg];
        __syncthreads();
        bf16_t* Y = (bf16_t*)(Ap->ws + WS_Y);
        const int ch = h * 64 + lane; const size_t m0 = (size_t)b * SEQ + n * 64 + 8 * w;
        if (mix == 0) { const float gn_w = Ap->in[I_GNW][l * 256 + ch], gn_b = Ap->in[I_GNB][l * 256 + ch];
#pragma unroll
            for (int tt = 0; tt < 8; ++tt) { const float y = Z[(8 * w + tt) * CK_FS + lane]; const float mean = wave_sum(y) * (1.f / 64.f); const float d = y - mean; const float var = wave_sum(d * d) * (1.f / 64.f);
                const float yn = d * rsqrtf(var + 64e-5f) * gn_w + gn_b; Y[(m0 + tt) * DM + 512 + ch] = (bf16_t)f2bf((yn + K.p0[tt] * K.v[tt]) * K.p1[tt]); } }
        else { const float onw = Ap->in[I_ONORM][l * 64 + lane];
#pragma unroll
            for (int tt = 0; tt < 8; ++tt) { const float o = Z[(8 * w + tt) * CK_FS + lane]; const float rs = rsqrtf(wave_sum(o * o) * (1.f / 64.f) + NORM_EPS);
                Y[(m0 + tt) * DM + 768 + ch] = (bf16_t)f2bf(o * rs * onw * K.p0[tt]); } }
    }
    }
}

__device__ __forceinline__ void chunk_phaseB(const Ctx& C, int l, int combo, int vt) {
    const ArgsP Ap = C.a; const int lane = C.lane, w = C.wave, r16 = lane & 15, g4 = lane >> 4;
    unsigned* ctl = (unsigned*)(Ap->ws + WS_CTL);
    if (C.tid == 0) { unsigned sp = 0; while (__hip_atomic_load(ctl + CW_CNTA + 64 * (16 * l + combo), __ATOMIC_RELAXED, __HIP_MEMORY_SCOPE_AGENT) < 128u) { __builtin_amdgcn_s_sleep(2); if (++sp > (1u << 24)) break; }
        __builtin_amdgcn_fence(__ATOMIC_ACQUIRE, "agent"); asm volatile("s_waitcnt vmcnt(0)" ::: "memory"); }
    __syncthreads();
    if (w != 0) return;
    const bf16_t* PSTg = (const bf16_t*)(Ap->ws + WS_PST) + (size_t)combo * 128 * 4096;
    bf16_t* DSg = (bf16_t*)(Ap->ws + WS_DS) + (size_t)combo * 128 * 4096;
    f32x4 st[4];
#pragma unroll
    for (int m = 0; m < 4; ++m) st[m] = (f32x4){0.f, 0.f, 0.f, 0.f};
    u32x2 pa[3][4][2][2], dd[3][4];
#define CKB_LOAD(sg, nn) do { const bf16_t* ps = PSTg + (size_t)(nn) * 4096; const bf16_t* ds = DSg + (size_t)(nn) * 4096; \
        _Pragma("unroll") for (int m = 0; m < 4; ++m) { dd[sg][m] = *(const u32x2*)(ds + (16 * vt + r16) * 64 + 16 * m + 4 * g4); \
            _Pragma("unroll") for (int s = 0; s < 2; ++s) { pa[sg][m][s][0] = *(const u32x2*)(ps + (16 * m + r16) * 64 + 32 * s + 4 * g4); pa[sg][m][s][1] = *(const u32x2*)(ps + (16 * m + r16) * 64 + 32 * s + 16 + 4 * g4); } } } while (0)
#define CKB_STEP(sg, nn) do { bf16x8 bb[2]; \
        _Pragma("unroll") for (int s = 0; s < 2; ++s) { u32x4 t4; t4.x = pk2(st[2 * s][0], st[2 * s][1]); t4.y = pk2(st[2 * s][2], st[2 * s][3]); t4.z = pk2(st[2 * s + 1][0], st[2 * s + 1][1]); t4.w = pk2(st[2 * s + 1][2], st[2 * s + 1][3]); bb[s] = __builtin_bit_cast(bf16x8, t4); } \
        f32x4 nw[4]; \
        _Pragma("unroll") for (int m = 0; m < 4; ++m) { f32x4 c = {bflo(dd[sg][m].x), bfhi(dd[sg][m].x), bflo(dd[sg][m].y), bfhi(dd[sg][m].y)}; \
            _Pragma("unroll") for (int s = 0; s < 2; ++s) { u32x4 a4; a4.x = pa[sg][m][s][0].x; a4.y = pa[sg][m][s][0].y; a4.z = pa[sg][m][s][1].x; a4.w = pa[sg][m][s][1].y; \
                c = __builtin_amdgcn_mfma_f32_16x16x32_bf16(__builtin_bit_cast(bf16x8, a4), bb[s], c, 0, 0, 0); } \
            nw[m] = c; } \
        asm volatile("" ::: "memory"); CKB_LOAD(sg, ((nn) + 3 < 128 ? (nn) + 3 : 127)); asm volatile("" ::: "memory"); __builtin_amdgcn_sched_barrier(0); \
        _Pragma("unroll") for (int m = 0; m < 4; ++m) { st[m] = nw[m]; u32x2 o; o.x = pk2(nw[m][0], nw[m][1]); o.y = pk2(nw[m][2], nw[m][3]); if (!dry) __hip_atomic_store((unsigned long long*)(DSg + (size_t)(nn) * 4096 + (16 * vt + r16) * 64 + 16 * m + 4 * g4), (unsigned long long)o.x | ((unsigned long long)o.y << 32), __ATOMIC_RELAXED, __HIP_MEMORY_SCOPE_AGENT); } } while (0)
    for (int pass = ((PROBE_DUP & 1024) ? 0 : 1); pass < 2; ++pass) {
    const bool dry = (pass == 0);
#pragma unroll
    for (int m = 0; m < 4; ++m) st[m] = (f32x4){0.f, 0.f, 0.f, 0.f};
    CKB_LOAD(0, 0); CKB_LOAD(1, 1); CKB_LOAD(2, 2); asm volatile("" ::: "memory"); __builtin_amdgcn_sched_barrier(0);
#pragma unroll 1
    for (int n = 0; n < 126; n += 3) { CKB_STEP(0, n); CKB_STEP(1, n + 1); CKB_STEP(2, n + 2); }
    CKB_STEP(0, 126); CKB_STEP(1, 127);
    if (dry) { float s = 0.f; _Pragma("unroll") for (int m = 0; m < 4; ++m) s += st[m][0] + st[m][1] + st[m][2] + st[m][3]; if (s == 123.456f) *(float*)(DSg) = s; }
    }
#undef CKB_STEP
#undef CKB_LOAD
    asm volatile("s_waitcnt vmcnt(0)" ::: "memory");
    if (lane == 0) __hip_atomic_fetch_add(ctl + CW_FLAGB + 64 * (16 * l + combo), 1u, __ATOMIC_RELAXED, __HIP_MEMORY_SCOPE_AGENT);
}

constexpr int DS_CAP = 1024;
constexpr int DS_KI = 128 * 1024, DS_KIROW = 144, DS_KIBUF = 64 * DS_KIROW, DS_HIST = DS_KI + 2 * DS_KIBUF;
static_assert(DS_HIST + 8 * 1024 <= LDS_MISC, "dsa lds");

__device__ __forceinline__ unsigned wave_select256(LAS unsigned* list, int n, LAS unsigned* hist, int lane, unsigned* bad = nullptr) {
    unsigned k[16];
#pragma unroll
    for (int j = 0; j < 16; ++j) { const int i = j * 64 + lane; k[j] = (i < n) ? list[i] : 0u; }
    unsigned prefix = 0u, mask = 0u; int rem = 256;
#pragma unroll 1
    for (int pass = 0; pass < 4; ++pass) {
        const int sh = 24 - 8 * pass;
        *(LAS u32x4*)(hist + 4 * lane) = (u32x4){0u, 0u, 0u, 0u};
        asm volatile("s_waitcnt lgkmcnt(0)" ::: "memory");
#pragma unroll
        for (int j = 0; j < 16; ++j) { const int i = j * 64 + lane; if (i < n && ((k[j] ^ prefix) & mask) == 0u) __hip_atomic_fetch_add((LAS unsigned*)&hist[(k[j] >> sh) & 255u], 1u, __ATOMIC_RELAXED, __HIP_MEMORY_SCOPE_WORKGROUP); }
        asm volatile("s_waitcnt lgkmcnt(0)" ::: "memory");
        const u32x4 hv = *(const LAS u32x4*)(hist + 4 * lane);
        const int tl = (int)(hv[0] + hv[1] + hv[2] + hv[3]);
        int inc = tl;
        inc += __builtin_amdgcn_update_dpp(0, inc, 0x101, 0xf, 0xf, true); inc += __builtin_amdgcn_update_dpp(0, inc, 0x102, 0xf, 0xf, true);
        inc += __builtin_amdgcn_update_dpp(0, inc, 0x104, 0xf, 0xf, true); inc += __builtin_amdgcn_update_dpp(0, inc, 0x108, 0xf, 0xf, true);
        { const int t1 = __builtin_amdgcn_readlane(inc, 16), t2 = __builtin_amdgcn_readlane(inc, 32), t3 = __builtin_amdgcn_readlane(inc, 48); const int rw = lane >> 4;
          inc += (rw == 0) ? (t1 + t2 + t3) : (rw == 1) ? (t2 + t3) : (rw == 2) ? t3 : 0; }
#if defined(SELFCHECK)
        { int chk = tl;
#pragma unroll
          for (int o = 1; o < 64; o <<= 1) { const int v = __shfl_down(chk, o); if (lane + o < 64) chk += v; }
          if (__any(chk != inc)) *bad = 1u; }
#endif
        const int suf = inc - tl;
        const int s3 = suf + (int)hv[3], s2 = s3 + (int)hv[2], s1 = s2 + (int)hv[1], s0 = s1 + (int)hv[0];
        int digit = -1, above = 0;
        if (s3 >= rem && suf < rem) { digit = 4 * lane + 3; above = suf; }
        else if (s2 >= rem && s3 < rem) { digit = 4 * lane + 2; above = s3; }
        else if (s1 >= rem && s2 < rem) { digit = 4 * lane + 1; above = s2; }
        else if (s0 >= rem && s1 < rem) { digit = 4 * lane + 0; above = s1; }
        const unsigned long long bal = __ballot(digit >= 0);
        const int src = (int)__builtin_ctzll(bal | (1ull << 63));
        digit = __shfl(digit, src); above = __shfl(above, src);
        prefix |= (unsigned)digit << sh; mask |= 0xffu << sh; rem -= above;
    }
    int run = 0;
#pragma unroll
    for (int j = 0; j < 16; ++j) { const int i = j * 64 + lane; const bool keep = (i < n) && (k[j] >= prefix);
        const unsigned long long bal = __ballot(keep);
        const int pos = run + (int)__builtin_amdgcn_mbcnt_hi((unsigned)(bal >> 32), __builtin_amdgcn_mbcnt_lo((unsigned)bal, 0u));
        if (keep) list[pos] = k[j];
        run += (int)__builtin_popcountll(bal); }
    asm volatile("s_waitcnt lgkmcnt(0)" ::: "memory");
    return prefix;
}

typedef short v4i16_t __attribute__((ext_vector_type(4)));
__device__ __forceinline__ u32x2 lds_tr16(const LAS unsigned char* p) { return __builtin_bit_cast(u32x2, __builtin_amdgcn_ds_read_tr16_b64_v4i16((LAS v4i16_t*)p)); }
__device__ __forceinline__ float key_floor(unsigned th) {
    if (th == 0u) return -INFINITY;
    const unsigned u = th & 0xffffe000u; return __builtin_bit_cast(float, (u & 0x80000000u) ? (u & 0x7fffffffu) : ~u);
}
constexpr int DS_VROW = 288;

__device__ __forceinline__ void dsa_item(const Ctx& C, int b, int qt) {
    const ArgsP Ap = C.a;
    const bf16_t* P = (const bf16_t*)(Ap->ws + WS_P); bf16_t* Y = (bf16_t*)(Ap->ws + WS_Y);
    int lane_o = C.lane; asm volatile("" : "+v"(lane_o));
    const int lane = lane_o, w = C.wave, tid = w * 64 + lane, hl = lane >> 5, l32 = lane & 31, r16 = lane & 15, g4 = lane >> 4;
    const int t0 = qt * 32;
    const size_t mb = (size_t)b * SEQ;
    LAS unsigned* cand = (LAS unsigned*)(C.lds) + w * 4 * DS_CAP;
    LAS unsigned* hist = (LAS unsigned*)(C.lds + DS_HIST) + w * 256;
#if defined(SELFCHECK)
    unsigned* bad = (unsigned*)(Ap->ws + WS_CTL) + 16;
#else
    unsigned* bad = nullptr;
#endif
    bf16x8 af[4];
    { const int rho = l32; const int qq = 2 * ((rho >> 2) & 1) + (rho >> 4), hd = (rho & 3) + 4 * ((rho >> 3) & 1);
      const bf16_t* src = P + (mb + t0 + 4 * w + qq) * NIN + PQI + hd * 64 + 8 * hl;
#pragma unroll
      for (int s = 0; s < 4; ++s) af[s] = *(const bf16x8*)(src + 16 * s); }
    float wA[8], wB[8];
    { const bf16_t* ra = P + (mb + t0 + 4 * w + 2 * hl) * NIN + PWI; const u32x4 va = *(const u32x4*)ra, vb = *(const u32x4*)(ra + NIN);
#pragma unroll
      for (int i = 0; i < 4; ++i) { wA[2 * i] = bflo(va[i]); wA[2 * i + 1] = bfhi(va[i]); wB[2 * i] = bflo(vb[i]); wB[2 * i + 1] = bfhi(vb[i]); } }
    const int tA = t0 + 4 * w + 2 * hl, tB = tA + 1;
    int cnt0 = 0, cnt1 = 0, cnt2 = 0, cnt3 = 0; unsigned th0 = 0u, th1 = 0u, th2 = 0u, th3 = 0u;
    const int NT = (t0 + 32 + 63) >> 6;
    for (int rep_i = 0; rep_i < ((PROBE_DUP & 256) ? 2 : 1); ++rep_i) {
    cnt0 = cnt1 = cnt2 = cnt3 = 0; th0 = th1 = th2 = th3 = 0u;
    const bf16_t* kisrc = P + (mb + (tid >> 3)) * NIN + PKI + 8 * (tid & 7);
    LAS unsigned char* kib = C.lds + DS_KI; const int kiw = (tid >> 3) * DS_KIROW + (tid & 7) * 16;
    __syncthreads();
    { const u32x4 v = *(const u32x4*)kisrc; *(LAS u32x4*)(kib + kiw) = v; }
    __syncthreads();
#pragma unroll 1
    for (int kt = 0; kt < NT; ++kt) {
        u32x4 nxt = (u32x4){0u, 0u, 0u, 0u};
        if (kt + 1 < NT) nxt = *(const u32x4*)(kisrc + (size_t)(kt + 1) * 64 * NIN);
        if (cnt0 > DS_CAP - 64) { th0 = wave_select256(cand + 0 * DS_CAP, cnt0, hist, lane, bad); cnt0 = 256; }
        if (cnt1 > DS_CAP - 64) { th1 = wave_select256(cand + 1 * DS_CAP, cnt1, hist, lane, bad); cnt1 = 256; }
        if (cnt2 > DS_CAP - 64) { th2 = wave_select256(cand + 2 * DS_CAP, cnt2, hist, lane, bad); cnt2 = 256; }
        if (cnt3 > DS_CAP - 64) { th3 = wave_select256(cand + 3 * DS_CAP, cnt3, hist, lane, bad); cnt3 = 256; }
        const unsigned thA = hl ? th2 : th0, thB = hl ? th3 : th1;
        const float fA = key_floor(thA), fB = key_floor(thB);
        const LAS unsigned char* kb = kib + (kt & 1) * DS_KIBUF;
#pragma unroll
        for (int nt = 0; nt < 2; ++nt) {
            f32x16 c = {};
#pragma unroll
            for (int s = 0; s < 4; ++s) { const bf16x8 bfr = *(const LAS bf16x8*)(kb + (nt * 32 + l32) * DS_KIROW + (16 * s + 8 * hl) * 2);
                c = __builtin_amdgcn_mfma_f32_32x32x16_bf16(af[s], bfr, c, 0, 0, 0); }
            float sA = 0.f, sB = 0.f;
#pragma unroll
            for (int i = 0; i < 8; ++i) { sA = fmaf(fmaxf(c[i], 0.f), wA[i], sA); sB = fmaf(fmaxf(c[8 + i], 0.f), wB[i], sB); }
            const int sidx = kt * 64 + nt * 32 + l32;
            const bool cA = (sidx <= tA) && (sA >= fA), cB = (sidx <= tB) && (sB >= fB);
            if (__any(cA || cB)) {
                unsigned uA = __builtin_bit_cast(unsigned, sA), uB = __builtin_bit_cast(unsigned, sB);
                uA = (uA & 0x80000000u) ? ~uA : (uA | 0x80000000u); uB = (uB & 0x80000000u) ? ~uB : (uB | 0x80000000u);
                const unsigned keyA = (uA & 0xffffe000u) | (unsigned)(8191 - sidx), keyB = (uB & 0xffffe000u) | (unsigned)(8191 - sidx);
                const bool pA = cA && (keyA > thA), pB = cB && (keyB > thB);
                { const unsigned long long bal = __ballot(pA); const unsigned lo = (unsigned)bal, hi = (unsigned)(bal >> 32);
                  const int pos = hl ? (cnt2 + (int)__builtin_amdgcn_mbcnt_hi(hi, 0u)) : (cnt0 + (int)__builtin_amdgcn_mbcnt_lo(lo, 0u));
                  if (pA) cand[(hl ? 2 : 0) * DS_CAP + pos] = keyA;
                  cnt0 += __builtin_popcount(lo); cnt2 += __builtin_popcount(hi); }
                { const unsigned long long bal = __ballot(pB); const unsigned lo = (unsigned)bal, hi = (unsigned)(bal >> 32);
                  const int pos = hl ? (cnt3 + (int)__builtin_amdgcn_mbcnt_hi(hi, 0u)) : (cnt1 + (int)__builtin_amdgcn_mbcnt_lo(lo, 0u));
                  if (pB) cand[(hl ? 3 : 1) * DS_CAP + pos] = keyB;
                  cnt1 += __builtin_popcount(lo); cnt3 += __builtin_popcount(hi); }
            }
        }
        if (kt + 1 < NT) *(LAS u32x4*)(kib + ((kt + 1) & 1) * DS_KIBUF + kiw) = nxt;
        __syncthreads();
    }
    if (cnt0 > 256) { wave_select256(cand + 0 * DS_CAP, cnt0, hist, lane, bad); cnt0 = 256; }
    if (cnt1 > 256) { wave_select256(cand + 1 * DS_CAP, cnt1, hist, lane, bad); cnt1 = 256; }
    if (cnt2 > 256) { wave_select256(cand + 2 * DS_CAP, cnt2, hist, lane, bad); cnt2 = 256; }
    if (cnt3 > 256) { wave_select256(cand + 3 * DS_CAP, cnt3, hist, lane, bad); cnt3 = 256; }
    }
    { u32x4 t1 = *(const LAS u32x4*)(cand + 1 * DS_CAP + 4 * lane), t2 = *(const LAS u32x4*)(cand + 2 * DS_CAP + 4 * lane), t3 = *(const LAS u32x4*)(cand + 3 * DS_CAP + 4 * lane);
      *(LAS u32x4*)(cand + 256 + 4 * lane) = t1; *(LAS u32x4*)(cand + 512 + 4 * lane) = t2; *(LAS u32x4*)(cand + 768 + 4 * lane) = t3; }
    LAS unsigned char* vt = (LAS unsigned char*)(cand + 1024);
#pragma unroll 1
    for (int qq_i = 0; qq_i < ((PROBE_DUP & 512) ? 8 : 4); ++qq_i) {
        const int qq = qq_i & 3;
        const int nsel = qq == 0 ? cnt0 : qq == 1 ? cnt1 : qq == 2 ? cnt2 : cnt3;
        const LAS unsigned* lst = cand + qq * 256;
        const size_t mq = mb + t0 + 4 * w + qq;
        const bf16_t* qrow = P + mq * NIN + PQ;
        bf16x8 bq0[2], bq1[2];
#pragma unroll
        for (int s = 0; s < 2; ++s) { bq0[s] = (bf16x8){0, 0, 0, 0, 0, 0, 0, 0}; bq1[s] = bq0[s];
            if (r16 < 8) { const bf16x8 v = *(const bf16x8*)(qrow + r16 * 64 + 32 * s + 8 * g4); if (r16 < 4) bq0[s] = v; else bq1[s] = v; } }
        u32x4 vg[8];
        const bf16_t* vsrc = P + mb * NIN + PV + 8 * r16;
#pragma unroll
        for (int j = 0; j < 8; ++j) { const int idx = 8191 - (int)(lst[g4 + 4 * j] & 8191u); vg[j] = *(const u32x4*)(vsrc + (size_t)idx * NIN); }
        f32x4 sc[16];
#pragma unroll
        for (int kt = 0; kt < 16; ++kt) {
            const int idx = 8191 - (int)(lst[16 * kt + r16] & 8191u);
            const bf16_t* krow = P + (mb + idx) * NIN + PK + 8 * g4;
            const bf16x8 k00 = *(const bf16x8*)krow, k01 = *(const bf16x8*)(krow + 32), k10 = *(const bf16x8*)(krow + 64), k11 = *(const bf16x8*)(krow + 96);
            f32x4 c = {0.f, 0.f, 0.f, 0.f};
            c = __builtin_amdgcn_mfma_f32_16x16x32_bf16(k00, bq0[0], c, 0, 0, 0); c = __builtin_amdgcn_mfma_f32_16x16x32_bf16(k01, bq0[1], c, 0, 0, 0);
            c = __builtin_amdgcn_mfma_f32_16x16x32_bf16(k10, bq1[0], c, 0, 0, 0); c = __builtin_amdgcn_mfma_f32_16x16x32_bf16(k11, bq1[1], c, 0, 0, 0);
            sc[kt] = c;
        }
        if (nsel < 256) {
#pragma unroll
            for (int kt = 0; kt < 16; ++kt)
#pragma unroll
                for (int rg = 0; rg < 4; ++rg) if (16 * kt + 4 * g4 + rg >= nsel) sc[kt][rg] = -INFINITY;
        }
        float mx = -INFINITY;
#pragma unroll
        for (int kt = 0; kt < 16; ++kt) mx = fmaxf(fmaxf(mx, fmaxf(sc[kt][0], sc[kt][1])), fmaxf(sc[kt][2], sc[kt][3]));
        mx = fmaxf(mx, __shfl_xor(mx, 16)); mx = fmaxf(mx, __shfl_xor(mx, 32));
        float sm = 0.f;
#pragma unroll
        for (int kt = 0; kt < 16; ++kt)
#pragma unroll
            for (int rg = 0; rg < 4; ++rg) { const float p = __expf(sc[kt][rg] - mx); sc[kt][rg] = p; sm += p; }
        sm += __shfl_xor(sm, 16); sm += __shfl_xor(sm, 32);
        const float inv = 1.f / sm;
        u32x4 pb[8];
#pragma unroll
        for (int s = 0; s < 8; ++s) { pb[s].x = pk2(sc[2 * s][0], sc[2 * s][1]); pb[s].y = pk2(sc[2 * s][2], sc[2 * s][3]); pb[s].z = pk2(sc[2 * s + 1][0], sc[2 * s + 1][1]); pb[s].w = pk2(sc[2 * s + 1][2], sc[2 * s + 1][3]); }
        const bool isg0 = r16 < 4, isg1 = (r16 >= 4) && (r16 < 8);
        f32x4 o[4];
#pragma unroll
        for (int mt = 0; mt < 4; ++mt) o[mt] = (f32x4){0.f, 0.f, 0.f, 0.f};
        const int trb = (4 * g4 + (r16 >> 2)) * DS_VROW + 8 * (r16 & 3);
#pragma unroll 1
        for (int s = 0; s < 8; ++s) {
#pragma unroll
            for (int j = 0; j < 8; ++j) *(LAS u32x4*)(vt + (g4 + 4 * j) * DS_VROW + r16 * 16) = vg[j];
            if (s + 1 < 8) {
#pragma unroll
                for (int j = 0; j < 8; ++j) { const int idx = 8191 - (int)(lst[32 * (s + 1) + g4 + 4 * j] & 8191u); vg[j] = *(const u32x4*)(vsrc + (size_t)idx * NIN); } }
            const u32x4 z4 = {0u, 0u, 0u, 0u};
            const u32x4 ps = pb[s];
            const bf16x8 p0 = __builtin_bit_cast(bf16x8, isg0 ? ps : z4), p1 = __builtin_bit_cast(bf16x8, isg1 ? ps : z4);
#pragma unroll
            for (int mt = 0; mt < 4; ++mt) {
                const u32x2 a00 = lds_tr16(vt + trb + mt * 32), a01 = lds_tr16(vt + trb + 16 * DS_VROW + mt * 32);
                const u32x2 a10 = lds_tr16(vt + trb + 128 + mt * 32), a11 = lds_tr16(vt + trb + 16 * DS_VROW + 128 + mt * 32);
                const u32x4 A0 = {a00.x, a00.y, a01.x, a01.y}, A1 = {a10.x, a10.y, a11.x, a11.y};
                o[mt] = __builtin_amdgcn_mfma_f32_16x16x32_bf16(__builtin_bit_cast(bf16x8, A0), p0, o[mt], 0, 0, 0);
                o[mt] = __builtin_amdgcn_mfma_f32_16x16x32_bf16(__builtin_bit_cast(bf16x8, A1), p1, o[mt], 0, 0, 0);
            }
        }
        if (r16 < 8) {
#pragma unroll
            for (int mt = 0; mt < 4; ++mt) { u32x2 ov; ov.x = pk2(o[mt][0] * inv, o[mt][1] * inv); ov.y = pk2(o[mt][2] * inv, o[mt][3] * inv);
                *(u32x2*)(Y + mq * DM + r16 * 64 + 16 * mt + 4 * g4) = ov; }
        }
    }
}

__device__ __forceinline__ void mixers_phase(const Ctx& C, int l) {
    const ArgsP Ap = C.a;
    unsigned* ctl = (unsigned*)(Ap->ws + WS_CTL);
    const int sub = Ap->sub;
    if (sub < 0 || sub == 0)
    for (int it = C.bid; it < 2048; it += C.G) { if (PROBE_DUP & 2) chunk_item<0, false>(C, l, it & 15, it >> 4); chunk_item<0>(C, l, it & 15, it >> 4); }
    if ((sub < 0 || sub == 1) && C.bid < 64) chunk_phaseB(C, l, C.bid >> 2, C.bid & 3);
    if (!(sub < 0 || sub == 2)) return;
    unsigned* work = ctl + CW_WORK + 64 * l;
    volatile LAS unsigned* misc = (volatile LAS unsigned*)(C.lds + LDS_MISC);
    bool bready = false;
    for (;;) {
        __syncthreads();
        if (C.tid == 0) misc[0] = __hip_atomic_fetch_add(work, 1u, __ATOMIC_RELAXED, __HIP_MEMORY_SCOPE_AGENT);
        __syncthreads();
        const int it = (int)misc[0];
        if (it >= 512 + 2048) break;
        if (it < 512) { dsa_item(C, it & 1, 255 - (it >> 1)); if (PROBE_DUP & 1) dsa_item(C, it & 1, 255 - (it >> 1)); continue; }
        if (!bready) {
            if (C.tid == 0) { unsigned sp = 0; for (;;) { unsigned ok = 1u;
                    for (int c = 0; c < 16; ++c) ok &= (__hip_atomic_load(ctl + CW_FLAGB + 64 * (16 * l + c), __ATOMIC_RELAXED, __HIP_MEMORY_SCOPE_AGENT) >= 4u) ? 1u : 0u;
                    if (ok || ++sp > (1u << 24)) break; __builtin_amdgcn_s_sleep(2); }
                __builtin_amdgcn_fence(__ATOMIC_ACQUIRE, "agent"); asm volatile("s_waitcnt vmcnt(0)" ::: "memory"); }
            __syncthreads(); bready = true; }
        const int ci = it - 512;
        chunk_item<1>(C, l, ci & 15, ci >> 4);
        if (PROBE_DUP & 4) chunk_item<1>(C, l, ci & 15, ci >> 4);
    }
    __syncthreads();
}

constexpr int NPHASE = 18;
__global__ void __launch_bounds__(512, 2) fwd_kernel(Args args_unused) {
    extern __shared__ __attribute__((aligned(16))) unsigned char lds_raw[];
    ArgsP ap0 = (ArgsP)__builtin_amdgcn_kernarg_segment_ptr();
    Ctx C; C.lds = (LAS unsigned char*)lds_raw; C.tid = threadIdx.x; C.lane = C.tid & 63; C.wave = __builtin_amdgcn_readfirstlane(C.tid >> 6); C.G = gridDim.x; C.bid = blockIdx.x; C.a = ap0;
    volatile LAS unsigned* misc = (volatile LAS unsigned*)(C.lds + LDS_MISC);
    if (C.tid < 64) misc[C.tid] = 0u;
    __syncthreads();
    const int ph_lo = ap0->ph_lo, ph_hi = ap0->ph_hi;
    XcdBarrier bar; bar.bar = (unsigned*)(ap0->ws + WS_CTL) + CW_BAR; bar.x = 0; bar.st = nullptr;
    const bool fused = (ph_hi - ph_lo) > 1;
    if (fused) bar = xcd_barrier_post((unsigned*)(ap0->ws + WS_CTL) + CW_BAR, misc + 8);
#ifndef PHASE_MASK
#define PHASE_MASK 0x3ff
#endif
#define PM(k) ((PHASE_MASK >> (k)) & 1)
    for (int ph = ph_lo; ph < ph_hi; ++ph) {
        { int t_ = threadIdx.x; asm volatile("" : "+v"(t_)); C.tid = t_; C.lane = t_ & 63; C.wave = __builtin_amdgcn_readfirstlane(t_ >> 6); }
        ArgsP ap = (ArgsP)__builtin_amdgcn_kernarg_segment_ptr(); asm volatile("" : "+s"(ap)); C.a = ap;
        unsigned char* ws = ap->ws; unsigned char* wb = ws + WS_W;
        bf16_t* XBF = (bf16_t*)(ws + WS_XBF); bf16_t* ACT = (bf16_t*)(ws + WS_ACT); bf16_t* PB = (bf16_t*)(ws + WS_P); bf16_t* YB = (bf16_t*)(ws + WS_Y);
        float* SSQA = (float*)(ws + WS_SSQ); float* SSQB = SSQA + (size_t)MTOK * 16; float* SSQC = SSQB + (size_t)MTOK * 16;
        if (ph == 0) { if (PM(9)) { convert_layer_weights(C, 0); prologue_x(C); if (PROBE_DUP & 32) { __syncthreads(); convert_layer_weights(C, 0); prologue_x(C); } } }
        else {
            const int l = (ph - 1) / 9, sp = (ph - 1) % 9;
            pg8::StaticOrder S;
            switch (sp) {
            case 0: if (PM(0)) { pg8::Gemm g{XBF, (const bf16_t*)(wb + W_GU1), MTOK, NGU, DM}; S.init(MTOK, NGU, C.G, C.bid); pg8::EpiFfnUp E{ACT, SSQA};
                      pg8::gemm_phase<pg8::EpiFfnUp, pg8::StaticOrder, true, true>(C.lds, g, S, E, C.tid); } break;
            case 1: if (PM(1)) { pg8::Gemm g{ACT, (const bf16_t*)(wb + W_D1), MTOK, DM, FF}; S.init(MTOK, DM, C.G, C.bid); pg8::EpiResid E{l == 0 ? ap->in[I_X] : ap->out, ap->out, XBF, SSQB, 0.5f};
                      pg8::gemm_phase<pg8::EpiResid, pg8::StaticOrder, true, true>(C.lds, g, S, E, C.tid); } break;
            case 2: if (PM(2)) { pg8::Gemm g{XBF, (const bf16_t*)(wb + W_IN), MTOK, NIN, DM}; S.init(MTOK, NIN, C.G, C.bid); pg8::EpiRowScaleBf16 E{PB, NIN, SSQB};
                      pg8::gemm_phase<pg8::EpiRowScaleBf16, pg8::StaticOrder, true, true>(C.lds, g, S, E, C.tid); } break;
            case 3: if (PM(3)) prep_phase(C, l); break;
            case 4: if (PM(4)) mixers_phase(C, l); break;
            case 5: if (PM(5)) { pg8::Gemm g{YB, (const bf16_t*)(wb + W_OUT), MTOK, DM, DM}; S.init(MTOK, DM, C.G, C.bid); pg8::EpiResid E{ap->out, ap->out, XBF, SSQC, 1.0f};
                      pg8::gemm_phase<pg8::EpiResid, pg8::StaticOrder, true, true>(C.lds, g, S, E, C.tid); } break;
            case 6: if (PM(6)) { pg8::Gemm g{XBF, (const bf16_t*)(wb + W_GU2), MTOK, NGU, DM}; S.init(MTOK, NGU, C.G, C.bid); pg8::EpiFfnUp E{ACT, SSQC};
                      pg8::gemm_phase<pg8::EpiFfnUp, pg8::StaticOrder, true, true>(C.lds, g, S, E, C.tid); } break;
            case 7: if (PM(7)) { pg8::Gemm g{ACT, (const bf16_t*)(wb + W_D2), MTOK, DM, FF}; S.init(MTOK, DM, C.G, C.bid); pg8::EpiResid E{ap->out, ap->out, XBF, SSQA, 0.5f};
                      pg8::gemm_phase<pg8::EpiResid, pg8::StaticOrder, true, true>(C.lds, g, S, E, C.tid); } break;
            case 8: if (PM(8)) convert_layer_weights(C, l + 1); break;
            }
        }
        if (ph + 1 < ph_hi) xcd_barrier(bar);
    }
#if defined(SELFCHECK)
    if (C.bid == 0 && threadIdx.x == 0 && ph_hi == NPHASE) { if (__hip_atomic_load((unsigned*)(ap0->ws + WS_CTL) + 16, __ATOMIC_RELAXED, __HIP_MEMORY_SCOPE_AGENT) != 0u) ap0->out[0] = __builtin_nanf(""); }
#endif
}

extern "C" void kernel_launch(void* const* d_in, const int* in_sizes, int n_in, void* d_out, int out_size, void* d_ws, size_t ws_size, hipStream_t stream) {
    static int grid = 0;
    if (grid == 0) {
        if (n_in != 28 || out_size != MTOK * DM || ws_size < WS_END) { fprintf(stderr, "kernel_launch: unexpected shapes (n_in %d out %d ws %zu)\n", n_in, out_size, ws_size); grid = -1; return; }
        int dev = 0, cus = 0, per_cu = 0;
        if (hipGetDevice(&dev) != hipSuccess || hipDeviceGetAttribute(&cus, hipDeviceAttributeMultiprocessorCount, dev) != hipSuccess) { grid = -1; return; }
        if (hipFuncSetAttribute((const void*)fwd_kernel, hipFuncAttributeMaxDynamicSharedMemorySize, LDS_BYTES) != hipSuccess) { fprintf(stderr, "kernel_launch: hipFuncSetAttribute failed\n"); grid = -1; return; }
        if (hipOccupancyMaxActiveBlocksPerMultiprocessor(&per_cu, (const void*)fwd_kernel, 512, LDS_BYTES) != hipSuccess || per_cu < 1) { fprintf(stderr, "kernel_launch: occupancy query says %d\n", per_cu); per_cu = 1; }
        (void)hipGetLastError();
        grid = cus;
    }
    if (grid < 0) return;
    (void)hipMemsetAsync((char*)d_ws + WS_CTL, 0, CTL_ZERO_BYTES, stream);
    Args a{};
    for (int i = 0; i < 28; ++i) a.in[i] = (const float*)d_in[i];
    a.out = (float*)d_out; a.ws = (unsigned char*)d_ws; a.sub = -1;
#if MK_N_LAUNCHES == 1
    a.ph_lo = 0; a.ph_hi = NPHASE;
    void* kargs[] = {&a};
    hipError_t e = hipLaunchCooperativeKernel((const void*)fwd_kernel, dim3(grid), dim3(512), kargs, LDS_BYTES, stream);
    if (e != hipSuccess) fprintf(stderr, "kernel_launch: cooperative launch failed: %s\n", hipGetErrorString(e));
#else
#ifndef PROBE_PH_DUP
#define PROBE_PH_DUP 0
#endif
#ifndef PROBE_SUB_DUP
#define PROBE_SUB_DUP 0
#endif
    for (int ph = 0; ph < NPHASE; ++ph) { a.ph_lo = ph; a.ph_hi = ph + 1;
        if (ph > 0 && (ph - 1) % 9 == 4) {
            if (PROBE_SUB_DUP & 8) { a.sub = 0; hipLaunchKernelGGL(fwd_kernel, dim3(grid), dim3(512), LDS_BYTES, stream, a); a.sub = 1; hipLaunchKernelGGL(fwd_kernel, dim3(grid), dim3(512), LDS_BYTES, stream, a); }
            for (int sb = 0; sb < 3; ++sb) { a.sub = sb; hipLaunchKernelGGL(fwd_kernel, dim3(grid), dim3(512), LDS_BYTES, stream, a);
                if ((PROBE_SUB_DUP >> sb) & 1) { if (sb == 2) (void)hipMemsetAsync((char*)d_ws + WS_CTL + CW_WORK * 4, 0, 1024, stream); hipLaunchKernelGGL(fwd_kernel, dim3(grid), dim3(512), LDS_BYTES, stream, a); } }
            a.sub = -1; continue; }
        hipLaunchKernelGGL(fwd_kernel, dim3(grid), dim3(512), LDS_BYTES, stream, a);
        if ((PROBE_PH_DUP >> ph) & 1) { (void)hipMemsetAsync((char*)d_ws + WS_CTL, 0, CTL_ZERO_BYTES, stream); hipLaunchKernelGGL(fwd_kernel, dim3(grid), dim3(512), LDS_BYTES, stream, a); } }
#endif
}
```

```cpp
#include <hip/hip_runtime.h>
#include <cstdio>
#include <cstdint>


#ifndef PROBE_FORCE_REDO
#define PROBE_FORCE_REDO 0
#endif
#ifndef PROBE_STAT_OFF
#define PROBE_STAT_OFF 0
#endif
#ifndef PROBE_STAT
#define PROBE_STAT -1
#endif
#define TS_NOW() (PROBE_STAT >= 0 ? __builtin_amdgcn_s_memrealtime() : 0ull)
#ifndef PROBE_CK
#define PROBE_CK 0
#endif
#ifndef PROBE_DUP
#define PROBE_DUP 0
#endif
#ifndef MK_N_LAUNCHES
#define MK_N_LAUNCHES 1
#endif

#define LAS __attribute__((address_space(3)))
#define GAS __attribute__((address_space(1)))
typedef unsigned short bf16_t;
typedef short bf16x8 __attribute__((ext_vector_type(8)));
typedef float f32x4 __attribute__((ext_vector_type(4)));
typedef float f32x16 __attribute__((ext_vector_type(16)));
typedef float f32x2 __attribute__((ext_vector_type(2)));
typedef unsigned u32x4 __attribute__((ext_vector_type(4)));
typedef unsigned u32x2 __attribute__((ext_vector_type(2)));

constexpr int BATCH = 2, SEQ = 8192, DM = 1024, FF = 2816, MTOK = BATCH * SEQ;
constexpr int NGU = 2 * FF;
constexpr int NIN = 3328;
constexpr int PQ = 0, PK = 512, PV = 640, PQI = 768, PKI = 1280, PWI = 1344, PGB = 1352, PGA = 1356;
constexpr int PRW = 1408;
constexpr int PGD = 2304;
constexpr float NORM_EPS = 1e-6f;

constexpr size_t MiB = 1u << 20;
constexpr size_t WS_CTL = 0, CTL_ZERO_BYTES = 64 * 1024;
constexpr size_t WS_ROPE = 64 * 1024;
constexpr size_t WS_LORA = 2 * MiB + 128 * 1024;
constexpr size_t WS_W = 3 * MiB;
constexpr size_t W_GU1 = 0, W_D1 = 11 * MiB, W_IN = W_D1 + 5632 * 1024, W_OUT = W_IN + (size_t)NIN * DM * 2, W_GU2 = W_OUT + 2 * MiB, W_D2 = W_GU2 + 11 * MiB, W_END = W_D2 + 5632 * 1024;
constexpr size_t WS_XBF = 45 * MiB;
constexpr size_t WS_BIG = 77 * MiB;
constexpr size_t WS_P = WS_BIG, WS_Y = WS_BIG + 104 * MiB, WS_ACT = WS_BIG;
constexpr size_t WS_SSQ = 213 * MiB;
constexpr size_t WS_VF = 216 * MiB;
constexpr size_t WS_END = 224 * MiB;
static_assert(W_END <= 42 * MiB && WS_W + W_END <= WS_XBF && WS_Y + 32 * MiB <= WS_SSQ, "ws map");

constexpr int CW_BAR = 1024;
constexpr int CW_WORK = 8192;

constexpr int LDS_MISC = 154 * 1024;
constexpr int LDS_BYTES = 155 * 1024;

typedef __bf16 hwbf16x2 __attribute__((ext_vector_type(2)));
__device__ __forceinline__ unsigned pk2(float lo, float hi) { const f32x2 v = {lo, hi}; return __builtin_bit_cast(unsigned, __builtin_convertvector(v, hwbf16x2)); }
__device__ __forceinline__ unsigned f2bf(float f) { return pk2(f, 0.f) & 0xffffu; }
__device__ __forceinline__ float bf2f(unsigned short h) { return __builtin_bit_cast(float, (unsigned)h << 16); }
__device__ __forceinline__ float bflo(unsigned w) { return __builtin_bit_cast(float, w << 16); }
__device__ __forceinline__ float bfhi(unsigned w) { return __builtin_bit_cast(float, w & 0xffff0000u); }
__device__ __forceinline__ float wave_sum_shfl(float v) {
#pragma unroll
    for (int o = 1; o < 64; o <<= 1) v += __shfl_xor(v, o);
    return v;
}
__device__ __forceinline__ float dpp_f(float v, int ctrl_quad  ) { return v; }
#define DPP_ADD(v, ctrl) v += __builtin_bit_cast(float, __builtin_amdgcn_update_dpp(0, __builtin_bit_cast(int, v), ctrl, 0xf, 0xf, true))
__device__ __forceinline__ float wave_sum(float v) {
    DPP_ADD(v, 0xB1); DPP_ADD(v, 0x4E); DPP_ADD(v, 0x141); DPP_ADD(v, 0x140);
    const int vi = __builtin_bit_cast(int, v);
    return (__builtin_bit_cast(float, __builtin_amdgcn_readlane(vi, 0)) + __builtin_bit_cast(float, __builtin_amdgcn_readlane(vi, 16))) +
           (__builtin_bit_cast(float, __builtin_amdgcn_readlane(vi, 32)) + __builtin_bit_cast(float, __builtin_amdgcn_readlane(vi, 48)));
}
__device__ __forceinline__ float dpp_mov_f(float v, int ctrl_b1_or_4e) { return v; }
#define DPP_GET(v, ctrl) __builtin_bit_cast(float, __builtin_amdgcn_update_dpp(0, __builtin_bit_cast(int, v), ctrl, 0xf, 0xf, true))
__device__ __forceinline__ void wave_sum8(const float (&v)[8], float (&s)[8], int lane) {
    const bool b0 = (lane & 1) != 0, b1 = (lane & 2) != 0, b2 = (lane & 4) != 0;
    float w[4], x[2];
#pragma unroll
    for (int i = 0; i < 4; ++i) { const float keep = b0 ? v[2 * i + 1] : v[2 * i], send = b0 ? v[2 * i] : v[2 * i + 1]; w[i] = keep + DPP_GET(send, 0xB1); }
#pragma unroll
    for (int i = 0; i < 2; ++i) { const float keep = b1 ? w[2 * i + 1] : w[2 * i], send = b1 ? w[2 * i] : w[2 * i + 1]; x[i] = keep + DPP_GET(send, 0x4E); }
    const float keep = b2 ? x[1] : x[0], send = b2 ? x[0] : x[1];
    float y = keep + __shfl_xor(send, 4);
    y += __shfl_xor(y, 8); y += __shfl_xor(y, 16); y += __shfl_xor(y, 32);
    const int yi = __builtin_bit_cast(int, y);
#pragma unroll
    for (int t = 0; t < 8; ++t) s[t] = __builtin_bit_cast(float, __builtin_amdgcn_readlane(yi, t));
}
__device__ __forceinline__ float sigmoidf_(float x) { return __builtin_amdgcn_rcpf(1.f + __expf(-x)); }
__device__ __forceinline__ float siluf_(float x) { return x * __builtin_amdgcn_rcpf(1.f + __expf(-x)); }
__device__ __forceinline__ float softplusf_(float x) { return x > 20.f ? x : __logf(1.f + __expf(x)); }

namespace pg8 {
constexpr int BM = 256, BK = 64, HALF = 128, HTB = HALF * BK * 2, STAGE_BYTES = 8 * HTB, NXCD = 8, WGM = 8;
__host__ __device__ __forceinline__ int lds_byte(int r, int c) { const int st = (r >> 4) * 2 + (c >> 5), rr = r & 15, cc = c & 31, ob = rr * 64 + cc * 2; return st * 1024 + (ob ^ (((ob >> 9) & 1) << 5)); }
__host__ __device__ __forceinline__ void stage_rc(int b, int& R, int& C) { const int st = b / 1024, sb = b % 1024, swz = sb ^ (((sb >> 9) & 1) << 5); R = (st >> 1) * 16 + swz / 64; C = (st & 1) * 32 + (swz % 64) / 2; }
__host__ __device__ __forceinline__ int perm32(int rho) { const int n = rho >> 4, i = rho & 15; return 8 * (i >> 2) + 4 * n + (i & 3); }
struct Unit { int pm, pn, ui; };
struct Gemm { const bf16_t* A; const bf16_t* Bt; int M, N, K; };
struct StaticOrder {
    int nM, nN, nwg, G, c;
    __host__ __device__ void init(int M, int N, int G_, int c_) { nM = M / BM; nN = N / BM; nwg = nM * nN; G = G_; c = c_; }
    __host__ __device__ bool next(int i, Unit& u) const {
        const long L = (long)i * G + c; if (L >= nwg) return false;
        int wgid = (int)L; { const int q = nwg / NXCD, r = nwg % NXCD, xcd = wgid % NXCD, off = wgid / NXCD; wgid = (xcd < r ? xcd * (q + 1) : r * (q + 1) + (xcd - r) * q) + off; }
        const int nig = WGM * nN, gid = wgid / nig, fm = gid * WGM, gsz = (nM - fm) < WGM ? (nM - fm) : WGM;
        u.pm = fm + ((wgid % nig) % gsz); u.pn = (wgid % nig) / gsz; u.ui = i; return true;
    }
};
__device__ __forceinline__ unsigned cvt_pk_bf16(float lo, float hi) { unsigned r; asm volatile("v_cvt_pk_bf16_f32 %0, %1, %2" : "=v"(r) : "v"(lo), "v"(hi)); return r; }

constexpr int RSTD_TAB_OFF = 128 * 1024;
template <class Sched>
__device__ __forceinline__ void rstd_table_fill(LAS unsigned char* lds, const float* ssq, const Sched& S, int tid) {
    LAS float* tab = (LAS float*)(lds + RSTD_TAB_OFF);
    Unit u;
    for (int ui = tid >> 8; S.next(ui, u); ui += 2) {
        const int row = u.pm * BM + (tid & 255);
        const f32x4* p = (const f32x4*)(ssq + (size_t)row * 16);
        const f32x4 a = p[0], b = p[1], c = p[2], d = p[3];
        const float s = ((a[0] + a[1]) + (a[2] + a[3])) + ((b[0] + b[1]) + (b[2] + b[3])) + ((c[0] + c[1]) + (c[2] + c[3])) + ((d[0] + d[1]) + (d[2] + d[3]));
        tab[ui * 256 + (tid & 255)] = rsqrtf(s * (1.0f / DM) + NORM_EPS);
    }
    __syncthreads();
}
__device__ __forceinline__ float row_rstd(const LAS float* tab, const Unit& u, int rloc) { return tab[u.ui * 256 + rloc]; }
struct EpiFfnUp {
    static constexpr bool PERM = true;
    bf16_t* O; const LAS float* tab;
    __device__ __forceinline__ void operator()(const f32x4 (&acc)[2][2][4][2], const Unit& u, int wr, int wc, int fr, int fq) const {
        const int row0 = u.pm * BM + wr * 64 + fr; const int col0 = u.pn * HALF + wc * 32 + 8 * fq;
#pragma unroll
        for (int ai = 0; ai < 2; ++ai)
#pragma unroll
            for (int m = 0; m < 4; ++m) { const int row = row0 + ai * HALF + m * 16; const float rs = row_rstd(tab, u, wr * 64 + fr + ai * HALF + m * 16);
                float o[8];
#pragma unroll
                for (int n = 0; n < 2; ++n)
#pragma unroll
                    for (int e = 0; e < 4; ++e) { const float g = acc[ai][0][m][n][e] * rs, up = acc[ai][1][m][n][e] * rs;
                        o[n * 4 + e] = g * __builtin_amdgcn_rcpf(1.f + __builtin_amdgcn_exp2f(-1.4426950408889634f * g)) * up; }
                u32x4 w; w.x = cvt_pk_bf16(o[0], o[1]); w.y = cvt_pk_bf16(o[2], o[3]); w.z = cvt_pk_bf16(o[4], o[5]); w.w = cvt_pk_bf16(o[6], o[7]);
                *(u32x4*)(O + (size_t)row * FF + col0) = w; }
    }
};
struct EpiRowScaleBf16 {
    static constexpr bool PERM = true;
    bf16_t* O; int ldc; const LAS float* tab;
    __device__ __forceinline__ void operator()(const f32x4 (&acc)[2][2][4][2], const Unit& u, int wr, int wc, int fr, int fq) const {
        const int row0 = u.pm * BM + wr * 64 + fr; const int col0 = u.pn * BM + wc * 32 + 8 * fq;
#pragma unroll
        for (int ai = 0; ai < 2; ++ai)
#pragma unroll
            for (int m = 0; m < 4; ++m) { const int row = row0 + ai * HALF + m * 16; const float rs = row_rstd(tab, u, wr * 64 + fr + ai * HALF + m * 16);
#pragma unroll
                for (int bj = 0; bj < 2; ++bj) { const f32x4 v0 = acc[ai][bj][m][0] * rs, v1 = acc[ai][bj][m][1] * rs;
                    u32x4 w; w.x = cvt_pk_bf16(v0[0], v0[1]); w.y = cvt_pk_bf16(v0[2], v0[3]); w.z = cvt_pk_bf16(v1[0], v1[1]); w.w = cvt_pk_bf16(v1[2], v1[3]);
                    *(u32x4*)(O + (size_t)row * ldc + col0 + bj * HALF) = w; } }
    }
};
struct EpiResid {
    static constexpr bool PERM = false;
    const bf16_t* xin; bf16_t* xbf; bf16_t* xcopy; float* xf32; float* ssq; float alpha;
    __device__ __forceinline__ void operator()(const f32x4 (&acc)[2][2][4][2], const Unit& u, int wr, int wc, int fr, int fq) const {
        const int row0 = u.pm * BM + wr * 64 + fr; const int col0 = u.pn * BM + wc * 32 + 4 * fq;
#pragma unroll
        for (int ai = 0; ai < 2; ++ai) {
            u32x2 xi[4][2][2];
#pragma unroll
            for (int m = 0; m < 4; ++m)
#pragma unroll
                for (int bj = 0; bj < 2; ++bj)
#pragma unroll
                    for (int n = 0; n < 2; ++n) xi[m][bj][n] = *(const u32x2*)(xin + (size_t)(row0 + ai * HALF + m * 16) * DM + col0 + bj * HALF + n * 16);
            __builtin_amdgcn_sched_barrier(0);
#pragma unroll
            for (int m = 0; m < 4; ++m) { const int row = row0 + ai * HALF + m * 16; const size_t off = (size_t)row * DM + col0; float s = 0.f;
#pragma unroll
                for (int bj = 0; bj < 2; ++bj)
#pragma unroll
                    for (int n = 0; n < 2; ++n) { const size_t o2 = off + bj * HALF + n * 16; const u32x2 xb = xi[m][bj][n];
                        const f32x4 xo = {__builtin_bit_cast(float, xb.x << 16), __builtin_bit_cast(float, xb.x & 0xffff0000u), __builtin_bit_cast(float, xb.y << 16), __builtin_bit_cast(float, xb.y & 0xffff0000u)};
                        const f32x4 v = xo + acc[ai][bj][m][n] * alpha;
                        u32x2 w; w.x = cvt_pk_bf16(v[0], v[1]); w.y = cvt_pk_bf16(v[2], v[3]); if (xbf) *(u32x2*)(xbf + o2) = w;
                        if (xcopy) *(u32x2*)(xcopy + o2) = w;
                        if (xf32) *(f32x4*)(xf32 + o2) = v;
                        s += (v[0] * v[0] + v[1] * v[1]) + (v[2] * v[2] + v[3] * v[3]); }
                s += __shfl_xor(s, 16); s += __shfl_xor(s, 32);
                if (fq == 0 && ssq) ssq[(size_t)row * 16 + u.pn * 4 + wc] = s; }
            __builtin_amdgcn_sched_barrier(0);
        }
    }
};

template <class Epi, class Sched, bool ALIGN_EPI = false, bool SP2 = false>
__device__ __forceinline__ void gemm_phase(LAS unsigned char* lds, const Gemm g, const Sched& S, const Epi& E, const int tid) {
    const int wid = __builtin_amdgcn_readfirstlane(tid >> 6), lane = tid & 63, wr = wid >> 2, wc = wid & 3, fr = lane & 15, fq = lane >> 4;
    const int K = g.K, nt = K / BK;
    unsigned voffA[2], voffB[2];
#pragma unroll
    for (int i = 0; i < 2; ++i) { int R, C; stage_rc(tid * 16 + i * 8192, R, C); const int Rb = Epi::PERM ? ((R & ~31) + perm32(R & 31)) : R;
        voffA[i] = (unsigned)(R * K + C) * 2u; voffB[i] = (unsigned)(Rb * K + C) * 2u; }
    const size_t kstep = (size_t)(BK * 2);
    const size_t hstep = (size_t)HALF * K * 2;
    const size_t tstep = 2 * hstep;
    const unsigned ldsw = (unsigned)wid * 1024u;
    const int aoff = lds_byte(wr * 64 + fr, fq * 8), boff = lds_byte(wc * 32 + fr, fq * 8);
#define PG8_SA(b, h) (((b) * 2 + (h)) * HTB)
#define PG8_SB(b, h) ((4 + (b) * 2 + (h)) * HTB)
#define PG8_STAGE(bufoff, gbase, voff) do { _Pragma("unroll") for (int _i = 0; _i < 2; ++_i) \
        __builtin_amdgcn_global_load_lds((const unsigned*)((const char*)(gbase) + (voff)[_i]), (LAS unsigned*)(lds + (bufoff) + ldsw + _i * 8192), 16, 0, 0); } while (0)
#define PG8_LDA(dst, b, h) do { _Pragma("unroll") for (int m = 0; m < 4; ++m) _Pragma("unroll") for (int k = 0; k < 2; ++k) dst[m][k] = *(const LAS bf16x8*)(lds + PG8_SA(b, h) + aoff + m * 2048 + k * 1024); } while (0)
#define PG8_LDB(dst, b, h) do { _Pragma("unroll") for (int n = 0; n < 2; ++n) _Pragma("unroll") for (int k = 0; k < 2; ++k) dst[n][k] = *(const LAS bf16x8*)(lds + PG8_SB(b, h) + boff + n * 2048 + k * 1024); } while (0)
#define PG8_MMA(ai, bj, At, Bt) do { __builtin_amdgcn_s_setprio(1); _Pragma("unroll") for (int m = 0; m < 4; ++m) _Pragma("unroll") for (int n = 0; n < 2; ++n) _Pragma("unroll") for (int k = 0; k < 2; ++k) \
        acc[ai][bj][m][n] = __builtin_amdgcn_mfma_f32_16x16x32_bf16(Bt[n][k], At[m][k], acc[ai][bj][m][n], 0, 0, 0); __builtin_amdgcn_s_setprio(0); } while (0)
#define PG8_WAIT_V(n) asm volatile("s_waitcnt vmcnt(" #n ")" ::: "memory")
#define PG8_WAIT_L(n) asm volatile("s_waitcnt lgkmcnt(" #n ")" ::: "memory")
#define PG8_BAR __builtin_amdgcn_s_barrier()
#define PG8_SCHED __builtin_amdgcn_sched_barrier(0)
    Unit cur, nxt; int ui = 0;
    if (!S.next(0, cur)) return;
    f32x4 acc[2][2][4][2];
#pragma unroll
    for (int a = 0; a < 2; ++a)
#pragma unroll
        for (int b = 0; b < 2; ++b)
#pragma unroll
            for (int m = 0; m < 4; ++m)
#pragma unroll
                for (int n = 0; n < 2; ++n) acc[a][b][m][n] = (f32x4){0.f, 0.f, 0.f, 0.f};
    bf16x8 At[4][2], B0[2][2], B1[2][2];
    const char* cA = (const char*)g.A + (size_t)cur.pm * tstep; const char* cB = (const char*)g.Bt + (size_t)cur.pn * tstep;
    if constexpr (SP2) {
        PG8_STAGE(PG8_SB(0, 0), cB, voffB); PG8_STAGE(PG8_SB(0, 1), cB + hstep, voffB); PG8_STAGE(PG8_SA(0, 0), cA, voffA); PG8_STAGE(PG8_SA(0, 1), cA + hstep, voffA);
        if (wr == 1) PG8_BAR;
        PG8_WAIT_V(2); PG8_BAR;
        PG8_STAGE(PG8_SB(1, 0), cB + kstep, voffB); PG8_STAGE(PG8_SA(1, 0), cA + kstep, voffA); PG8_STAGE(PG8_SB(1, 1), cB + hstep + kstep, voffB);
        PG8_WAIT_V(6); PG8_BAR;
    } else {
        PG8_STAGE(PG8_SB(0, 0), cB, voffB); PG8_STAGE(PG8_SA(0, 0), cA, voffA); PG8_STAGE(PG8_SB(0, 1), cB + hstep, voffB); PG8_STAGE(PG8_SA(0, 1), cA + hstep, voffA);
        if (wr == 1) PG8_BAR;
        PG8_WAIT_V(4); PG8_BAR;
        PG8_STAGE(PG8_SB(1, 0), cB + kstep, voffB); PG8_STAGE(PG8_SA(1, 0), cA + kstep, voffA); PG8_STAGE(PG8_SB(1, 1), cB + hstep + kstep, voffB);
        PG8_WAIT_V(6); PG8_BAR;
    }
    for (;;) {
        const bool has_next = S.next(ui + 1, nxt);
        const char* nA = has_next ? (const char*)g.A + (size_t)nxt.pm * tstep : cA; const char* nB = has_next ? (const char*)g.Bt + (size_t)nxt.pn * tstep : cB;
        for (int t = 0; t < nt; t += 2) {
            const bool last = (t == nt - 2);
            const char* a1 = cA + (size_t)(t + 1) * kstep;
            const char* a2 = last ? nA : cA + (size_t)(t + 2) * kstep; const char* b2 = last ? nB : cB + (size_t)(t + 2) * kstep;
            const char* a3 = a2 + kstep; const char* b3 = b2 + kstep;
            if constexpr (SP2) {
            PG8_LDB(B0, 0, 0); PG8_LDB(B1, 0, 1); PG8_SCHED; PG8_LDA(At, 0, 0); PG8_STAGE(PG8_SA(1, 1), a1 + hstep, voffA);
            PG8_WAIT_V(8); PG8_WAIT_L(0); PG8_BAR; PG8_MMA(0, 0, At, B0); PG8_MMA(0, 1, At, B1); PG8_BAR; PG8_SCHED;
            PG8_LDA(At, 0, 1); PG8_STAGE(PG8_SB(0, 0), b2, voffB); PG8_STAGE(PG8_SB(0, 1), b2 + hstep, voffB); PG8_STAGE(PG8_SA(0, 0), a2, voffA);
            PG8_WAIT_V(8); PG8_WAIT_L(0); PG8_BAR; PG8_MMA(1, 0, At, B0); PG8_MMA(1, 1, At, B1); PG8_BAR; PG8_SCHED;
            PG8_LDB(B0, 1, 0); PG8_LDB(B1, 1, 1); PG8_SCHED; PG8_LDA(At, 1, 0); PG8_STAGE(PG8_SA(0, 1), a2 + hstep, voffA);
            PG8_WAIT_V(8); PG8_WAIT_L(0); PG8_BAR; PG8_MMA(0, 0, At, B0); PG8_MMA(0, 1, At, B1); PG8_BAR; PG8_SCHED;
            PG8_LDA(At, 1, 1); PG8_STAGE(PG8_SB(1, 0), b3, voffB); PG8_STAGE(PG8_SB(1, 1), b3 + hstep, voffB); PG8_STAGE(PG8_SA(1, 0), a3, voffA);
            PG8_WAIT_V(8); PG8_WAIT_L(0); PG8_BAR; PG8_MMA(1, 0, At, B0); PG8_MMA(1, 1, At, B1); PG8_BAR; PG8_SCHED;
            } else {
            PG8_LDB(B0, 0, 0); PG8_SCHED; PG8_LDA(At, 0, 0); PG8_STAGE(PG8_SA(1, 1), a1 + hstep, voffA);
            PG8_WAIT_L(8); PG8_BAR; PG8_WAIT_L(0); PG8_MMA(0, 0, At, B0); PG8_BAR; PG8_SCHED;
            PG8_LDB(B1, 0, 1); PG8_STAGE(PG8_SB(0, 0), b2, voffB);
            PG8_BAR; PG8_WAIT_L(0); PG8_MMA(0, 1, At, B1); PG8_BAR;
            PG8_LDA(At, 0, 1); PG8_STAGE(PG8_SA(0, 0), a2, voffA);
            PG8_BAR; PG8_WAIT_L(0); PG8_MMA(1, 0, At, B0); PG8_BAR; PG8_SCHED;
            PG8_STAGE(PG8_SB(0, 1), b2 + hstep, voffB);
            PG8_WAIT_V(6); PG8_BAR; PG8_MMA(1, 1, At, B1); PG8_BAR;
            PG8_LDB(B0, 1, 0); PG8_SCHED; PG8_LDA(At, 1, 0); PG8_STAGE(PG8_SA(0, 1), a2 + hstep, voffA);
            PG8_WAIT_L(8); PG8_BAR; PG8_WAIT_L(0); PG8_MMA(0, 0, At, B0); PG8_BAR; PG8_SCHED;
            PG8_LDB(B1, 1, 1); PG8_STAGE(PG8_SB(1, 0), b3, voffB);
            PG8_BAR; PG8_WAIT_L(0); PG8_MMA(0, 1, At, B1); PG8_BAR;
            PG8_LDA(At, 1, 1); PG8_STAGE(PG8_SA(1, 0), a3, voffA);
            PG8_BAR; PG8_WAIT_L(0); PG8_MMA(1, 0, At, B0); PG8_BAR; PG8_SCHED;
            PG8_STAGE(PG8_SB(1, 1), b3 + hstep, voffB);
            PG8_WAIT_V(6); PG8_BAR; PG8_MMA(1, 1, At, B1); PG8_BAR;
            }
        }
        if constexpr (ALIGN_EPI) { if (wr == 0) PG8_BAR; }
        E(acc, cur, wr, wc, fr, fq);
        if (!has_next) break;
#pragma unroll
        for (int a = 0; a < 2; ++a)
#pragma unroll
            for (int b = 0; b < 2; ++b)
#pragma unroll
                for (int m = 0; m < 4; ++m)
#pragma unroll
                    for (int n = 0; n < 2; ++n) acc[a][b][m][n] = (f32x4){0.f, 0.f, 0.f, 0.f};
        cur = nxt; cA = nA; cB = nB; ++ui;
        if constexpr (ALIGN_EPI) { if (wr == 1) PG8_BAR; }
    }
    PG8_WAIT_V(0);
    if constexpr (!ALIGN_EPI) { if (wr == 0) PG8_BAR; }
    PG8_BAR;
#undef PG8_SA
#undef PG8_SB
#undef PG8_STAGE
#undef PG8_LDA
#undef PG8_LDB
#undef PG8_MMA
#undef PG8_WAIT_V
#undef PG8_WAIT_L
#undef PG8_BAR
#undef PG8_SCHED
}
}

#define XB_TMO      128
#define XB_XCNT(j)  (256  + 64 * (j))
#define XB_XSUB(j)  (1280 + 64 * (j))
#define XB_XGEN(j)  (2304 + 64 * (j))
#define XB_TOP      3328
#define XB_TOPGEN   3392
#define XCD_BAR_WORDS 3456
#define XB_SPIN_CAP (1u << 20)
__device__ __forceinline__ unsigned xb_ld(unsigned* p)              { return __hip_atomic_load(p, __ATOMIC_RELAXED, __HIP_MEMORY_SCOPE_AGENT); }
__device__ __forceinline__ unsigned xb_add(unsigned* p, unsigned v) { return __hip_atomic_fetch_add(p, v, __ATOMIC_RELAXED, __HIP_MEMORY_SCOPE_AGENT); }
__device__ __forceinline__ unsigned xb_xcc_id() { return (unsigned)__builtin_amdgcn_s_getreg((3 << 11) | 20) & 0xFu; }
#define XB_SPIN(cond, bar) do { unsigned _sp = 0; while (cond) { __builtin_amdgcn_s_sleep(1); \
    if ((++_sp & 255u) == 0u) { if (xb_ld(&(bar)[XB_TMO])) break; if (_sp > XB_SPIN_CAP) { atomicAdd(&(bar)[XB_TMO], 1u); break; } } } } while (0)
struct XcdBarrier { unsigned* bar; unsigned x; volatile LAS unsigned* st; };
__device__ __forceinline__ XcdBarrier xcd_barrier_post(unsigned* bar, volatile LAS unsigned* st) {
    XcdBarrier b; b.bar = bar; b.x = xb_xcc_id(); b.st = st;
    if (threadIdx.x == 0) (void)xb_add(&bar[XB_XCNT(b.x)], 1u);
    return b;
}
__device__ __forceinline__ void xcd_barrier_complete(unsigned* bar, unsigned x, unsigned& nloc, unsigned& nx) {
    const unsigned G = gridDim.x * gridDim.y * gridDim.z;
    unsigned sum, cnt, mine, sp = 0u;
    for (;;) {
        sum = 0u; cnt = 0u; mine = 0u;
#pragma unroll
        for (unsigned j = 0; j < 16; ++j) { const unsigned c = xb_ld(&bar[XB_XCNT(j)]); sum += c; cnt += (c > 0u) ? 1u : 0u; mine = (j == x) ? c : mine; }
        if (sum == G) break;
        __builtin_amdgcn_s_sleep(1);
        if ((++sp & 255u) == 0u) { if (xb_ld(&bar[XB_TMO])) break; if (sp > XB_SPIN_CAP) { atomicAdd(&bar[XB_TMO], 1u); break; } }
    }
    nloc = mine > 0u ? mine : 1u; nx = cnt > 0u ? cnt : 1u;
}
__device__ __forceinline__ void xcd_barrier(const XcdBarrier& b, int wave0 = -1) {
    asm volatile("s_waitcnt vmcnt(0)" ::: "memory");
    __syncthreads();
    const bool t0 = wave0 < 0 ? (threadIdx.x == 0) : (wave0 == 0 && __builtin_amdgcn_mbcnt_hi(~0u, __builtin_amdgcn_mbcnt_lo(~0u, 0u)) == 0u);
    if (t0) {
        unsigned* bar = b.bar;
        __builtin_amdgcn_s_waitcnt(0);
        unsigned nloc = b.st[0], nx = b.st[1];
        if (nloc == 0u) { xcd_barrier_complete(bar, b.x, nloc, nx); b.st[0] = nloc; b.st[1] = nx; }
        const unsigned old = xb_add(&bar[XB_XSUB(b.x)], 1u);
        const unsigned gen = old / nloc;
        if (old + 1u == (gen + 1u) * nloc) {
            __builtin_amdgcn_fence(__ATOMIC_RELEASE, "agent");
            asm volatile("s_waitcnt vmcnt(0)" ::: "memory");
            const unsigned og = xb_add(&bar[XB_TOP], 1u);
            if (og + 1u == (gen + 1u) * nx) xb_add(&bar[XB_TOPGEN], 1u);
        }
        XB_SPIN(xb_ld(&bar[XB_TOPGEN]) == gen, bar);
        __builtin_amdgcn_fence(__ATOMIC_ACQUIRE, "agent");
        asm volatile("s_waitcnt vmcnt(0)" ::: "memory");
    }
    __syncthreads();
}

struct Args { const float* in[28]; float* out; unsigned char* ws; int ph_lo, ph_hi, sub, shadow; };
enum { I_X = 0, I_FFN_NORM, I_WG, I_WU, I_WD, I_MIX_NORM, I_WIN, I_WOUT, I_QN, I_KN, I_MU, I_W0, I_WUP, I_A0, I_AUP, I_GUP, I_KK, I_KA, I_RK, I_GNW, I_GNB, I_V0, I_VDOWN, I_VUP, I_CONV, I_ALOG, I_DTB, I_ONORM };

typedef const __attribute__((address_space(4))) Args* ArgsP;
struct Ctx {
    LAS unsigned char* lds;
    int tid, lane, wave, G, bid;
    ArgsP a;
};

template <class Src>
__device__ __forceinline__ void cvt_item(Src srcp, const float* gv, int K, bf16_t* WT, LAS float* scr, int kb, int nb, int lane) {
    const int k0 = 64 * kb, n0 = 64 * nb; const int g = lane >> 4, n4 = (lane & 15) * 4;
    f32x4 v[16];
#pragma unroll
    for (int i = 0; i < 16; ++i) { const int k = k0 + 4 * i + g; const float* p = srcp(k, n0 + n4); v[i] = p ? *(const f32x4*)p : (f32x4){0.f, 0.f, 0.f, 0.f}; if (gv) v[i] = v[i] * gv[k]; }
#pragma unroll
    for (int i = 0; i < 16; ++i) { LAS float* d = scr + (4 * i + g) * 65 + n4; d[0] = v[i][0]; d[1] = v[i][1]; d[2] = v[i][2]; d[3] = v[i][3]; }
    asm volatile("s_waitcnt lgkmcnt(0)" ::: "memory");
    const int kc = lane & 7;
#pragma unroll
    for (int j = 0; j < 8; ++j) { const int n = (lane >> 3) + 8 * j; const LAS float* s = scr + (8 * kc) * 65 + n;
        u32x4 o; o.x = pk2(s[0 * 65], s[1 * 65]); o.y = pk2(s[2 * 65], s[3 * 65]); o.z = pk2(s[4 * 65], s[5 * 65]); o.w = pk2(s[6 * 65], s[7 * 65]);
        *(u32x4*)(WT + (size_t)(n0 + n) * K + k0 + 8 * kc) = o; }
    asm volatile("s_waitcnt lgkmcnt(0)" ::: "memory");
}
__device__ __forceinline__ int win_cmap(int nn) {
    if (nn < 1352) return nn;
    if (nn < 1356) return 3272 + (nn - 1352);
    if (nn < 1360) return 3276 + (nn - 1356);
    if (nn < 1408) return -1;
    if (nn < 2304) return 1352 + (nn - 1408);
    return 2248 + (nn - 2304);
}
constexpr unsigned CV_GU1 = 1, CV_GU2 = 2, CV_D1 = 4, CV_D2 = 8, CV_IN = 16, CV_OUT = 32, CV_LORA = 64;
constexpr size_t OUT_ALT_W = (size_t)MTOK * DM * 2;
__device__ __forceinline__ void convert_weights(const Ctx& C, int l, const unsigned sel, int gw, int NGW, unsigned char* wb1) {
    const ArgsP Ap = C.a;
    LAS float* scr = (LAS float*)(C.lds + C.wave * 16640);
    unsigned char* wb = Ap->ws + WS_W;
    constexpr int I_GU = (DM / 64) * (NGU / 64), I_D = (FF / 64) * (DM / 64), I_IN = (DM / 64) * (NIN / 64), I_OUT = (DM / 64) * (DM / 64);
    const int n0 = (sel & CV_GU1) ? I_GU : 0, n1 = (sel & CV_GU2) ? I_GU : 0, n2 = (sel & CV_D1) ? I_D : 0, n3 = (sel & CV_D2) ? I_D : 0, n4 = (sel & CV_IN) ? I_IN : 0, n5 = (sel & CV_OUT) ? I_OUT : 0;
    const int NIT = n0 + n1 + n2 + n3 + n4 + n5;
    for (int it = gw; it < NIT; it += NGW) {
        int r = it;
        if (r < n0 + n1) { const int f = r < n0 ? 0 : 1; r -= f ? n0 : 0; const int nblk = NGU / 64, kb = r / nblk, nb = r % nblk;
            const float* wg = Ap->in[I_WG] + (size_t)(l * 2 + f) * DM * FF; const float* wu = Ap->in[I_WU] + (size_t)(l * 2 + f) * DM * FF; const float* gv = Ap->in[I_FFN_NORM] + (size_t)(l * 2 + f) * DM;
            auto sp = [=](int k, int nn) -> const float* { const int pn = nn >> 8, bj = (nn >> 7) & 1, j = nn & 127; const float* w = bj ? wu : wg; return w + (size_t)k * FF + pn * 128 + j; };
            cvt_item(sp, gv, DM, (bf16_t*)(f ? wb + W_GU2 : wb1 + W_GU1), scr, kb, nb, C.lane); continue; }
        r -= n0 + n1;
        if (r < n2 + n3) { const int f = r < n2 ? 0 : 1; r -= f ? n2 : 0; const int nblk = DM / 64, kb = r / nblk, nb = r % nblk;
            const float* wd = Ap->in[I_WD] + (size_t)(l * 2 + f) * FF * DM;
            auto sp = [=](int k, int nn) -> const float* { return wd + (size_t)k * DM + nn; };
            cvt_item(sp, (const float*)nullptr, FF, (bf16_t*)(f ? wb + W_D2 : wb1 + W_D1), scr, kb, nb, C.lane); continue; }
        r -= n2 + n3;
        if (r < n4) { const int nblk = NIN / 64, kb = r / nblk, nb = r % nblk;
            const float* wi = Ap->in[I_WIN] + (size_t)l * DM * 3280; const float* gv = Ap->in[I_MIX_NORM] + (size_t)l * DM;
            auto sp = [=](int k, int nn) -> const float* { const int c = win_cmap(nn); return c < 0 ? (const float*)nullptr : wi + (size_t)k * 3280 + c; };
            cvt_item(sp, gv, DM, (bf16_t*)(wb + W_IN), scr, kb, nb, C.lane); continue; }
        r -= n4;
        { const int nblk = DM / 64, kb = r / nblk, nb = r % nblk;
            const float* wo = Ap->in[I_WOUT] + (size_t)l * DM * DM;
            auto sp = [=](int k, int nn) -> const float* { return wo + (size_t)k * DM + nn; };
            cvt_item(sp, (const float*)nullptr, DM, (bf16_t*)(wb + W_OUT), scr, kb, nb, C.lane); }
    }
    if (sel & CV_LORA) { bf16_t* LW = (bf16_t*)(Ap->ws + WS_LORA);
      const float* wup = Ap->in[I_WUP] + (size_t)l * 32 * 256; const float* aup = Ap->in[I_AUP] + (size_t)l * 32 * 256; const float* gup = Ap->in[I_GUP] + (size_t)l * 64 * 256;
      const float* vup = Ap->in[I_VUP] + (size_t)(l > 0 ? l - 1 : 0) * 32 * 256; const float* vdn = Ap->in[I_VDOWN] + (size_t)(l > 0 ? l - 1 : 0) * 256 * 32;
      for (int e = gw * 64 + C.lane; e < 256 * 160 + 32 * 256; e += NGW * 64) {
          float v;
          if (e < 256 * 160) { const int ch = e / 160, kc = e % 160;
              v = kc < 32 ? wup[kc * 256 + ch] : kc < 64 ? aup[(kc - 32) * 256 + ch] : kc < 128 ? gup[(kc - 64) * 256 + ch] : (l > 0 ? vup[(kc - 128) * 256 + ch] : 0.f); }
          else { const int r = e - 256 * 160, j = r >> 8, k = r & 255; v = l > 0 ? vdn[k * 32 + j] : 0.f; }
          LW[e] = (bf16_t)f2bf(v); } }
}

__device__ const float ROPE_INV_HI[32] = {1.000000000e+00f, 7.498942018e-01f, 5.623413324e-01f, 4.216965139e-01f, 3.162277639e-01f, 2.371373773e-01f, 1.778279394e-01f, 1.333521456e-01f, 1.000000015e-01f, 7.498942316e-02f, 5.623413250e-02f, 4.216964915e-02f, 3.162277490e-02f, 2.371373773e-02f, 1.778279431e-02f, 1.333521400e-02f, 9.999999776e-03f, 7.498942316e-03f, 5.623413250e-03f, 4.216964822e-03f, 3.162277630e-03f, 2.371373819e-03f, 1.778279431e-03f, 1.333521446e-03f, 1.000000047e-03f, 7.498941850e-04f, 5.623413017e-04f, 4.216965172e-04f, 3.162277571e-04f, 2.371373703e-04f, 1.778279402e-04f, 1.333521504e-04f};
__device__ const float ROPE_INV_LO[32] = {0.000000000e+00f, 7.576931971e-09f, -7.245258615e-09f, -1.046263787e-08f, 2.125617904e-09f, -6.695950017e-09f, 1.612756151e-09f, -2.336302707e-09f, -1.490116142e-09f, -2.222539042e-09f, 2.053218012e-11f, 1.188910415e-09f, 1.702677888e-09f, -6.695949906e-10f, -2.112534175e-10f, 3.251632574e-10f, 2.235174129e-10f, -2.222539097e-10f, 2.053217839e-12f, 2.120233017e-10f, 3.056940465e-11f, -1.135256264e-10f, -2.112534106e-11f, -1.404980212e-11f, -4.749745042e-11f, 2.434073776e-11f, 2.348838658e-11f, -1.372226725e-11f, 8.877706729e-12f, 2.889693693e-13f, 7.978488746e-13f, -7.225746477e-12f};
__device__ __forceinline__ void prologue_x(const Ctx& C) {
    const ArgsP Ap = C.a;
    const float* x = Ap->in[I_X]; bf16_t* xbf = (bf16_t*)(Ap->ws + WS_XBF); float* ssq = (float*)(Ap->ws + WS_SSQ);
    const int gw = C.bid * 8 + C.wave, NGW = C.G * 8;
    for (int m0 = gw; m0 < MTOK; m0 += 2 * NGW) {
        const int m1 = m0 + NGW < MTOK ? m0 + NGW : m0;
        f32x4 v[2][4];
#pragma unroll
        for (int r = 0; r < 2; ++r) { const f32x4* xr = (const f32x4*)(x + (size_t)(r ? m1 : m0) * DM) + C.lane;
#pragma unroll
            for (int j = 0; j < 4; ++j) v[r][j] = xr[64 * j]; }
#pragma unroll
        for (int r = 0; r < 2; ++r) { const int m = r ? m1 : m0; float s = 0.f;
#pragma unroll
            for (int j = 0; j < 4; ++j) s += (v[r][j][0] * v[r][j][0] + v[r][j][1] * v[r][j][1]) + (v[r][j][2] * v[r][j][2] + v[r][j][3] * v[r][j][3]);
            s = wave_sum(s);
            u32x2* o8 = (u32x2*)(xbf + (size_t)m * DM) + C.lane;
#pragma unroll
            for (int j = 0; j < 4; ++j) { u32x2 w; w.x = pk2(v[r][j][0], v[r][j][1]); w.y = pk2(v[r][j][2], v[r][j][3]); o8[64 * j] = w; }
            if (C.lane < 16) ssq[(size_t)m * 16 + C.lane] = (C.lane == 0) ? s : 0.f; }
    }
    f32x2* cs = (f32x2*)(Ap->ws + WS_ROPE);
    const int gt = C.bid * 512 + C.tid, NT = C.G * 512;
    for (int e = gt; e < SEQ * 32; e += NT) {
        const int pos = e >> 5, i = e & 31;
        const float fpos = (float)pos, ih = ROPE_INV_HI[i], il = ROPE_INV_LO[i];
        const float ph = fpos * ih; const float pe = fmaf(fpos, ih, -ph) + fpos * il;
        const float k = rintf(ph * 0.15915494309189535f);
        float r = fmaf(-k, 6.2831854820251465f, ph); r = fmaf(-k, -1.7484555e-07f, r); r += pe;
        const float r2 = r * r;
        float ts = 1.f, tc = 1.f;
        ts = 1.f - ts * r2 * (1.f / (18.f * 19.f)); ts = 1.f - ts * r2 * (1.f / (16.f * 17.f)); ts = 1.f - ts * r2 * (1.f / (14.f * 15.f)); ts = 1.f - ts * r2 * (1.f / (12.f * 13.f));
        ts = 1.f - ts * r2 * (1.f / (10.f * 11.f)); ts = 1.f - ts * r2 * (1.f / (8.f * 9.f)); ts = 1.f - ts * r2 * (1.f / (6.f * 7.f)); ts = 1.f - ts * r2 * (1.f / (4.f * 5.f)); ts = 1.f - ts * r2 * (1.f / (2.f * 3.f));
        tc = 1.f - tc * r2 * (1.f / (19.f * 20.f)); tc = 1.f - tc * r2 * (1.f / (17.f * 18.f)); tc = 1.f - tc * r2 * (1.f / (15.f * 16.f)); tc = 1.f - tc * r2 * (1.f / (13.f * 14.f)); tc = 1.f - tc * r2 * (1.f / (11.f * 12.f));
        tc = 1.f - tc * r2 * (1.f / (9.f * 10.f)); tc = 1.f - tc * r2 * (1.f / (7.f * 8.f)); tc = 1.f - tc * r2 * (1.f / (5.f * 6.f)); tc = 1.f - tc * r2 * (1.f / (3.f * 4.f)); tc = 1.f - tc * r2 * (1.f / (1.f * 2.f));
        cs[e] = (f32x2){tc, ts * r};
    }
}

__device__ __forceinline__ float row16_sum(float v) {
    DPP_ADD(v, 0xB1); DPP_ADD(v, 0x4E); DPP_ADD(v, 0x141); DPP_ADD(v, 0x140); return v;
}
__device__ __forceinline__ void prep_phase(const Ctx& C, int l) {
    const ArgsP Ap = C.a;
    bf16_t* P = (bf16_t*)(Ap->ws + WS_P);
    {
        const f32x4* cs = (const f32x4*)(Ap->ws + WS_ROPE);
        const int gw = C.bid * 8 + C.wave, NGW = C.G * 8; const int j = C.lane & 15, hq = C.lane >> 4;
        const float* kn = Ap->in[I_KN] + l * 64;
        const f32x2 kn1 = *(const f32x2*)(kn + 2 * j), kn2 = *(const f32x2*)(kn + 32 + 2 * j);
        const int col = hq < 2 ? PK + hq * 64 : PKI;
        for (int m0 = gw; m0 < MTOK; m0 += 4 * NGW) {
            unsigned xa[4], xb[4]; f32x4 cq[4];
#pragma unroll
            for (int t = 0; t < 4; ++t) { const int m = (m0 + t * NGW) < MTOK ? (m0 + t * NGW) : m0; const bf16_t* row = P + (size_t)m * NIN;
                cq[t] = cs[(m & (SEQ - 1)) * 16 + j]; xa[t] = *(const unsigned*)(row + col + 2 * j); xb[t] = *(const unsigned*)(row + col + 32 + 2 * j); }
            __builtin_amdgcn_sched_barrier(0);
#pragma unroll
            for (int t = 0; t < 4; ++t) { const int m = m0 + t * NGW; const f32x4 c = cq[t];
                float a0 = bflo(xa[t]), a1 = bfhi(xa[t]), b0 = bflo(xb[t]), b1 = bfhi(xb[t]);
                const float ss = row16_sum((a0 * a0 + a1 * a1) + (b0 * b0 + b1 * b1));
                if (hq < 2) { const float rs = rsqrtf(ss * (1.f / 64.f) + NORM_EPS); a0 *= rs * kn1[0]; a1 *= rs * kn1[1]; b0 *= rs * kn2[0]; b1 *= rs * kn2[1]; }
                const float o0 = a0 * c[0] - b0 * c[1], o1 = a1 * c[2] - b1 * c[3], p0 = b0 * c[0] + a0 * c[1], p1 = b1 * c[2] + a1 * c[3];
                if (hq < 3 && m < MTOK) { bf16_t* row = P + (size_t)m * NIN; *(unsigned*)(row + col + 2 * j) = pk2(o0, o1); *(unsigned*)(row + col + 32 + 2 * j) = pk2(p0, p1); } }
        }
    }
    {
        bf16_t* LO = (bf16_t*)(Ap->ws + WS_XBF); const bf16_t* LW = (const bf16_t*)(Ap->ws + WS_LORA);
        LAS unsigned char* IN = C.lds;
        LAS unsigned char* VT = C.lds + 17408;
        LAS unsigned char* IN2 = C.lds + 17408 + 33792;
        const float* mu = Ap->in[I_MU] + l * 896;
        const int lane = C.lane, w = C.wave, r16 = lane & 15, g4 = lane >> 4;
        for (int tile = C.bid; tile < MTOK / 64; tile += C.G) {
            const int m0 = tile * 64;
            int tid = C.tid; asm volatile("" : "+v"(tid));
            __syncthreads();
            {
              const int t = tid >> 3, j0 = (tid & 7) * 16; const int m = m0 + t; const bf16_t* row = P + (size_t)m * NIN + PRW + 768 + j0; const bool hp = (m & (SEQ - 1)) != 0;
              const u32x4 c0 = *(const u32x4*)row, c1 = *(const u32x4*)(row + 8); u32x4 p0 = {0u, 0u, 0u, 0u}, p1 = p0;
              if (hp) { p0 = *(const u32x4*)(row - NIN); p1 = *(const u32x4*)(row - NIN + 8); }
              float h[16];
#pragma unroll
              for (int q = 0; q < 4; ++q) { h[2 * q] = bflo(c0[q]); h[2 * q + 1] = bfhi(c0[q]); h[8 + 2 * q] = bflo(c1[q]); h[9 + 2 * q] = bfhi(c1[q]); }
              float pv[16];
#pragma unroll
              for (int q = 0; q < 4; ++q) { pv[2 * q] = bflo(p0[q]); pv[2 * q + 1] = bfhi(p0[q]); pv[8 + 2 * q] = bflo(p1[q]); pv[9 + 2 * q] = bfhi(p1[q]); }
#pragma unroll
              for (int q = 0; q < 16; ++q) { float x = h[q] + (pv[q] - h[q]) * mu[768 + j0 + q];
                  if (j0 < 32) x = 1.f - 2.f * __builtin_amdgcn_rcpf(1.f + __expf(2.f * x)); else if (j0 >= 64) x = sigmoidf_(x);
                  h[q] = x; }
              u32x4 o0, o1;
#pragma unroll
              for (int q = 0; q < 4; ++q) { o0[q] = pk2(h[2 * q], h[2 * q + 1]); o1[q] = pk2(h[8 + 2 * q], h[9 + 2 * q]); }
              *(LAS u32x4*)(IN + t * 272 + j0 * 2) = o0; *(LAS u32x4*)(IN + t * 272 + j0 * 2 + 16) = o1; }
            if (l > 0) {
              const int t = tid >> 3, j0 = (tid & 7) * 32; const int m = m0 + t; const bf16_t* row = P + (size_t)m * NIN + PRW + 512 + j0; const bool hp = (m & (SEQ - 1)) != 0;
#pragma unroll
              for (int q4 = 0; q4 < 4; ++q4) { const u32x4 c0 = *(const u32x4*)(row + 8 * q4); u32x4 p0 = {0u, 0u, 0u, 0u}; if (hp) p0 = *(const u32x4*)(row - NIN + 8 * q4);
                  u32x4 o;
#pragma unroll
                  for (int q = 0; q < 4; ++q) { const float a = bflo(c0[q]), b = bfhi(c0[q]); const float pa = bflo(p0[q]), pb = bfhi(p0[q]);
                      o[q] = pk2(a + (pa - a) * mu[512 + j0 + 8 * q4 + 2 * q], b + (pb - b) * mu[512 + j0 + 8 * q4 + 2 * q + 1]); }
                  *(LAS u32x4*)(VT + t * 528 + (j0 + 8 * q4) * 2) = o; } }
            __syncthreads();
            if (l > 0) {
              const int tmv = w >> 1, tnv = w & 1; f32x4 c = {0.f, 0.f, 0.f, 0.f};
              const bf16_t* vdt = LW + 256 * 160 + (size_t)(16 * tnv + r16) * 256 + 8 * g4;
#pragma unroll
              for (int s = 0; s < 8; ++s) { const bf16x8 a = *(const LAS bf16x8*)(VT + (16 * tmv + r16) * 528 + (32 * s + 8 * g4) * 2); const bf16x8 b = *(const bf16x8*)(vdt + 32 * s);
                  c = __builtin_amdgcn_mfma_f32_16x16x32_bf16(a, b, c, 0, 0, 0); }
#pragma unroll
              for (int rg = 0; rg < 4; ++rg) *(LAS bf16_t*)(IN2 + (16 * tmv + 4 * g4 + rg) * 80 + (16 * tnv + r16) * 2) = (bf16_t)f2bf(c[rg]);
              __syncthreads(); }
#pragma unroll 1
            for (int mt = 0; mt < 2; ++mt) {
                const int ch0 = 32 * w + 16 * mt;
                const bf16_t* wrow = LW + (size_t)(ch0 + r16) * 160 + 8 * g4;
                const bf16x8 aw = *(const bf16x8*)wrow, aa = *(const bf16x8*)(wrow + 32), ag0 = *(const bf16x8*)(wrow + 64), ag1 = *(const bf16x8*)(wrow + 96), av = *(const bf16x8*)(wrow + 128);
                const int chq = ch0 + 4 * g4;
                const f32x4 w0v = *(const f32x4*)(Ap->in[I_W0] + l * 256 + chq), a0v = *(const f32x4*)(Ap->in[I_A0] + l * 256 + chq);
                f32x4 v0v = {0.f, 0.f, 0.f, 0.f}; if (l > 0) v0v = *(const f32x4*)(Ap->in[I_V0] + (l - 1) * 256 + chq);
#pragma unroll
                for (int nt = 0; nt < 4; ++nt) {
                    const LAS unsigned char* inr = IN + (16 * nt + r16) * 272 + 16 * g4;
                    const bf16x8 bw = *(const LAS bf16x8*)inr, ba = *(const LAS bf16x8*)(inr + 64), bg0 = *(const LAS bf16x8*)(inr + 128), bg1 = *(const LAS bf16x8*)(inr + 192);
                    const f32x4 z4 = {0.f, 0.f, 0.f, 0.f};
                    f32x4 cw = __builtin_amdgcn_mfma_f32_16x16x32_bf16(aw, bw, z4, 0, 0, 0);
                    f32x4 ca = __builtin_amdgcn_mfma_f32_16x16x32_bf16(aa, ba, z4, 0, 0, 0);
                    f32x4 cg = __builtin_amdgcn_mfma_f32_16x16x32_bf16(ag0, bg0, z4, 0, 0, 0); cg = __builtin_amdgcn_mfma_f32_16x16x32_bf16(ag1, bg1, cg, 0, 0, 0);
                    bf16_t* lo = LO + (size_t)(m0 + 16 * nt + r16) * 1024 + chq;
                    float o[4];
#pragma unroll
                    for (int rg = 0; rg < 4; ++rg) { const float s = cw[rg] + w0v[rg]; o[rg] = -__expf(-softplusf_(-s) - 0.5f); }
                    { u32x2 ov; ov.x = pk2(o[0], o[1]); ov.y = pk2(o[2], o[3]); *(u32x2*)lo = ov; }
#pragma unroll
                    for (int rg = 0; rg < 4; ++rg) o[rg] = sigmoidf_(ca[rg] + a0v[rg]);
                    { u32x2 ov; ov.x = pk2(o[0], o[1]); ov.y = pk2(o[2], o[3]); *(u32x2*)(lo + 256) = ov; }
                    { u32x2 ov; ov.x = pk2(cg[0], cg[1]); ov.y = pk2(cg[2], cg[3]); *(u32x2*)(lo + 512) = ov; }
                    if (l > 0) { const bf16x8 bv = *(const LAS bf16x8*)(IN2 + (16 * nt + r16) * 80 + 16 * g4);
                        const f32x4 cv = __builtin_amdgcn_mfma_f32_16x16x32_bf16(av, bv, z4, 0, 0, 0);
#pragma unroll
                        for (int rg = 0; rg < 4; ++rg) o[rg] = sigmoidf_(cv[rg] + v0v[rg]);
                        u32x2 ov; ov.x = pk2(o[0], o[1]); ov.y = pk2(o[2], o[3]); *(u32x2*)(lo + 768) = ov; }
                }
            }
        }
        __syncthreads();
    }
}

constexpr int CK_ST = 144, CK_MAT = 64 * CK_ST, CK_FS = 68;
struct CkA {
    static constexpr int YA = 0, XB = CK_MAT, XK = 2 * CK_MAT, YR = 3 * CK_MAT, RTS = 4 * CK_MAT;
    static constexpr int WBF = 0, MBR = 2 * CK_MAT, MKR = 3 * CK_MAT;
    static constexpr int VT = 5 * CK_MAT, BBT = 6 * CK_MAT, KBT = 7 * CK_MAT, NAK = 8 * CK_MAT;
    static constexpr int NAB = 9 * CK_MAT;
    static constexpr int Z = NAB + 64 * CK_FS * 4;
    static constexpr int TJ = Z + 128 * CK_FS * 4;
    static constexpr int SC = TJ + 4096;
    static constexpr int END = SC + (3 * 64 + 512) * 4;
};
static_assert(CkA::END <= LDS_MISC, "chunk lds");

constexpr size_t WS_PST = 224 * MiB, WS_DS = 240 * MiB;
constexpr size_t WS_PYT = WS_W;
static_assert(16 * MiB <= W_IN, "PY^T fits under the dead FFN1 weights");
constexpr int CW_CNTA = 12288, CW_FLAGB = 14336;

__device__ __forceinline__ void mm2(f32x4 (&c)[2], const LAS unsigned char* A, const LAS unsigned char* B, int tm, int tn0, int lane) {
    const int r = lane & 15, g = lane >> 4;
#pragma unroll
    for (int s = 0; s < 2; ++s) {
        const bf16x8 a = *(const LAS bf16x8*)(A + (tm * 16 + r) * CK_ST + (32 * s + 8 * g) * 2);
#pragma unroll
        for (int q = 0; q < 2; ++q) { const bf16x8 b = *(const LAS bf16x8*)(B + ((tn0 + q) * 16 + r) * CK_ST + (32 * s + 8 * g) * 2);
            c[q] = __builtin_amdgcn_mfma_f32_16x16x32_bf16(a, b, c[q], 0, 0, 0); }
    }
}
__device__ __forceinline__ void st_bf(LAS unsigned char* base, int row, int col, float v) { *(LAS bf16_t*)(base + row * CK_ST + col * 2) = (bf16_t)f2bf(v); }
__device__ __forceinline__ void st8_bf(LAS unsigned char* base, int row, int col0, const float (&v)[8]) {
    u32x4 w; w.x = pk2(v[0], v[1]); w.y = pk2(v[2], v[3]); w.z = pk2(v[4], v[5]); w.w = pk2(v[6], v[7]); *(LAS u32x4*)(base + row * CK_ST + col0 * 2) = w; }
__device__ __forceinline__ void ck_store_tok(LAS unsigned char* lds, int t, int lane, float ya, float xb, float xk, float yr, float rts) {
    st_bf(lds + CkA::YA, t, lane, ya); st_bf(lds + CkA::XB, t, lane, xb); st_bf(lds + CkA::XK, t, lane, xk); st_bf(lds + CkA::YR, t, lane, yr); st_bf(lds + CkA::RTS, t, lane, rts);
}

constexpr int CKS_BASE = 8 * CK_MAT, CKS_WAVE = 5504, CKS_XTRA = CkA::END;
static_assert(CKS_BASE + 8 * CKS_WAVE <= CkA::Z + 64 * CK_FS * 4, "staging stays below the Z rows the next prep writes");
static_assert(CKS_XTRA % 16 == 0 && CKS_XTRA + 6 * 2048 <= LDS_MISC, "extra staging fits");
__device__ __forceinline__ int cks_xtra(int w) { return w < 2 ? CkA::TJ + w * 2048 : CKS_XTRA + (w - 2) * 2048; }
#define CKS_DMA(gp, lp) __builtin_amdgcn_global_load_lds((const unsigned*)(gp), (LAS unsigned*)(lp), 16, 0, 0)
__device__ __forceinline__ void chunk_A_consts(const Ctx& C, int l, int combo, float (&kc)[12]) {
    const ArgsP Ap = C.a; const int mix = combo >> 3, h = combo & 3, ch = h * 64 + C.lane;
    if (mix == 0) { const float* mu = Ap->in[I_MU] + l * 896;
        kc[0] = mu[ch]; kc[1] = mu[256 + ch]; kc[2] = mu[512 + ch]; kc[3] = Ap->in[I_KK][l * 256 + ch]; kc[4] = Ap->in[I_KA][l * 256 + ch]; kc[5] = Ap->in[I_RK][l * 256 + ch];
#pragma unroll
        for (int j = 6; j < 12; ++j) kc[j] = 0.f; }
    else { const float* cw = Ap->in[I_CONV] + (size_t)l * 4 * 768;
#pragma unroll
        for (int j = 0; j < 4; ++j) { kc[j] = cw[j * 768 + ch]; kc[4 + j] = cw[j * 768 + 256 + ch]; kc[8 + j] = cw[j * 768 + 512 + ch]; } }
}
__device__ __forceinline__ void chunk_A_stage(const Ctx& C, int l, int combo, int n) {
    const ArgsP Ap = C.a; const int lane = C.lane, w = C.wave;
    const int mix = combo >> 3, bh = combo & 7, b = bh >> 2, h = bh & 3;
    const bf16_t* P = (const bf16_t*)(Ap->ws + WS_P);
    const int tq0 = n * 64 + 8 * w; const size_t m0 = (size_t)b * SEQ + tq0;
    LAS unsigned char* st = C.lds + CKS_BASE + w * CKS_WAVE;
    const int tt = lane >> 3, c8 = (lane & 7) * 8;
    if (mix == 0) {
        const bf16_t* LO = (const bf16_t*)(Ap->ws + WS_XBF); const bf16_t* VF = (const bf16_t*)(Ap->ws + WS_VF);
        const bf16_t* row = P + (m0 + tt) * NIN + PRW + h * 64 + c8; const bf16_t* lo = LO + (m0 + tt) * 1024 + h * 64 + c8;
        CKS_DMA(row, st); CKS_DMA(row + 256, st + 1024); CKS_DMA(row + 512, st + 2048); CKS_DMA(lo, st + 3072); CKS_DMA(lo + 256, st + 4096);
        if (lane < 24) { const size_t mp = (tq0 > 0) ? (m0 - 1) : m0; CKS_DMA(P + mp * NIN + PRW + tt * 256 + h * 64 + c8, st + 5120); }
        if (l > 0) { LAS unsigned char* sx = C.lds + cks_xtra(w); CKS_DMA(lo + 768, sx); CKS_DMA(VF + (m0 + tt) * 256 + h * 64 + c8, sx + 1024); }
    } else {
        const int t0 = tq0 - 3 + tt, t1 = tq0 + 5 + tt;
        const bf16_t* r0 = P + ((size_t)b * SEQ + (t0 < 0 ? 0 : t0)) * NIN + PGD + h * 64 + c8; const bf16_t* r1 = P + ((size_t)b * SEQ + t1) * NIN + PGD + h * 64 + c8;
#pragma unroll
        for (int a = 0; a < 3; ++a) { CKS_DMA(r0 + a * 256, st + a * 1408); if (lane < 24) CKS_DMA(r1 + a * 256, st + a * 1408 + 1024); }
    }
}

__device__ __forceinline__ void rwkv_prep(const Ctx& C, int l, int b, int h, int n, LAS unsigned char* lds, const float (&kc)[12]) {
    typedef CkA L; LAS float* Gs = (LAS float*)(lds + L::SC); LAS float* Bs = Gs + 64; LAS float* Gam = Gs + 128; LAS float* wsum = Gs + 192; LAS float* Z = (LAS float*)(lds + L::Z);
    const ArgsP Ap = C.a; const int lane = C.lane, w = C.wave, ch = h * 64 + lane;
    const bf16_t* P = (const bf16_t*)(Ap->ws + WS_P); bf16_t* LO = (bf16_t*)(Ap->ws + WS_XBF); bf16_t* VF = (bf16_t*)(Ap->ws + WS_VF);
    const float mu_r = kc[0], mu_k = kc[1], mu_v = kc[2], k_k = kc[3], k_a = kc[4], r_k = kc[5];
    const int tq0 = n * 64 + 8 * w;
    const size_t m0 = (size_t)b * SEQ + tq0;
    asm volatile("s_waitcnt vmcnt(0)" ::: "memory");
    const LAS bf16_t* sg = (const LAS bf16_t*)(lds + CKS_BASE + w * CKS_WAVE) + lane; const LAS bf16_t* sx = (const LAS bf16_t*)(lds + cks_xtra(w)) + lane;
    bf16_t q_rc[9], q_kc[9], q_vc[9], q_wl[8], q_a[8], q_vg[8], q_vf[8];
    q_rc[8] = sg[2560]; q_kc[8] = sg[2560 + 64]; q_vc[8] = sg[2560 + 128];
#pragma unroll
    for (int tt = 0; tt < 8; ++tt) {
        q_rc[tt] = sg[tt * 64]; q_kc[tt] = sg[512 + tt * 64]; q_vc[tt] = sg[1024 + tt * 64]; q_wl[tt] = sg[1536 + tt * 64]; q_a[tt] = sg[2048 + tt * 64];
        q_vg[tt] = 0; q_vf[tt] = 0;
        if (l > 0) { q_vg[tt] = sx[tt * 64]; q_vf[tt] = sx[512 + tt * 64]; }
    }
    float rp = (tq0 > 0) ? bf2f(q_rc[8]) : 0.f, kp = (tq0 > 0) ? bf2f(q_kc[8]) : 0.f, vp = (tq0 > 0) ? bf2f(q_vc[8]) : 0.f;
    float lw[8], as[8], bs_[8], k2[8], rr[8], vv[8], kkp[8], aa[8], sq[8], n2[8], bon[8];
#pragma unroll
    for (int tt = 0; tt < 8; ++tt) {
        const size_t m = m0 + tt;
        const float rc = bf2f(q_rc[tt]), kc = bf2f(q_kc[tt]), vc = bf2f(q_vc[tt]);
        const float r = rc + (rp - rc) * mu_r, k = kc + (kp - kc) * mu_k; float v = vc + (vp - vc) * mu_v;
        rp = rc; kp = kc; vp = vc;
        const float a = bf2f(q_a[tt]);
        if (l == 0) VF[m * 256 + ch] = (bf16_t)f2bf(v);
        else { const float vg = bf2f(q_vg[tt]); const float vf = bf2f(q_vf[tt]); v = v + (vf - v) * vg; }
        kkp[tt] = k * k_k; sq[tt] = kkp[tt] * kkp[tt];
        k2[tt] = k * (1.f + (a - 1.f) * k_a); rr[tt] = r; lw[tt] = bf2f(q_wl[tt]); vv[tt] = v; aa[tt] = a;
        bon[tt] = r * k2[tt] * r_k;
    }
    wave_sum8(sq, n2, lane);
    { float bs8[8]; wave_sum8(bon, bs8, lane);
#if defined(SELFCHECK)
#pragma unroll
      for (int tt = 0; tt < 8; ++tt) { const float c1 = wave_sum(sq[tt]), c2 = wave_sum(bon[tt]);
          if (!(fabsf(n2[tt] - c1) <= 1e-4f * fabsf(c1) + 1e-20f) || !(fabsf(bs8[tt] - c2) <= 1e-4f * fabsf(c2) + 1e-6f)) *((unsigned*)(Ap->ws + WS_CTL) + 16) = 1u; }
#endif
#pragma unroll
      for (int tt = 0; tt < 8; ++tt) { const float kk = kkp[tt] * rsqrtf(n2[tt] + 1e-12f); as[tt] = -kk; bs_[tt] = kk * aa[tt];
          __hip_atomic_store(LO + (m0 + tt) * 1024 + ch, (bf16_t)f2bf(bs8[tt] * vv[tt]), __ATOMIC_RELAXED, __HIP_MEMORY_SCOPE_AGENT); } }
    float g[8]; g[0] = lw[0];
#pragma unroll
    for (int tt = 1; tt < 8; ++tt) g[tt] = g[tt - 1] + lw[tt];
    wsum[w * 64 + lane] = g[7];
    __syncthreads();
    float pre = 0.f, tot = 0.f;
#pragma unroll
    for (int ww = 0; ww < 8; ++ww) { const float s = wsum[ww * 64 + lane]; tot += s; if (ww < w) pre += s; }
    float bb[8], kb[8], at[8]; float eGprev = __expf(pre); const float etot = __expf(tot);
#pragma unroll
    for (int tt = 0; tt < 8; ++tt) {
        const float G = pre + g[tt];
        const float eG = __expf(G), eGi = __builtin_amdgcn_rcpf(eG), eGp = eGprev, eT = etot * eGi;
        eGprev = eG;
        const float ya = as[tt] * eGp, yr = rr[tt] * eG;
        ck_store_tok(lds, 8 * w + tt, lane, ya, bs_[tt] * eGi, k2[tt] * eGi, yr, yr);
        bb[tt] = bs_[tt] * eT; kb[tt] = k2[tt] * eT; at[tt] = ya;
    }
    st8_bf(lds + L::VT, lane, 8 * w, vv);
    st8_bf(lds + L::BBT, lane, 8 * w, bb); st8_bf(lds + L::KBT, lane, 8 * w, kb);
#pragma unroll
    for (int tt = 0; tt < 8; ++tt) Z[(64 + lane) * CK_FS + 8 * w + tt] = at[tt];
    if (w == 0) Gam[lane] = etot;
    if (lane < 8) { Gs[8 * w + lane] = 0.f; Bs[8 * w + lane] = 1.f; }
}
__device__ __forceinline__ void gdn_prep(const Ctx& C, int l, int b, int h, int n, LAS unsigned char* lds, const float (&kc)[12]) {
    typedef CkA L; LAS float* Gs = (LAS float*)(lds + L::SC); LAS float* Bs = Gs + 64; LAS float* Gam = Gs + 128; LAS float* wsum = Gs + 192; LAS float* Z = (LAS float*)(lds + L::Z);
    const ArgsP Ap = C.a; const int lane = C.lane, w = C.wave, ch = h * 64 + lane;
    const bf16_t* P = (const bf16_t*)(Ap->ws + WS_P);
    float wq[4], wk[4], wv[4];
#pragma unroll
    for (int j = 0; j < 4; ++j) { wq[j] = kc[j]; wk[j] = kc[4 + j]; wv[j] = kc[8 + j]; }
    const float nexpa = -__expf(Ap->in[I_ALOG][l * 4 + h]), dtb = Ap->in[I_DTB][l * 4 + h];
    const int tq0 = n * 64 + 8 * w; const size_t m0 = (size_t)b * SEQ + tq0;
    bf16_t q_q[11], q_k[11], q_v[11], q_b[8], q_a[8];
#pragma unroll
    for (int tt = 0; tt < 8; ++tt) { const bf16_t* row = P + (m0 + tt) * NIN; q_b[tt] = row[PGB + h]; q_a[tt] = row[PGA + h]; }
    asm volatile("s_waitcnt vmcnt(0)" ::: "memory");
    const LAS bf16_t* sg = (const LAS bf16_t*)(lds + CKS_BASE + w * CKS_WAVE) + lane;
#pragma unroll
    for (int d = 0; d < 11; ++d) { q_q[d] = sg[d * 64]; q_k[d] = sg[704 + d * 64]; q_v[d] = sg[1408 + d * 64]; }
    float xq[11], xk[11], xv[11];
#pragma unroll
    for (int d = 0; d < 11; ++d) { const bool ok = (tq0 - 3 + d) >= 0; xq[d] = ok ? bf2f(q_q[d]) : 0.f; xk[d] = ok ? bf2f(q_k[d]) : 0.f; xv[d] = ok ? bf2f(q_v[d]) : 0.f; }
    float lw[8], kr[8], qr[8], be[8], vv[8], q2[8], k2s[8], nq[8], nk[8];
#pragma unroll
    for (int tt = 0; tt < 8; ++tt) {
        float sq = wq[0] * xq[tt] + wq[1] * xq[tt + 1] + wq[2] * xq[tt + 2] + wq[3] * xq[tt + 3];
        float sk = wk[0] * xk[tt] + wk[1] * xk[tt + 1] + wk[2] * xk[tt + 2] + wk[3] * xk[tt + 3];
        float sv = wv[0] * xv[tt] + wv[1] * xv[tt + 1] + wv[2] * xv[tt + 2] + wv[3] * xv[tt + 3];
        sq = siluf_(sq); sk = siluf_(sk); sv = siluf_(sv);
        qr[tt] = sq; kr[tt] = sk; vv[tt] = sv; q2[tt] = sq * sq; k2s[tt] = sk * sk;
        be[tt] = sigmoidf_(bf2f(q_b[tt])); lw[tt] = nexpa * softplusf_(bf2f(q_a[tt]) + dtb);
    }
    wave_sum8(q2, nq, lane); wave_sum8(k2s, nk, lane);
#pragma unroll
    for (int tt = 0; tt < 8; ++tt) { qr[tt] *= rsqrtf(nq[tt] + 1e-6f) * 0.125f; kr[tt] *= rsqrtf(nk[tt] + 1e-6f); }
    float g[8]; g[0] = lw[0];
#pragma unroll
    for (int tt = 1; tt < 8; ++tt) g[tt] = g[tt - 1] + lw[tt];
    wsum[w * 64 + lane] = g[7];
    __syncthreads();
    float pre = 0.f, tot = 0.f;
#pragma unroll
    for (int ww = 0; ww < 8; ++ww) { const float s = wsum[ww * 64 + lane]; tot += s; if (ww < w) pre += s; }
    float bb[8], kb[8], at[8];
#pragma unroll
    for (int tt = 0; tt < 8; ++tt) {
        const float G = pre + g[tt]; const float eG = __expf(G), eT = __expf(tot - G);
        ck_store_tok(lds, 8 * w + tt, lane, kr[tt], -kr[tt], kr[tt], qr[tt], qr[tt] * eG);
        bb[tt] = -be[tt] * kr[tt] * eT; kb[tt] = -bb[tt]; at[tt] = kr[tt] * eG;
        if (lane == tt) { Gs[8 * w + tt] = G; Bs[8 * w + tt] = be[tt]; }
    }
    st8_bf(lds + L::VT, lane, 8 * w, vv);
    st8_bf(lds + L::BBT, lane, 8 * w, bb); st8_bf(lds + L::KBT, lane, 8 * w, kb);
#pragma unroll
    for (int tt = 0; tt < 8; ++tt) Z[(64 + lane) * CK_FS + 8 * w + tt] = at[tt];
    if (w == 0) Gam[lane] = __expf(tot);
}

template <bool PUBLISH = true>
__device__ __forceinline__ void chunk_A(const Ctx& C, int l, int combo, int n, bool has_next, int ncombo, int nn, const float (&kc)[12]) {
    typedef CkA L;
    int lane_o = C.lane; asm volatile("" : "+v"(lane_o));
    const ArgsP Ap = C.a; const int lane = lane_o, w = C.wave, tid = w * 64 + lane, r16 = lane & 15, g4 = lane >> 4;
    const int mix = combo >> 3, bh = combo & 7, b = bh >> 2, h = bh & 3;
    LAS unsigned char* lds = C.lds;
    LAS float* NAB = (LAS float*)(lds + L::NAB); LAS float* Z = (LAS float*)(lds + L::Z); LAS float* TJ = (LAS float*)(lds + L::TJ);
    LAS float* Gs = (LAS float*)(lds + L::SC); LAS float* Bs = Gs + 64; LAS float* Gam = Gs + 128;
    const size_t slot = ((size_t)combo * 128 + n) * 4096;
    bf16_t* PSTg = (bf16_t*)(Ap->ws + WS_PST) + slot; bf16_t* DSg = (bf16_t*)(Ap->ws + WS_DS) + slot; bf16_t* PYTg = (bf16_t*)(Ap->ws + WS_PYT) + slot;
    __syncthreads();
    unsigned long long tsA[6]; tsA[0] = TS_NOW();
    Ctx C2 = C; C2.lane = lane; C2.tid = tid;
    if (mix == 0) rwkv_prep(C2, l, b, h, n, lds, kc); else gdn_prep(C2, l, b, h, n, lds, kc);
    __syncthreads();
    tsA[1] = TS_NOW();
    const int tm = w >> 1, tn0 = 2 * (w & 1);
    {
        f32x4 cab[2] = {{0.f, 0.f, 0.f, 0.f}, {0.f, 0.f, 0.f, 0.f}}, cak[2] = {{0.f, 0.f, 0.f, 0.f}, {0.f, 0.f, 0.f, 0.f}};
        f32x4 cbr[2] = {{0.f, 0.f, 0.f, 0.f}, {0.f, 0.f, 0.f, 0.f}}, ckr[2] = {{0.f, 0.f, 0.f, 0.f}, {0.f, 0.f, 0.f, 0.f}};
        mm2(cab, lds + L::YA, lds + L::XB, tm, tn0, lane); mm2(cak, lds + L::YA, lds + L::XK, tm, tn0, lane);
        mm2(cbr, lds + L::YR, lds + L::XB, tm, tn0, lane); mm2(ckr, lds + L::YR, lds + L::XK, tm, tn0, lane);
        __syncthreads();
#pragma unroll
        for (int q = 0; q < 2; ++q) { const int i = 16 * (tn0 + q) + r16; const float gi = Gs[i], bi = Bs[i];
#pragma unroll
            for (int rg = 0; rg < 4; ++rg) { const int t = 16 * tm + 4 * g4 + rg; const float f = (i <= t) ? bi * __expf(Gs[t] - gi) : 0.f; const float fs = (i < t) ? f : 0.f;
                NAB[t * CK_FS + i] = cab[q][rg] * fs; st_bf(lds + L::NAK, t, i, cak[q][rg] * fs);
                st_bf(lds + L::MBR, t, i, cbr[q][rg] * f); st_bf(lds + L::MKR, t, i, ckr[q][rg] * f); } }
    }
    __syncthreads();
    tsA[2] = TS_NOW();
    {
        f32x4 cx[2] = {{0.f, 0.f, 0.f, 0.f}, {0.f, 0.f, 0.f, 0.f}};
        mm2(cx, lds + L::VT, lds + L::NAK, tm, tn0, lane);
#pragma unroll
        for (int q = 0; q < 2; ++q)
#pragma unroll
            for (int rg = 0; rg < 4; ++rg) Z[(16 * tm + 4 * g4 + rg) * CK_FS + 16 * (tn0 + q) + r16] = cx[q][rg];
    }
    if (w == 0) {
        const int J = g4, r = r16; float T[16];
#pragma unroll
        for (int c = 0; c < 16; ++c) { float s = (c == r) ? 1.f : 0.f;
#pragma unroll
            for (int mm = 0; mm < 16; ++mm) if (mm < c) s += T[mm] * NAB[(16 * J + c) * CK_FS + 16 * J + mm];
            T[c] = s; }
#pragma unroll
        for (int c = 0; c < 16; ++c) TJ[J * 256 + r * 16 + c] = T[c];
    }
    __syncthreads();
    tsA[3] = TS_NOW();
    {
        const int r0 = 16 * w;
#pragma unroll
        for (int J = 0; J < 4; ++J) {
            f32x4 acc;
#pragma unroll
            for (int rg = 0; rg < 4; ++rg) acc[rg] = Z[(r0 + 4 * g4 + rg) * CK_FS + 16 * J + r16];
#pragma unroll
            for (int I = 0; I < 4; ++I) if (I < J) {
#pragma unroll
                for (int q = 0; q < 4; ++q) { const float a = Z[(r0 + r16) * CK_FS + 16 * I + 4 * q + g4]; const float bq = NAB[(16 * J + r16) * CK_FS + 16 * I + 4 * q + g4];
                    acc = __builtin_amdgcn_mfma_f32_16x16x4f32(a, bq, acc, 0, 0, 0); } }
#pragma unroll
            for (int rg = 0; rg < 4; ++rg) Z[(r0 + 4 * g4 + rg) * CK_FS + 16 * J + r16] = acc[rg];
            f32x4 wv = {0.f, 0.f, 0.f, 0.f};
#pragma unroll
            for (int q = 0; q < 4; ++q) { const float a = Z[(r0 + r16) * CK_FS + 16 * J + 4 * q + g4]; const float bq = TJ[J * 256 + (4 * q + g4) * 16 + r16];
                wv = __builtin_amdgcn_mfma_f32_16x16x4f32(a, bq, wv, 0, 0, 0); }
#pragma unroll
            for (int rg = 0; rg < 4; ++rg) { Z[(r0 + 4 * g4 + rg) * CK_FS + 16 * J + r16] = wv[rg]; st_bf(lds + L::WBF, r0 + 4 * g4 + rg, 16 * J + r16, wv[rg]); }
        }
    }
    __syncthreads();
    tsA[4] = TS_NOW();
    if (has_next) chunk_A_stage(C2, l, ncombo, nn);
    {
        f32x4 cp[2] = {{0.f, 0.f, 0.f, 0.f}, {0.f, 0.f, 0.f, 0.f}};
        mm2(cp, lds + L::WBF + 64 * CK_ST, lds + L::BBT, tm, tn0, lane);
        f32x4 cd[2] = {{0.f, 0.f, 0.f, 0.f}, {0.f, 0.f, 0.f, 0.f}};
        mm2(cd, lds + L::BBT, lds + L::WBF, tm, tn0, lane); mm2(cd, lds + L::KBT, lds + L::VT, tm, tn0, lane);
        f32x4 cy[2] = {{0.f, 0.f, 0.f, 0.f}, {0.f, 0.f, 0.f, 0.f}};
        mm2(cy, lds + L::WBF + 64 * CK_ST, lds + L::MBR, tm, tn0, lane);
        f32x4 cq[2] = {{0.f, 0.f, 0.f, 0.f}, {0.f, 0.f, 0.f, 0.f}};
        mm2(cq, lds + L::WBF, lds + L::MBR, tm, tn0, lane); mm2(cq, lds + L::VT, lds + L::MKR, tm, tn0, lane);
        bf16_t* Y = (bf16_t*)(Ap->ws + WS_Y) + ((size_t)b * SEQ + n * 64) * DM + (mix == 0 ? 512 : 768) + h * 64;
#pragma unroll
        for (int q = 0; q < 2; ++q) { const int jp = 16 * (tn0 + q) + r16, j0 = 16 * tm + 4 * g4; f32x4 v = cp[q];
#pragma unroll
            for (int rg = 0; rg < 4; ++rg) if (j0 + rg == jp) v[rg] += Gam[jp];
            const unsigned long long o = (unsigned long long)pk2(v[0], v[1]) | ((unsigned long long)pk2(v[2], v[3]) << 32);
            __hip_atomic_store((unsigned long long*)(PSTg + jp * 64 + j0), o, __ATOMIC_RELAXED, __HIP_MEMORY_SCOPE_AGENT);
            const unsigned long long o2 = (unsigned long long)pk2(cd[q][0], cd[q][1]) | ((unsigned long long)pk2(cd[q][2], cd[q][3]) << 32);
            __hip_atomic_store((unsigned long long*)(DSg + jp * 64 + j0), o2, __ATOMIC_RELAXED, __HIP_MEMORY_SCOPE_AGENT);
            const int t = jp; const u32x2 rt = *(const LAS u32x2*)(lds + L::RTS + t * CK_ST + j0 * 2);
            const unsigned long long o3 = (unsigned long long)pk2(cy[q][0] + bflo(rt.x), cy[q][1] + bfhi(rt.x)) | ((unsigned long long)pk2(cy[q][2] + bflo(rt.y), cy[q][3] + bfhi(rt.y)) << 32);
            __hip_atomic_store((unsigned long long*)(PYTg + t * 64 + j0), o3, __ATOMIC_RELAXED, __HIP_MEMORY_SCOPE_AGENT);
            const unsigned long long o4 = (unsigned long long)pk2(cq[q][0], cq[q][1]) | ((unsigned long long)pk2(cq[q][2], cq[q][3]) << 32);
            __hip_atomic_store((unsigned long long*)(Y + (size_t)t * DM + j0), o4, __ATOMIC_RELAXED, __HIP_MEMORY_SCOPE_AGENT); }
        (void)PUBLISH;
    }
    if (PROBE_STAT >= 0 && tid == 0) { tsA[5] = TS_NOW(); unsigned* st = (unsigned*)(Ap->ws + WS_CTL) + 32 + 24;
        for (int i = 0; i < 5; ++i) atomicAdd(st + i, (unsigned)(tsA[i + 1] - tsA[i]) >> 6); }
}

struct CPre { u32x4 s0, py; };
__device__ __forceinline__ void chunk_C_fetch(const Ctx& C, int combo, int n, CPre& r) {
    const ArgsP Ap = C.a; const int tid = C.wave * 64 + C.lane;
    const size_t slot = ((size_t)combo * 128 + n) * 4096;
    const bf16_t* DSg = (const bf16_t*)(Ap->ws + WS_DS) + slot; const bf16_t* PYTg = (const bf16_t*)(Ap->ws + WS_PYT) + slot;
    const int row = tid >> 3, c8 = (tid & 7) * 8;
    r.s0 = *(const u32x4*)(DSg - 4096 + row * 64 + c8);
    r.py = *(const u32x4*)(PYTg + row * 64 + c8);
}
__device__ __forceinline__ void chunk_C(const Ctx& C, int l, int combo, int n, CPre& pre, bool has_next, int ncombo, int nn) {
    int lane_o = C.lane; asm volatile("" : "+v"(lane_o));
    const ArgsP Ap = C.a; const int lane = lane_o, w = C.wave, tid = w * 64 + lane, r16 = lane & 15, g4 = lane >> 4;
    const int mix = combo >> 3, bh = combo & 7, b = bh >> 2, h = bh & 3;
    LAS unsigned char* lds = C.lds;
    LAS float* Yt = (LAS float*)(lds + 2 * CK_MAT);
    __syncthreads();
    { const int row = tid >> 3, c8 = (tid & 7) * 8; const u32x4 z4 = {0u, 0u, 0u, 0u};
      *(LAS u32x4*)(lds + row * CK_ST + c8 * 2) = n > 0 ? pre.s0 : z4; *(LAS u32x4*)(lds + CK_MAT + row * CK_ST + c8 * 2) = pre.py; }
    bf16_t* Y = (bf16_t*)(Ap->ws + WS_Y) + ((size_t)b * SEQ + n * 64 + 8 * w) * DM + (mix == 0 ? 512 : 768) + h * 64 + lane;
    const size_t m0 = (size_t)b * SEQ + n * 64 + 8 * w; const int ch = h * 64 + lane;
    float kc0, kc1 = 0.f;
    if (mix == 0) { kc0 = Ap->in[I_GNW][l * 256 + ch]; kc1 = Ap->in[I_GNB][l * 256 + ch]; } else kc0 = Ap->in[I_ONORM][l * 64 + lane];
    LAS unsigned char* stg = lds + 40960 + w * 3072;
    { const int tt = lane >> 3, c8 = (lane & 7) * 8;
      const bf16_t* ysrc = (const bf16_t*)(Ap->ws + WS_Y) + (m0 + tt) * DM + (mix == 0 ? 512 : 768) + h * 64 + c8;
      __builtin_amdgcn_global_load_lds((const unsigned*)ysrc, (LAS unsigned*)stg, 16, 0, 0);
      if (mix == 0) { const bf16_t* lo = (const bf16_t*)(Ap->ws + WS_XBF) + (m0 + tt) * 1024 + h * 64 + c8;
          __builtin_amdgcn_global_load_lds((const unsigned*)lo, (LAS unsigned*)(stg + 1024), 16, 0, 0); __builtin_amdgcn_global_load_lds((const unsigned*)(lo + 512), (LAS unsigned*)(stg + 2048), 16, 0, 0); }
      else { const bf16_t* zg = (const bf16_t*)(Ap->ws + WS_P) + (m0 + tt) * NIN + PGD + 768 + h * 64 + c8;
          __builtin_amdgcn_global_load_lds((const unsigned*)zg, (LAS unsigned*)(stg + 1024), 16, 0, 0); } }
    __builtin_amdgcn_sched_barrier(0);
    if (has_next) chunk_C_fetch(C, ncombo, nn, pre);
    __syncthreads();
    { const int tm = w >> 1, tn0 = 2 * (w & 1);
      f32x4 cy[2] = {{0.f, 0.f, 0.f, 0.f}, {0.f, 0.f, 0.f, 0.f}};
      mm2(cy, lds + CK_MAT, lds, tm, tn0, lane);
#pragma unroll
      for (int q = 0; q < 2; ++q)
#pragma unroll
          for (int rg = 0; rg < 4; ++rg) Yt[(16 * tm + 4 * g4 + rg) * CK_FS + 16 * (tn0 + q) + r16] = cy[q][rg]; }
    __syncthreads();
    if (has_next) asm volatile("s_waitcnt vmcnt(2)" ::: "memory"); else asm volatile("s_waitcnt vmcnt(0)" ::: "memory");
    const LAS bf16_t* sq_ = (const LAS bf16_t*)stg + lane;
    bf16_t qy[8], e0[8], e1[8];
#pragma unroll
    for (int tt = 0; tt < 8; ++tt) { qy[tt] = sq_[tt * 64]; e0[tt] = sq_[512 + tt * 64]; e1[tt] = mix == 0 ? sq_[1024 + tt * 64] : (bf16_t)0; }
    if (mix == 0) { const float gn_w = kc0, gn_b = kc1;
        float yv[8], sm[8], sq[8];
#pragma unroll
        for (int tt = 0; tt < 8; ++tt) yv[tt] = Yt[(8 * w + tt) * CK_FS + lane] + bf2f(qy[tt]);
        wave_sum8(yv, sm, lane);
#pragma unroll
        for (int tt = 0; tt < 8; ++tt) { yv[tt] -= sm[tt] * (1.f / 64.f); sm[tt] = yv[tt] * yv[tt]; }
        wave_sum8(sm, sq, lane);
#pragma unroll
        for (int tt = 0; tt < 8; ++tt) { const float yn = yv[tt] * rsqrtf(sq[tt] * (1.f / 64.f) + 64e-5f) * gn_w + gn_b; Y[(size_t)tt * DM] = (bf16_t)f2bf((yn + bf2f(e0[tt])) * bf2f(e1[tt])); } }
    else { const float onw = kc0;
        float ov[8], o2[8], sq[8];
#pragma unroll
        for (int tt = 0; tt < 8; ++tt) { ov[tt] = Yt[(8 * w + tt) * CK_FS + lane] + bf2f(qy[tt]); o2[tt] = ov[tt] * ov[tt]; }
        wave_sum8(o2, sq, lane);
#pragma unroll
        for (int tt = 0; tt < 8; ++tt) { const float rs = rsqrtf(sq[tt] * (1.f / 64.f) + NORM_EPS); Y[(size_t)tt * DM] = (bf16_t)f2bf(ov[tt] * rs * onw * siluf_(bf2f(e0[tt]))); } }
}

__device__ __forceinline__ void chunk_phaseB(const Ctx& C, int l, int combo, int vt) {
    const ArgsP Ap = C.a; const int lane = C.lane, w = C.wave, r16 = lane & 15, g4 = lane >> 4;
    unsigned* ctl = (unsigned*)(Ap->ws + WS_CTL);
    if (w != 0) {
        const int gw = C.bid * 7 + (w - 1), NGW = 64 * 7;
        convert_weights(C, 1, l == 0 ? CV_GU1 : (CV_GU2 | CV_D2), gw, NGW, (unsigned char*)Ap->out + OUT_ALT_W);
        return; }
    if (lane == 0) { unsigned sp = 0; while (__hip_atomic_load(ctl + CW_CNTA + 64 * (16 * l + combo), __ATOMIC_RELAXED, __HIP_MEMORY_SCOPE_AGENT) < 128u) { __builtin_amdgcn_s_sleep(2); if (++sp > (1u << 24)) break; } }
    __builtin_amdgcn_fence(__ATOMIC_ACQUIRE, "agent"); asm volatile("s_waitcnt vmcnt(0)" ::: "memory");
    const bf16_t* PSTg = (const bf16_t*)(Ap->ws + WS_PST) + (size_t)combo * 128 * 4096;
    bf16_t* DSg = (bf16_t*)(Ap->ws + WS_DS) + (size_t)combo * 128 * 4096;
    f32x4 st[4];
#pragma unroll
    for (int m = 0; m < 4; ++m) st[m] = (f32x4){0.f, 0.f, 0.f, 0.f};
    u32x2 pa[4][4][2][2], dd[4][4];
#define CKB_LOAD(sg, nn) do { const bf16_t* ps = PSTg + (size_t)(nn) * 4096; const bf16_t* ds = DSg + (size_t)(nn) * 4096; \
        _Pragma("unroll") for (int m = 0; m < 4; ++m) { dd[sg][m] = *(const u32x2*)(ds + (16 * vt + r16) * 64 + 16 * m + 4 * g4); \
            _Pragma("unroll") for (int s = 0; s < 2; ++s) { pa[sg][m][s][0] = *(const u32x2*)(ps + (16 * m + r16) * 64 + 32 * s + 4 * g4); pa[sg][m][s][1] = *(const u32x2*)(ps + (16 * m + r16) * 64 + 32 * s + 16 + 4 * g4); } } } while (0)
#define CKB_STEP(sg, nn) do { bf16x8 bb[2]; \
        _Pragma("unroll") for (int s = 0; s < 2; ++s) { u32x4 t4; t4.x = pk2(st[2 * s][0], st[2 * s][1]); t4.y = pk2(st[2 * s][2], st[2 * s][3]); t4.z = pk2(st[2 * s + 1][0], st[2 * s + 1][1]); t4.w = pk2(st[2 * s + 1][2], st[2 * s + 1][3]); bb[s] = __builtin_bit_cast(bf16x8, t4); } \
        f32x4 nw[4]; \
        _Pragma("unroll") for (int m = 0; m < 4; ++m) { f32x4 c = {bflo(dd[sg][m].x), bfhi(dd[sg][m].x), bflo(dd[sg][m].y), bfhi(dd[sg][m].y)}; \
            _Pragma("unroll") for (int s = 0; s < 2; ++s) { u32x4 a4; a4.x = pa[sg][m][s][0].x; a4.y = pa[sg][m][s][0].y; a4.z = pa[sg][m][s][1].x; a4.w = pa[sg][m][s][1].y; \
                c = __builtin_amdgcn_mfma_f32_16x16x32_bf16(__builtin_bit_cast(bf16x8, a4), bb[s], c, 0, 0, 0); } \
            nw[m] = c; } \
        asm volatile("" ::: "memory"); CKB_LOAD(sg, ((nn) + 4 < 128 ? (nn) + 4 : 127)); asm volatile("" ::: "memory"); __builtin_amdgcn_sched_barrier(0); \
        _Pragma("unroll") for (int m = 0; m < 4; ++m) { st[m] = nw[m]; u32x2 o; o.x = pk2(nw[m][0], nw[m][1]); o.y = pk2(nw[m][2], nw[m][3]); if (!dry) __hip_atomic_store((unsigned long long*)(DSg + (size_t)(nn) * 4096 + (16 * vt + r16) * 64 + 16 * m + 4 * g4), (unsigned long long)o.x | ((unsigned long long)o.y << 32), __ATOMIC_RELAXED, __HIP_MEMORY_SCOPE_AGENT); } } while (0)
    for (int pass = ((PROBE_DUP & 1024) ? 0 : 1); pass < 2; ++pass) {
    const bool dry = (pass == 0);
#pragma unroll
    for (int m = 0; m < 4; ++m) st[m] = (f32x4){0.f, 0.f, 0.f, 0.f};
    CKB_LOAD(0, 0); CKB_LOAD(1, 1); CKB_LOAD(2, 2); CKB_LOAD(3, 3); asm volatile("" ::: "memory"); __builtin_amdgcn_sched_barrier(0);
#pragma unroll 1
    for (int n = 0; n < 128; n += 4) { CKB_STEP(0, n); CKB_STEP(1, n + 1); CKB_STEP(2, n + 2); CKB_STEP(3, n + 3); }
    if (dry) { float s = 0.f; _Pragma("unroll") for (int m = 0; m < 4; ++m) s += st[m][0] + st[m][1] + st[m][2] + st[m][3]; if (s == 123.456f) *(float*)(DSg) = s; }
    }
#undef CKB_STEP
#undef CKB_LOAD
    asm volatile("s_waitcnt vmcnt(0)" ::: "memory");
    if (lane == 0) __hip_atomic_fetch_add(ctl + CW_FLAGB + 64 * (16 * l + combo), 1u, __ATOMIC_RELAXED, __HIP_MEMORY_SCOPE_AGENT);
}

constexpr int DS_CAP = 1024;
constexpr int DS_KI = 128 * 1024, DS_KIROW = 144, DS_KIBUF = 64 * DS_KIROW, DS_HIST = DS_KI + 2 * DS_KIBUF;
static_assert(DS_HIST + 8 * 1024 <= LDS_MISC, "dsa lds");

#define DPP_OP(v, ctrl, OP) v = v OP (unsigned)__builtin_amdgcn_update_dpp(0, (int)v, ctrl, 0xf, 0xf, true)
__device__ __forceinline__ unsigned wave_or(unsigned v) { DPP_OP(v, 0xB1, |); DPP_OP(v, 0x4E, |); DPP_OP(v, 0x141, |); DPP_OP(v, 0x140, |);
    return (unsigned)__builtin_amdgcn_readlane((int)v, 0) | (unsigned)__builtin_amdgcn_readlane((int)v, 16) | (unsigned)__builtin_amdgcn_readlane((int)v, 32) | (unsigned)__builtin_amdgcn_readlane((int)v, 48); }
__device__ __forceinline__ unsigned wave_and(unsigned v) { DPP_OP(v, 0xB1, &); DPP_OP(v, 0x4E, &); DPP_OP(v, 0x141, &); DPP_OP(v, 0x140, &);
    return (unsigned)__builtin_amdgcn_readlane((int)v, 0) & (unsigned)__builtin_amdgcn_readlane((int)v, 16) & (unsigned)__builtin_amdgcn_readlane((int)v, 32) & (unsigned)__builtin_amdgcn_readlane((int)v, 48); }
template <bool EXACT>
__device__ __forceinline__ unsigned wave_select_sparse(LAS unsigned* list, LAS unsigned* hist, int lane, int& nkeep, const int r2 = 256) {
    unsigned k[16]; unsigned ov = 0u, av = 0xffffffffu; int nv = 0;
#pragma unroll
    for (int j = 0; j < 16; ++j) { k[j] = list[j * 64 + lane]; ov |= k[j]; av &= k[j] ? k[j] : 0xffffffffu; nv += k[j] ? 1 : 0; }
    const int valid = (int)wave_sum((float)nv);
    const int R = valid < 256 ? valid : 256;
    unsigned prefix = 0u, mask = 0u, thr2 = 0u;
    if (valid > 256) {
        const unsigned orv = wave_or(ov), andv = wave_and(av), diff = orv ^ andv;
        const int hb = diff ? 31 - __builtin_clz(diff) : 0;
        mask = hb >= 31 ? 0u : ~((2u << hb) - 1u); prefix = andv & mask;
        int rem = 256, rem2 = r2; bool split = EXACT || r2 >= 256;
#pragma unroll 1
        for (int top = hb; top >= 0; top -= 8) {
            const int wdt = top + 1 < 8 ? top + 1 : 8; const int sh = top + 1 - wdt; const unsigned dm = (1u << wdt) - 1u;
            *(LAS u32x4*)(hist + 4 * lane) = (u32x4){0u, 0u, 0u, 0u};
            asm volatile("s_waitcnt lgkmcnt(0)" ::: "memory");
#pragma unroll
            for (int j = 0; j < 16; ++j) { if (k[j] != 0u && ((k[j] ^ prefix) & mask) == 0u) __hip_atomic_fetch_add((LAS unsigned*)&hist[(k[j] >> sh) & dm], 1u, __ATOMIC_RELAXED, __HIP_MEMORY_SCOPE_WORKGROUP); }
            asm volatile("s_waitcnt lgkmcnt(0)" ::: "memory");
            const u32x4 hv = *(const LAS u32x4*)(hist + 4 * lane);
            const int tl = (int)(hv[0] + hv[1] + hv[2] + hv[3]);
            int inc = tl;
            inc += __builtin_amdgcn_update_dpp(0, inc, 0x101, 0xf, 0xf, true); inc += __builtin_amdgcn_update_dpp(0, inc, 0x102, 0xf, 0xf, true);
            inc += __builtin_amdgcn_update_dpp(0, inc, 0x104, 0xf, 0xf, true); inc += __builtin_amdgcn_update_dpp(0, inc, 0x108, 0xf, 0xf, true);
            { const int t1 = __builtin_amdgcn_readlane(inc, 16), t2 = __builtin_amdgcn_readlane(inc, 32), t3 = __builtin_amdgcn_readlane(inc, 48); const int rw = lane >> 4;
              inc += (rw == 0) ? (t1 + t2 + t3) : (rw == 1) ? (t2 + t3) : (rw == 2) ? t3 : 0; }
            const int suf = inc - tl;
            const int s3 = suf + (int)hv[3], s2 = s3 + (int)hv[2], s1 = s2 + (int)hv[1], s0 = s1 + (int)hv[0];
            int digit = -1, above = 0, binsz = 0;
            if (s3 >= rem && suf < rem) { digit = 4 * lane + 3; above = suf; binsz = (int)hv[3]; }
            else if (s2 >= rem && s3 < rem) { digit = 4 * lane + 2; above = s3; binsz = (int)hv[2]; }
            else if (s1 >= rem && s2 < rem) { digit = 4 * lane + 1; above = s2; binsz = (int)hv[1]; }
            else if (s0 >= rem && s1 < rem) { digit = 4 * lane + 0; above = s1; binsz = (int)hv[0]; }
            const unsigned long long bal = __ballot(digit >= 0);
            const int srcl = __builtin_amdgcn_readfirstlane((int)__builtin_ctzll(bal | (1ull << 63)));
            digit = __builtin_amdgcn_readlane(digit, srcl); above = __builtin_amdgcn_readlane(above, srcl); binsz = __builtin_amdgcn_readlane(binsz, srcl);
            if (!EXACT && !split) {
                int d2 = -1;
                if (s3 >= rem2 && suf < rem2) d2 = 4 * lane + 3; else if (s2 >= rem2 && s3 < rem2) d2 = 4 * lane + 2; else if (s1 >= rem2 && s2 < rem2) d2 = 4 * lane + 1; else if (s0 >= rem2 && s1 < rem2) d2 = 4 * lane + 0;
                const unsigned long long bal2 = __ballot(d2 >= 0);
                d2 = __builtin_amdgcn_readlane(d2, __builtin_amdgcn_readfirstlane((int)__builtin_ctzll(bal2 | (1ull << 63))));
                if (d2 != digit) { split = true; thr2 = (prefix | ((unsigned)d2 << sh)) - 1u; } else rem2 -= above;
            }
            prefix |= (unsigned)digit << sh; mask |= dm << sh; rem -= above;
            if (!EXACT && (256 - rem) + binsz <= 320) break;
            if (EXACT && binsz == rem) break;
        }
    }
    const unsigned thr = valid > 256 ? prefix : 1u;
    int run = 0;
#pragma unroll
    for (int j = 0; j < 16; ++j) { const bool keep = k[j] >= thr;
        const unsigned long long bal = __ballot(keep);
        const int pos = run + (int)__builtin_amdgcn_mbcnt_hi((unsigned)(bal >> 32), __builtin_amdgcn_mbcnt_lo((unsigned)bal, 0u));
        if (keep) list[pos] = k[j];
        run += (int)__builtin_popcountll(bal); }
    const int kept = EXACT ? R : run;
#pragma unroll
    for (int j = 0; j < 16; ++j) if (j * 64 + lane >= kept) list[j * 64 + lane] = 0u;
    asm volatile("s_waitcnt lgkmcnt(0)" ::: "memory");
    nkeep = kept;
    return valid > 256 ? (EXACT ? prefix : (thr2 ? thr2 : prefix - 1u)) : 0u;
}
__device__ __forceinline__ unsigned wave_select256(LAS unsigned* list, int n, LAS unsigned* hist, int lane, unsigned* bad = nullptr) {
    unsigned k[16];
#pragma unroll
    for (int j = 0; j < 16; ++j) { const int i = j * 64 + lane; k[j] = (i < n) ? list[i] : 0u; }
    unsigned prefix = 0u, mask = 0u; int rem = 256;
#pragma unroll 1
    for (int pass = 0; pass < 4; ++pass) {
        const int sh = 24 - 8 * pass;
        *(LAS u32x4*)(hist + 4 * lane) = (u32x4){0u, 0u, 0u, 0u};
        asm volatile("s_waitcnt lgkmcnt(0)" ::: "memory");
#pragma unroll
        for (int j = 0; j < 16; ++j) { const int i = j * 64 + lane; if (i < n && ((k[j] ^ prefix) & mask) == 0u) __hip_atomic_fetch_add((LAS unsigned*)&hist[(k[j] >> sh) & 255u], 1u, __ATOMIC_RELAXED, __HIP_MEMORY_SCOPE_WORKGROUP); }
        asm volatile("s_waitcnt lgkmcnt(0)" ::: "memory");
        const u32x4 hv = *(const LAS u32x4*)(hist + 4 * lane);
        const int tl = (int)(hv[0] + hv[1] + hv[2] + hv[3]);
        int inc = tl;
        inc += __builtin_amdgcn_update_dpp(0, inc, 0x101, 0xf, 0xf, true); inc += __builtin_amdgcn_update_dpp(0, inc, 0x102, 0xf, 0xf, true);
        inc += __builtin_amdgcn_update_dpp(0, inc, 0x104, 0xf, 0xf, true); inc += __builtin_amdgcn_update_dpp(0, inc, 0x108, 0xf, 0xf, true);
        { const int t1 = __builtin_amdgcn_readlane(inc, 16), t2 = __builtin_amdgcn_readlane(inc, 32), t3 = __builtin_amdgcn_readlane(inc, 48); const int rw = lane >> 4;
          inc += (rw == 0) ? (t1 + t2 + t3) : (rw == 1) ? (t2 + t3) : (rw == 2) ? t3 : 0; }
#if defined(SELFCHECK)
        { int chk = tl;
#pragma unroll
          for (int o = 1; o < 64; o <<= 1) { const int v = __shfl_down(chk, o); if (lane + o < 64) chk += v; }
          if (__any(chk != inc)) *bad = 1u; }
#endif
        const int suf = inc - tl;
        const int s3 = suf + (int)hv[3], s2 = s3 + (int)hv[2], s1 = s2 + (int)hv[1], s0 = s1 + (int)hv[0];
        int digit = -1, above = 0;
        if (s3 >= rem && suf < rem) { digit = 4 * lane + 3; above = suf; }
        else if (s2 >= rem && s3 < rem) { digit = 4 * lane + 2; above = s3; }
        else if (s1 >= rem && s2 < rem) { digit = 4 * lane + 1; above = s2; }
        else if (s0 >= rem && s1 < rem) { digit = 4 * lane + 0; above = s1; }
        const unsigned long long bal = __ballot(digit >= 0);
        const int src = (int)__builtin_ctzll(bal | (1ull << 63));
        digit = __shfl(digit, src); above = __shfl(above, src);
        prefix |= (unsigned)digit << sh; mask |= 0xffu << sh; rem -= above;
    }
    int run = 0;
#pragma unroll
    for (int j = 0; j < 16; ++j) { const int i = j * 64 + lane; const bool keep = (i < n) && (k[j] >= prefix);
        const unsigned long long bal = __ballot(keep);
        const int pos = run + (int)__builtin_amdgcn_mbcnt_hi((unsigned)(bal >> 32), __builtin_amdgcn_mbcnt_lo((unsigned)bal, 0u));
        if (keep) list[pos] = k[j];
        run += (int)__builtin_popcountll(bal); }
    asm volatile("s_waitcnt lgkmcnt(0)" ::: "memory");
    return prefix;
}

typedef short v4i16_t __attribute__((ext_vector_type(4)));
__device__ __forceinline__ u32x2 lds_tr16(const LAS unsigned char* p) { return __builtin_bit_cast(u32x2, __builtin_amdgcn_ds_read_tr16_b64_v4i16((LAS v4i16_t*)p)); }
__device__ __forceinline__ float key_floor(unsigned th) {
    if (th == 0u) return -INFINITY;
    const unsigned u = th & 0xffffe000u; return __builtin_bit_cast(float, (u & 0x80000000u) ? (u & 0x7fffffffu) : ~u);
}
__device__ __forceinline__ float relu1(float x) { const int i = __builtin_bit_cast(int, x); return __builtin_bit_cast(float, i > 0 ? i : 0); }
constexpr int DS_VROW = 288;

__device__ __forceinline__ void rope_frag(bf16x8& lo, bf16x8& hi, const f32x4 (&cs)[4], const float (&slo)[8], const float (&shi)[8]) {
    const u32x4 ul = __builtin_bit_cast(u32x4, lo), uh = __builtin_bit_cast(u32x4, hi); u32x4 ol, oh;
#pragma unroll
    for (int p2 = 0; p2 < 4; ++p2) {
        const float a0 = bflo(ul[p2]) * slo[2 * p2], a1 = bfhi(ul[p2]) * slo[2 * p2 + 1], b0 = bflo(uh[p2]) * shi[2 * p2], b1 = bfhi(uh[p2]) * shi[2 * p2 + 1];
        const f32x4 c = cs[p2];
        ol[p2] = pk2(a0 * c[0] - b0 * c[1], a1 * c[2] - b1 * c[3]); oh[p2] = pk2(b0 * c[0] + a0 * c[1], b1 * c[2] + a1 * c[3]); }
    lo = __builtin_bit_cast(bf16x8, ol); hi = __builtin_bit_cast(bf16x8, oh);
}

__device__ __forceinline__ void dsa_item_impl(const Ctx& C, int l, int b, int qt, const bf16_t* __restrict__ P, bf16_t* __restrict__ Y) {
    const ArgsP Ap = C.a;
    int lane_o = C.lane; asm volatile("" : "+v"(lane_o));
    const int lane = lane_o, w = C.wave, tid = w * 64 + lane, hl = lane >> 5, l32 = lane & 31, r16 = lane & 15, g4 = lane >> 4;
    const int t0 = qt * 32;
    const size_t mb = (size_t)b * SEQ;
    LAS unsigned* cand = (LAS unsigned*)(C.lds) + w * 4 * DS_CAP;
    LAS unsigned* hist = (LAS unsigned*)(C.lds + DS_HIST) + w * 256;
#if defined(SELFCHECK)
    unsigned* bad = (unsigned*)(Ap->ws + WS_CTL) + 16;
#else
    unsigned* bad = nullptr;
#endif
    bf16x8 af[4];
    { const int rho = l32; const int qq = 2 * ((rho >> 2) & 1) + (rho >> 4), hd = (rho & 3) + 4 * ((rho >> 3) & 1);
      const bf16_t* src = P + (mb + t0 + 4 * w + qq) * NIN + PQI + hd * 64 + 8 * hl;
#pragma unroll
      for (int s = 0; s < 4; ++s) af[s] = *(const bf16x8*)(src + 16 * s);
      const f32x4* csq = (const f32x4*)(Ap->ws + WS_ROPE) + (size_t)(t0 + 4 * w + qq) * 16;
      const float one8[8] = {1.f, 1.f, 1.f, 1.f, 1.f, 1.f, 1.f, 1.f};
#pragma unroll
      for (int s = 0; s < 2; ++s) { f32x4 cs4[4];
#pragma unroll
          for (int e = 0; e < 4; ++e) cs4[e] = csq[(8 * hl + 16 * s) / 2 + e];
          rope_frag(af[s], af[s + 2], cs4, one8, one8); } }
    float wA[8], wB[8];
    { const bf16_t* ra = P + (mb + t0 + 4 * w + 2 * hl) * NIN + PWI; const u32x4 va = *(const u32x4*)ra, vb = *(const u32x4*)(ra + NIN);
#pragma unroll
      for (int i = 0; i < 4; ++i) { wA[2 * i] = bflo(va[i]); wA[2 * i + 1] = bfhi(va[i]); wB[2 * i] = bflo(vb[i]); wB[2 * i + 1] = bfhi(vb[i]); } }
    const int tA = t0 + 4 * w + 2 * hl, tB = tA + 1;
    int cnt0 = 0, cnt1 = 0, cnt2 = 0, cnt3 = 0; unsigned th0 = 0u, th1 = 0u, th2 = 0u, th3 = 0u;
    unsigned long long ts0 = 0, ts1 = 0, tsel_ = 0; int nsel_ = 0;
    const int NT = (t0 + 32 + 63) >> 6;
#pragma unroll 1
    for (int attempt = 0; attempt < 2; ++attempt) {
    cnt0 = cnt1 = cnt2 = cnt3 = 0; th0 = th1 = th2 = th3 = 0u;
    __syncthreads();
    ts0 = TS_NOW();
    const bf16_t* kisrc = P + (mb + (tid >> 3)) * NIN + PKI + 8 * (tid & 7);
    LAS unsigned char* kib = C.lds + DS_KI; const int kiw = (tid >> 3) * DS_KIROW + (tid & 7) * 16;
    const int kir = l32 * DS_KIROW + 16 * hl;
    LAS unsigned* thl = (LAS unsigned*)(C.lds + LDS_MISC) + 48 + 4 * w;
    LAS unsigned* nkl = (LAS unsigned*)(C.lds + LDS_MISC) + 16 + 4 * w;
    volatile LAS unsigned* creq = (volatile LAS unsigned*)(C.lds + LDS_MISC) + 80;
    LAS unsigned* thm = (LAS unsigned*)(C.lds + LDS_MISC) + 96 + 4 * w;
    volatile LAS unsigned* redo = (volatile LAS unsigned*)(C.lds + LDS_MISC) + 81;
    if (lane < 4) { thl[lane] = 0u; thm[lane] = 0u; }
    volatile LAS unsigned* qctr = (volatile LAS unsigned*)(C.lds + LDS_MISC) + 82;
    if (tid == 0) { creq[0] = 0xffffffffu; redo[0] = 0u; qctr[0] = 0u; }
#pragma unroll
    for (int j = 0; j < 16; ++j) *(LAS u32x4*)(cand + 4 * (j * 64 + lane)) = (u32x4){0u, 0u, 0u, 0u};
    LAS unsigned* colA = cand + (2 * hl) * DS_CAP + l32; LAS unsigned* colB = colA + DS_CAP;
    int nA = 0, nB = 0;
    float fA = -INFINITY, fB = -INFINITY;
    u32x4 kreg0, kreg1;
    const int NT2 = (NT + 1) & ~1;
#define KI_LOAD(rg, tile) rg = *(const u32x4*)(kisrc + (size_t)((tile) < NT ? (tile) : NT - 1) * 64 * NIN)
    f32x16 acc[2][2];
    { KI_LOAD(kreg0, 0); KI_LOAD(kreg1, 1); *(LAS u32x4*)(kib + kiw) = kreg0; }
    __syncthreads();
    { const LAS unsigned char* kb_ = kib + kir;
#pragma unroll
      for (int nt = 0; nt < 2; ++nt) { acc[0][nt] = (f32x16){};
#pragma unroll
          for (int s = 0; s < 4; ++s) { const bf16x8 bfr = *(const LAS bf16x8*)(kb_ + nt * 32 * DS_KIROW + 32 * s); acc[0][nt] = __builtin_amdgcn_mfma_f32_32x32x16_bf16(af[s], bfr, acc[0][nt], 0, 0, 0); } } }
    *(LAS u32x4*)(kib + DS_KIBUF + kiw) = kreg1;
    KI_LOAD(kreg0, 2); KI_LOAD(kreg1, 3);
#pragma unroll 1
    for (int kt2 = 0; kt2 < NT2; kt2 += 2)
#pragma unroll
    for (int u = 0; u < 2; ++u) { const int kt = kt2 + u;
        __syncthreads();
        { const LAS unsigned char* kb_ = kib + (u ^ 1) * DS_KIBUF + kir;
#pragma unroll
          for (int nt = 0; nt < 2; ++nt) { acc[u ^ 1][nt] = (f32x16){};
#pragma unroll
              for (int s = 0; s < 4; ++s) { const bf16x8 bfr = *(const LAS bf16x8*)(kb_ + nt * 32 * DS_KIROW + 32 * s); acc[u ^ 1][nt] = __builtin_amdgcn_mfma_f32_32x32x16_bf16(af[s], bfr, acc[u ^ 1][nt], 0, 0, 0); } } }
        { const int nm = nA > nB ? nA : nB; const bool full = __any(nm >= 30); const bool all_now = ((int)creq[0] == kt);
          if (full || (all_now && __any(nm >= 16))) {
              const unsigned long long tq0_ = TS_NOW();
              int r2 = 256;
              if (attempt == 0) { const float rho = 256.f * (float)(kt * 64) / (float)(t0 + 1); const int rr = PROBE_FORCE_REDO ? (int)(rho * 0.6f) + 1 : (int)(rho + 8.f + 4.f * __builtin_sqrtf(4.f + rho)); r2 = rr < 256 ? rr : 256; }
#pragma unroll 1
              for (int q = 0; q < 4; ++q) { const int myn = (q & 1) ? nB : nA; const bool mine = (q >> 1) == hl;
                  if (__any(mine && myn >= 16)) { int nk; const unsigned t = wave_select_sparse<false>(cand + q * DS_CAP, hist, lane, nk, r2); if (lane == 0) { thl[q] = t; if (t > thm[q]) thm[q] = t; }
                      const int rows = (nk + 31 - l32) >> 5;
                      if (mine) { if (q & 1) nB = rows; else nA = rows; } ++nsel_; } }
              tsel_ += TS_NOW() - tq0_;
              { const u32x4 tv = *(const LAS u32x4*)thl;
                fA = key_floor(hl ? tv.z : tv.x); fB = key_floor(hl ? tv.w : tv.y); }
          } else if (__any(nm >= 28) && lane == 0) creq[0] = (unsigned)(kt + 1); }
#pragma unroll
        for (int nt = 0; nt < 2; ++nt) {
            float sA = 0.f, sB = 0.f;
#pragma unroll
            for (int i = 0; i < 8; ++i) { sA = fmaf(relu1(acc[u][nt][i]), wA[i], sA); sB = fmaf(relu1(acc[u][nt][8 + i]), wB[i], sB); }
            const int sidx = kt * 64 + nt * 32 + l32;
            const bool cA = (sidx <= tA) && (sA >= fA), cB = (sidx <= tB) && (sB >= fB);
            if (__builtin_amdgcn_ballot_w64(cA || cB) != 0ull) {
                const int iA = __builtin_bit_cast(int, sA), iB = __builtin_bit_cast(int, sB);
                const unsigned uA = (unsigned)iA ^ ((unsigned)(iA >> 31) | 0x80000000u), uB = (unsigned)iB ^ ((unsigned)(iB >> 31) | 0x80000000u);
                const unsigned keyA = (uA & 0xffffe000u) | (unsigned)(8191 - sidx), keyB = (uB & 0xffffe000u) | (unsigned)(8191 - sidx);
                if (cA) { colA[nA * 32] = keyA; ++nA; }
                if (cB) { colB[nB * 32] = keyB; ++nB; }
            }
        }
        if (u) { *(LAS u32x4*)(kib + DS_KIBUF + kiw) = kreg1; KI_LOAD(kreg1, kt + 4); }
        else   { *(LAS u32x4*)(kib + kiw) = kreg0; KI_LOAD(kreg0, kt + 4); }
        asm volatile("" ::: "memory");
    }
#undef KI_LOAD
    asm volatile("s_waitcnt lgkmcnt(0)" ::: "memory");
    ts1 = TS_NOW();
#pragma unroll 1
    for (int q = 0; q < 4; ++q) { int nk; (void)wave_select_sparse<true>(cand + q * DS_CAP, hist, lane, nk); if (lane == 0) nkl[q] = (unsigned)nk;
        if (attempt == 0) { const unsigned tm = thm[q]; const u32x4 kv = *(const LAS u32x4*)(cand + q * DS_CAP + 4 * lane);
            const unsigned a = kv.x < kv.y ? kv.x : kv.y, c = kv.z < kv.w ? kv.z : kv.w, mn = a < c ? a : c;
            if (__any(tm != 0u && mn <= tm) && lane == 0) redo[0] = 1u; } }
    asm volatile("s_waitcnt lgkmcnt(0)" ::: "memory");
    { const u32x4 cv = *(const LAS u32x4*)nkl; cnt0 = __builtin_amdgcn_readfirstlane(cv.x); cnt1 = __builtin_amdgcn_readfirstlane(cv.y); cnt2 = __builtin_amdgcn_readfirstlane(cv.z); cnt3 = __builtin_amdgcn_readfirstlane(cv.w); }
    { u32x4 t1 = *(const LAS u32x4*)(cand + 1 * DS_CAP + 4 * lane), t2 = *(const LAS u32x4*)(cand + 2 * DS_CAP + 4 * lane), t3 = *(const LAS u32x4*)(cand + 3 * DS_CAP + 4 * lane);
      *(LAS u32x4*)(cand + 256 + 4 * lane) = t1; *(LAS u32x4*)(cand + 512 + 4 * lane) = t2; *(LAS u32x4*)(cand + 768 + 4 * lane) = t3; }
    __syncthreads();
    if (attempt == 0 && redo[0] != 0u) { if (PROBE_STAT >= 0 && tid == 0) atomicAdd((unsigned*)(Ap->ws + WS_CTL) + 32 + 21, 10000u); continue; }
    break;
    }
    LAS unsigned char* vt = (LAS unsigned char*)(cand + 1024);
    const unsigned long long ts2 = TS_NOW();
#pragma unroll 1
    for (;;) {
        int qi_ = 0; if (lane == 0) qi_ = (int)__hip_atomic_fetch_add((LAS unsigned*)(C.lds + LDS_MISC) + 82, 1u, __ATOMIC_RELAXED, __HIP_MEMORY_SCOPE_WORKGROUP);
        const int qi = __builtin_amdgcn_readfirstlane(qi_);
        if (qi >= 32) break;
        const int nsel = __builtin_amdgcn_readfirstlane((int)((const volatile LAS unsigned*)(C.lds + LDS_MISC))[16 + qi]);
        const LAS unsigned* lst = (const LAS unsigned*)(C.lds) + (qi >> 2) * 4 * DS_CAP + (qi & 3) * 256;
        const size_t mq = mb + t0 + qi;
        const bf16_t* qrow = P + mq * NIN + PQ;
        bf16x8 bq0[2], bq1[2];
        bf16x8 qv[2];
#pragma unroll
        for (int s = 0; s < 2; ++s) qv[s] = *(const bf16x8*)(qrow + (r16 & 7) * 64 + 32 * s + 8 * g4);
        const float* qn = Ap->in[I_QN] + l * 64 + 8 * g4;
        const f32x4 g0 = *(const f32x4*)qn, g1 = *(const f32x4*)(qn + 4), g2 = *(const f32x4*)(qn + 32), g3 = *(const f32x4*)(qn + 36);
        const f32x4* csq = (const f32x4*)(Ap->ws + WS_ROPE) + (size_t)(t0 + qi) * 16 + 4 * g4;
        f32x4 cs4[4];
#pragma unroll
        for (int e = 0; e < 4; ++e) cs4[e] = csq[e];
        __builtin_amdgcn_sched_barrier(0);
#define Q_PREP() do { \
          float ss = 0.f; \
          { const u32x4 u0 = __builtin_bit_cast(u32x4, qv[0]), u1 = __builtin_bit_cast(u32x4, qv[1]); \
            _Pragma("unroll") for (int e = 0; e < 4; ++e) { const float x0 = bflo(u0[e]), x1 = bfhi(u0[e]), y0 = bflo(u1[e]), y1 = bfhi(u1[e]); ss += (x0 * x0 + x1 * x1) + (y0 * y0 + y1 * y1); } } \
          ss += __shfl_xor(ss, 16); ss += __shfl_xor(ss, 32); \
          const float rs = rsqrtf(ss * (1.f / 64.f) + NORM_EPS) * 0.125f; \
          const float slo[8] = {rs * g0[0], rs * g0[1], rs * g0[2], rs * g0[3], rs * g1[0], rs * g1[1], rs * g1[2], rs * g1[3]}; \
          const float shi[8] = {rs * g2[0], rs * g2[1], rs * g2[2], rs * g2[3], rs * g3[0], rs * g3[1], rs * g3[2], rs * g3[3]}; \
          rope_frag(qv[0], qv[1], cs4, slo, shi); \
          const bf16x8 z8 = {0, 0, 0, 0, 0, 0, 0, 0}; \
          _Pragma("unroll") for (int s = 0; s < 2; ++s) { bq0[s] = r16 < 4 ? qv[s] : z8; bq1[s] = (r16 >= 4 && r16 < 8) ? qv[s] : z8; } } while (0)
        const bf16_t* vsrc = P + mb * NIN + PV + 8 * r16;
        f32x4 sc[16];
#pragma unroll
        for (int kb = 0; kb < 4; ++kb) {
            bf16x8 kk[4][4];
#pragma unroll
            for (int i = 0; i < 4; ++i) { const int idx = 8191 - (int)(lst[16 * (4 * kb + i) + r16] & 8191u);
                const bf16_t* krow = P + (mb + idx) * NIN + PK + 8 * g4;
                kk[i][0] = *(const bf16x8*)krow; kk[i][1] = *(const bf16x8*)(krow + 32); kk[i][2] = *(const bf16x8*)(krow + 64); kk[i][3] = *(const bf16x8*)(krow + 96); }
            __builtin_amdgcn_sched_barrier(0);
            if (kb == 0) { Q_PREP(); __builtin_amdgcn_sched_barrier(0); }
#pragma unroll
            for (int i = 0; i < 4; ++i) { f32x4 c = {0.f, 0.f, 0.f, 0.f};
                c = __builtin_amdgcn_mfma_f32_16x16x32_bf16(kk[i][0], bq0[0], c, 0, 0, 0); c = __builtin_amdgcn_mfma_f32_16x16x32_bf16(kk[i][1], bq0[1], c, 0, 0, 0);
                c = __builtin_amdgcn_mfma_f32_16x16x32_bf16(kk[i][2], bq1[0], c, 0, 0, 0); c = __builtin_amdgcn_mfma_f32_16x16x32_bf16(kk[i][3], bq1[1], c, 0, 0, 0);
                sc[4 * kb + i] = c; }
            __builtin_amdgcn_sched_barrier(0);
        }
        u32x4 vg[3][8];
#define V_LOAD(sg, step) do { _Pragma("unroll") for (int j = 0; j < 8; ++j) { const int idx = 8191 - (int)(lst[32 * (step) + g4 + 4 * j] & 8191u); vg[sg][j] = *(const u32x4*)(vsrc + (size_t)idx * NIN); } } while (0)
        V_LOAD(0, 0); V_LOAD(1, 1); V_LOAD(2, 2);
        __builtin_amdgcn_sched_barrier(0);
        if (nsel < 256) {
#pragma unroll
            for (int kt = 0; kt < 16; ++kt)
#pragma unroll
                for (int rg = 0; rg < 4; ++rg) if (16 * kt + 4 * g4 + rg >= nsel) sc[kt][rg] = -INFINITY;
        }
        float mx = -INFINITY;
#pragma unroll
        for (int kt = 0; kt < 16; ++kt) mx = fmaxf(fmaxf(mx, fmaxf(sc[kt][0], sc[kt][1])), fmaxf(sc[kt][2], sc[kt][3]));
        mx = fmaxf(mx, __shfl_xor(mx, 16)); mx = fmaxf(mx, __shfl_xor(mx, 32));
        float sm = 0.f;
#pragma unroll
        for (int kt = 0; kt < 16; ++kt)
#pragma unroll
            for (int rg = 0; rg < 4; ++rg) { const float p = __expf(sc[kt][rg] - mx); sc[kt][rg] = p; sm += p; }
        sm += __shfl_xor(sm, 16); sm += __shfl_xor(sm, 32);
        const float inv = 1.f / sm;
        u32x4 pb[8];
#pragma unroll
        for (int s = 0; s < 8; ++s) { pb[s].x = pk2(sc[2 * s][0], sc[2 * s][1]); pb[s].y = pk2(sc[2 * s][2], sc[2 * s][3]); pb[s].z = pk2(sc[2 * s + 1][0], sc[2 * s + 1][1]); pb[s].w = pk2(sc[2 * s + 1][2], sc[2 * s + 1][3]); }
        const bool isg0 = r16 < 4, isg1 = (r16 >= 4) && (r16 < 8);
        f32x4 o[4];
#pragma unroll
        for (int mt = 0; mt < 4; ++mt) o[mt] = (f32x4){0.f, 0.f, 0.f, 0.f};
        const int trb = (4 * g4 + (r16 >> 2)) * DS_VROW + 8 * (r16 & 3);
#define V_STEP(sg, s_) do { const int s = (s_); \
            _Pragma("unroll") for (int j = 0; j < 8; ++j) *(LAS u32x4*)(vt + (g4 + 4 * j) * DS_VROW + r16 * 16) = vg[sg][j]; \
            if (s + 3 < 8) { V_LOAD(sg, s + 3); } \
            asm volatile("" ::: "memory"); __builtin_amdgcn_sched_barrier(0); \
            const u32x4 z4 = {0u, 0u, 0u, 0u}; const u32x4 ps = pb[s]; \
            const bf16x8 p0 = __builtin_bit_cast(bf16x8, isg0 ? ps : z4), p1 = __builtin_bit_cast(bf16x8, isg1 ? ps : z4); \
            _Pragma("unroll") for (int mt = 0; mt < 4; ++mt) { \
                const u32x2 a00 = lds_tr16(vt + trb + mt * 32), a01 = lds_tr16(vt + trb + 16 * DS_VROW + mt * 32); \
                const u32x2 a10 = lds_tr16(vt + trb + 128 + mt * 32), a11 = lds_tr16(vt + trb + 16 * DS_VROW + 128 + mt * 32); \
                const u32x4 A0 = {a00.x, a00.y, a01.x, a01.y}, A1 = {a10.x, a10.y, a11.x, a11.y}; \
                o[mt] = __builtin_amdgcn_mfma_f32_16x16x32_bf16(__builtin_bit_cast(bf16x8, A0), p0, o[mt], 0, 0, 0); \
                o[mt] = __builtin_amdgcn_mfma_f32_16x16x32_bf16(__builtin_bit_cast(bf16x8, A1), p1, o[mt], 0, 0, 0); } } while (0)
        V_STEP(0, 0); V_STEP(1, 1); V_STEP(2, 2); V_STEP(0, 3); V_STEP(1, 4); V_STEP(2, 5); V_STEP(0, 6); V_STEP(1, 7);
#undef V_STEP
#undef V_LOAD
        if (r16 < 8) {
#pragma unroll
            for (int mt = 0; mt < 4; ++mt) { u32x2 ov; ov.x = pk2(o[mt][0] * inv, o[mt][1] * inv); ov.y = pk2(o[mt][2] * inv, o[mt][3] * inv);
                *(u32x2*)(Y + mq * DM + r16 * 64 + 16 * mt + 4 * g4) = ov; }
        }
    }
    if (PROBE_STAT >= 0 && tid == 0) { unsigned* st = (unsigned*)(Ap->ws + WS_CTL) + 32 + 16; const unsigned long long ts3 = TS_NOW();
        atomicAdd(st + 3, (unsigned)tsel_ >> 8); atomicAdd(st + 4, (unsigned)nsel_ * 16u); atomicAdd(st + 0, (unsigned)(ts1 - ts0) >> 8); atomicAdd(st + 1, (unsigned)(ts2 - ts1) >> 8); atomicAdd(st + 2, (unsigned)(ts3 - ts2) >> 8); }
}

__device__ __forceinline__ void dsa_item(const Ctx& C, int l, int b, int qt) { dsa_item_impl(C, l, b, qt, (const bf16_t*)(C.a->ws + WS_P), (bf16_t*)(C.a->ws + WS_Y)); }

__device__ __forceinline__ void mixers_phase(const Ctx& C, int l) {
    const ArgsP Ap = C.a;
    unsigned* ctl = (unsigned*)(Ap->ws + WS_CTL);
    const int sub = Ap->sub;
    const unsigned long long t_ph0 = TS_NOW();
#define MX_STAT(k) do { if (PROBE_STAT >= 0 && C.tid == 0) atomicMax(ctl + 32 + 8 * l + (k), (unsigned)(TS_NOW() - t_ph0)); } while (0)
    if (sub < 0 || sub == 0) {
        int nA = 0;
        __syncthreads();
        if (C.bid < 2048) chunk_A_stage(C, l, C.bid & 15, C.bid >> 4);
        float kc[12]; int kcombo = -1;
        for (int it = C.bid; it < 2048; it += C.G) { const int itn = it + C.G;
            if ((it & 15) != kcombo) { kcombo = it & 15; chunk_A_consts(C, l, kcombo, kc); }
            chunk_A<>(C, l, it & 15, it >> 4, itn < 2048, itn & 15, itn >> 4, kc); ++nA; }
        asm volatile("s_waitcnt vmcnt(0)" ::: "memory");
        __syncthreads();
        if (C.tid == 0) { if ((C.G & 15) == 0) __hip_atomic_fetch_add(ctl + CW_CNTA + 64 * (16 * l + (C.bid & 15)), (unsigned)nA, __ATOMIC_RELAXED, __HIP_MEMORY_SCOPE_AGENT);
                          else for (int it = C.bid; it < 2048; it += C.G) __hip_atomic_fetch_add(ctl + CW_CNTA + 64 * (16 * l + (it & 15)), 1u, __ATOMIC_RELAXED, __HIP_MEMORY_SCOPE_AGENT); }
    }
    MX_STAT(0);
    if ((sub < 0 || sub == 1) && C.bid < 64) { chunk_phaseB(C, l, C.bid >> 2, C.bid & 3); MX_STAT(1); }
    if (!(sub < 0 || sub == 2)) return;
    unsigned* work = ctl + CW_WORK + 256 * l;
    volatile LAS unsigned* misc = (volatile LAS unsigned*)(C.lds + LDS_MISC);
    const int pref = (int)(xb_xcc_id() & 1u);
    bool bready = false; int dsa_open = 3;
    bool first_ = true; unsigned long long tqa_ = 0;
    for (;;) {
        __syncthreads();
        if (first_ && C.bid < 64) MX_STAT(4);
        first_ = false;
        const unsigned long long tqb_ = TS_NOW();
        if (PROBE_STAT >= 0 && C.tid == 0 && tqa_ != 0) atomicAdd(ctl + 32 + 22, (unsigned)(tqb_ - tqa_) >> 8);
        if (C.tid == 0) {
            unsigned r = 0xffffffffu;
            if (dsa_open & (1 << pref)) { const unsigned i0 = __hip_atomic_fetch_add(work + 64 * pref, 1u, __ATOMIC_RELAXED, __HIP_MEMORY_SCOPE_AGENT); if (i0 < 256u) r = (unsigned)pref * 256u + i0; else dsa_open &= ~(1 << pref); }
            if (r == 0xffffffffu && (dsa_open & (2 >> pref))) { const unsigned i1 = __hip_atomic_fetch_add(work + 64 * (1 - pref), 1u, __ATOMIC_RELAXED, __HIP_MEMORY_SCOPE_AGENT); if (i1 < 256u) r = (unsigned)(1 - pref) * 256u + i1; else dsa_open &= ~(2 >> pref); }
            if (r == 0xffffffffu) r = 512u + 4u * __hip_atomic_fetch_add(work + 128, 1u, __ATOMIC_RELAXED, __HIP_MEMORY_SCOPE_AGENT);
            misc[0] = r; }
        __syncthreads();
        const int it = (int)misc[0];
        if (PROBE_STAT >= 0 && C.tid == 0 && it < 512) atomicAdd(ctl + 32 + 23, (unsigned)(TS_NOW() - tqb_));
        if (it >= 512 + 2048) break;
        if (it >= 512 && !bready) MX_STAT(2);
        if (it < 512) { dsa_item(C, l, it >> 8, 255 - (it & 255)); tqa_ = TS_NOW(); continue; }
        tqa_ = 0;
        if (!bready) {
            if (C.tid == 0) { unsigned sp = 0; for (;;) { unsigned ok = 1u;
                    for (int c = 0; c < 16; ++c) ok &= (__hip_atomic_load(ctl + CW_FLAGB + 64 * (16 * l + c), __ATOMIC_RELAXED, __HIP_MEMORY_SCOPE_AGENT) >= 4u) ? 1u : 0u;
                    if (ok || ++sp > (1u << 24)) break; __builtin_amdgcn_s_sleep(2); }
                __builtin_amdgcn_fence(__ATOMIC_ACQUIRE, "agent"); asm volatile("s_waitcnt vmcnt(0)" ::: "memory"); }
            __syncthreads(); bready = true; }
        const int ci = it - 512;
        CPre pre; chunk_C_fetch(C, ci & 15, ci >> 4, pre);
#pragma unroll 1
        for (int cj = ci; cj < ci + 4; ++cj) chunk_C(C, l, cj & 15, cj >> 4, pre, cj + 1 < ci + 4, (cj + 1) & 15, (cj + 1) >> 4);
    }
    __syncthreads();
    MX_STAT(3);
}

constexpr int NPHASE = 17;
__global__ void __launch_bounds__(512, 2) fwd_kernel(Args args_unused) {
    extern __shared__ __attribute__((aligned(16))) unsigned char lds_raw[];
    ArgsP ap0 = (ArgsP)__builtin_amdgcn_kernarg_segment_ptr();
    Ctx C; C.lds = (LAS unsigned char*)lds_raw; C.tid = threadIdx.x; C.lane = C.tid & 63; C.wave = __builtin_amdgcn_readfirstlane(C.tid >> 6); C.G = gridDim.x; C.bid = blockIdx.x; C.a = ap0;
    volatile LAS unsigned* misc = (volatile LAS unsigned*)(C.lds + LDS_MISC);
    if (C.tid < 64) misc[C.tid] = 0u;
    __syncthreads();
    const int ph_lo = ap0->ph_lo, ph_hi = ap0->ph_hi;
    const int wave0 = __builtin_amdgcn_readfirstlane((int)threadIdx.x >> 6);
    XcdBarrier bar; bar.bar = (unsigned*)(ap0->ws + WS_CTL) + CW_BAR; bar.x = 0; bar.st = nullptr;
    const bool fused = (ph_hi - ph_lo) > 1;
    if (fused) bar = xcd_barrier_post((unsigned*)(ap0->ws + WS_CTL) + CW_BAR, misc + 8);
#ifndef PHASE_MASK
#define PHASE_MASK 0x3ff
#endif
#define PM(k) ((PHASE_MASK >> (k)) & 1)
    unsigned long long tph_ = TS_NOW();
    for (int ph = ph_lo; ph < ph_hi; ++ph) {
        { int l_ = (int)__builtin_amdgcn_mbcnt_hi(~0u, __builtin_amdgcn_mbcnt_lo(~0u, 0u)); asm volatile("" : "+v"(l_)); C.lane = l_; C.tid = wave0 * 64 + l_; C.wave = wave0; }
        ArgsP ap = (ArgsP)__builtin_amdgcn_kernarg_segment_ptr(); asm volatile("" : "+s"(ap)); C.a = ap;
        unsigned char* ws = ap->ws; unsigned char* wb = ws + WS_W;
        bf16_t* XBF = (bf16_t*)(ws + WS_XBF); bf16_t* ACT = (bf16_t*)(ws + WS_ACT); bf16_t* PB = (bf16_t*)(ws + WS_P); bf16_t* YB = (bf16_t*)(ws + WS_Y);
        float* SSQA = (float*)(ws + WS_SSQ); float* SSQB = SSQA + (size_t)MTOK * 16; float* SSQC = SSQB + (size_t)MTOK * 16;
        if (ph == 0) { if (PM(9)) { convert_weights(C, 0, CV_GU1 | CV_LORA, C.bid * 8 + C.wave, C.G * 8, wb); prologue_x(C); } }
        else {
            const int l = (ph - 1) / 8, sp = (ph - 1) % 8;
            const unsigned char* wb1 = l == 0 ? wb : (const unsigned char*)ap->out + OUT_ALT_W;
            pg8::StaticOrder S;
            int tail_l = 0, tail_rem = 0; unsigned tail_sel = 0u;
#define TAIL_CONVERT(L, SEL) do { tail_l = (L); tail_sel = (SEL); tail_rem = S.nwg % C.G; } while (0)
            switch (sp) {
            case 0: if (PM(0)) { pg8::Gemm g{XBF, (const bf16_t*)(wb1 + W_GU1), MTOK, NGU, DM}; S.init(MTOK, NGU, C.G, C.bid); pg8::rstd_table_fill(C.lds, SSQA, S, C.tid); pg8::EpiFfnUp E{ACT, (const LAS float*)(C.lds + pg8::RSTD_TAB_OFF)};
                      pg8::gemm_phase<pg8::EpiFfnUp, pg8::StaticOrder, true, true>(C.lds, g, S, E, C.tid);
                      if (l == 0) TAIL_CONVERT(0, CV_D1 | CV_IN); } break;
            case 1: if (PM(1)) { pg8::Gemm g{ACT, (const bf16_t*)(wb1 + W_D1), MTOK, DM, FF}; S.init(MTOK, DM, C.G, C.bid); pg8::EpiResid E{XBF, XBF, (bf16_t*)ap->out, nullptr, SSQB, ap->shadow ? 0.f : 0.5f};
                      pg8::gemm_phase<pg8::EpiResid, pg8::StaticOrder, true, true>(C.lds, g, S, E, C.tid); } break;
            case 2: if (PM(2)) { pg8::Gemm g{XBF, (const bf16_t*)(wb + W_IN), MTOK, NIN, DM}; S.init(MTOK, NIN, C.G, C.bid); pg8::rstd_table_fill(C.lds, SSQB, S, C.tid); pg8::EpiRowScaleBf16 E{PB, NIN, (const LAS float*)(C.lds + pg8::RSTD_TAB_OFF)};
                      pg8::gemm_phase<pg8::EpiRowScaleBf16, pg8::StaticOrder, true, true>(C.lds, g, S, E, C.tid);
                      if (l == 0) TAIL_CONVERT(0, CV_OUT | CV_GU2 | CV_D2); } break;
            case 3: if (PM(3)) prep_phase(C, l); break;
            case 4: if (PM(4)) mixers_phase(C, l); break;
            case 5: if (PM(5)) { pg8::Gemm g{YB, (const bf16_t*)(wb + W_OUT), MTOK, DM, DM}; S.init(MTOK, DM, C.G, C.bid); pg8::EpiResid E{(const bf16_t*)ap->out, XBF, nullptr, nullptr, SSQC, ap->shadow ? 0.f : 1.0f};
                      pg8::gemm_phase<pg8::EpiResid, pg8::StaticOrder, true, true>(C.lds, g, S, E, C.tid); } break;
            case 6: if (PM(6)) { pg8::Gemm g{XBF, (const bf16_t*)(wb + W_GU2), MTOK, NGU, DM}; S.init(MTOK, NGU, C.G, C.bid); pg8::rstd_table_fill(C.lds, SSQC, S, C.tid); pg8::EpiFfnUp E{ACT, (const LAS float*)(C.lds + pg8::RSTD_TAB_OFF)};
                      pg8::gemm_phase<pg8::EpiFfnUp, pg8::StaticOrder, true, true>(C.lds, g, S, E, C.tid);
                      if (l == 0) TAIL_CONVERT(1, CV_IN | CV_OUT | CV_LORA | CV_D1); } break;
            case 7: if (PM(7)) { pg8::Gemm g{ACT, (const bf16_t*)(wb + W_D2), MTOK, DM, FF}; S.init(MTOK, DM, C.G, C.bid); pg8::EpiResid E{XBF, l == 1 ? nullptr : XBF, nullptr, l == 1 ? ap->out : nullptr, l == 1 ? nullptr : SSQA, ap->shadow ? 0.f : 0.5f};
                      pg8::gemm_phase<pg8::EpiResid, pg8::StaticOrder, true, true>(C.lds, g, S, E, C.tid); } break;
            }
            if (tail_sel != 0u && tail_rem != 0 && C.bid >= tail_rem) convert_weights(C, tail_l, tail_sel, (C.bid - tail_rem) * 8 + C.wave, (C.G - tail_rem) * 8, tail_l == 0 ? ap->ws + WS_W : (unsigned char*)ap->out + OUT_ALT_W);
        }
        if (ph + 1 < ph_hi) xcd_barrier(bar, wave0);
        if (PROBE_STAT >= 40 && C.bid == 0 && C.tid == 0) { const unsigned long long tn_ = TS_NOW(); ((unsigned*)(ap0->ws + WS_CTL))[32 + 40 + ph] = (unsigned)(tn_ - tph_) * 10u; tph_ = tn_; }
    }
    if (PROBE_STAT >= 0 && ph_hi == NPHASE && ph_lo == 0) {
        xcd_barrier(bar, wave0);
        if (C.bid == 0 && C.tid == 0) { const unsigned tk = __hip_atomic_load((unsigned*)(ap0->ws + WS_CTL) + 32 + PROBE_STAT, __ATOMIC_RELAXED, __HIP_MEMORY_SCOPE_AGENT); ap0->out[0] += ((float)tk - (float)PROBE_STAT_OFF) * 1e-4f; }
    }
#if defined(SELFCHECK)
    if (C.bid == 0 && C.tid == 0 && ph_hi == NPHASE) { if (__hip_atomic_load((unsigned*)(ap0->ws + WS_CTL) + 16, __ATOMIC_RELAXED, __HIP_MEMORY_SCOPE_AGENT) != 0u) ap0->out[0] = __builtin_nanf(""); }
#endif
}

extern "C" void kernel_launch(void* const* d_in, const int* in_sizes, int n_in, void* d_out, int out_size, void* d_ws, size_t ws_size, hipStream_t stream) {
    static int grid = 0;
    if (grid == 0) {
        if (n_in != 28 || out_size != MTOK * DM || ws_size < WS_END) { fprintf(stderr, "kernel_launch: unexpected shapes (n_in %d out %d ws %zu)\n", n_in, out_size, ws_size); grid = -1; return; }
        int dev = 0, cus = 0, per_cu = 0;
        if (hipGetDevice(&dev) != hipSuccess || hipDeviceGetAttribute(&cus, hipDeviceAttributeMultiprocessorCount, dev) != hipSuccess) { grid = -1; return; }
        if (hipFuncSetAttribute((const void*)fwd_kernel, hipFuncAttributeMaxDynamicSharedMemorySize, LDS_BYTES) != hipSuccess) { fprintf(stderr, "kernel_launch: hipFuncSetAttribute failed\n"); grid = -1; return; }
        if (hipOccupancyMaxActiveBlocksPerMultiprocessor(&per_cu, (const void*)fwd_kernel, 512, LDS_BYTES) != hipSuccess || per_cu < 1) { fprintf(stderr, "kernel_launch: occupancy query says %d\n", per_cu); per_cu = 1; }
        (void)hipGetLastError();
        grid = cus;
    }
    if (grid < 0) return;
    (void)hipMemsetAsync((char*)d_ws + WS_CTL, 0, CTL_ZERO_BYTES, stream);
    Args a{};
    for (int i = 0; i < 28; ++i) a.in[i] = (const float*)d_in[i];
    a.out = (float*)d_out; a.ws = (unsigned char*)d_ws; a.sub = -1;
#if MK_N_LAUNCHES == 1
    a.ph_lo = 0; a.ph_hi = NPHASE;
    void* kargs[] = {&a};
    hipError_t e = hipLaunchCooperativeKernel((const void*)fwd_kernel, dim3(grid), dim3(512), kargs, LDS_BYTES, stream);
    if (e != hipSuccess) fprintf(stderr, "kernel_launch: cooperative launch failed: %s\n", hipGetErrorString(e));
#else
#ifndef PROBE_PH_DUP
#define PROBE_PH_DUP 0
#endif
#ifndef PROBE_SUB_DUP
#define PROBE_SUB_DUP 0
#endif
    for (int ph = 0; ph < NPHASE; ++ph) { a.ph_lo = ph; a.ph_hi = ph + 1;
        if (ph > 0 && (ph - 1) % 8 == 4) {
            if (PROBE_SUB_DUP & 8) { a.sub = 0; hipLaunchKernelGGL(fwd_kernel, dim3(grid), dim3(512), LDS_BYTES, stream, a); a.sub = 1; hipLaunchKernelGGL(fwd_kernel, dim3(grid), dim3(512), LDS_BYTES, stream, a); }
            for (int sb = 0; sb < 3; ++sb) { a.sub = sb; hipLaunchKernelGGL(fwd_kernel, dim3(grid), dim3(512), LDS_BYTES, stream, a);
                if ((PROBE_SUB_DUP >> sb) & 1) { if (sb == 2) (void)hipMemsetAsync((char*)d_ws + WS_CTL + CW_WORK * 4, 0, 1024, stream); hipLaunchKernelGGL(fwd_kernel, dim3(grid), dim3(512), LDS_BYTES, stream, a); } }
            a.sub = -1; continue; }
#ifndef PROBE_SHADOW
#define PROBE_SHADOW 0
#endif
        if ((PROBE_SHADOW >> ph) & 1) { a.shadow = 1; hipLaunchKernelGGL(fwd_kernel, dim3(grid), dim3(512), LDS_BYTES, stream, a); a.shadow = 0; }
        hipLaunchKernelGGL(fwd_kernel, dim3(grid), dim3(512), LDS_BYTES, stream, a);
        if ((PROBE_PH_DUP >> ph) & 1) { (void)hipMemsetAsync((char*)d_ws + WS_CTL, 0, CTL_ZERO_BYTES, stream); hipLaunchKernelGGL(fwd_kernel, dim3(grid), dim3(512), LDS_BYTES, stream, a); } }
#endif
}
```
